# Optimizing an MI355X kernel written in HIP

```python
import math
import jax, jax.numpy as jnp
from jax import lax
import numpy as np

D_MODEL = 1024
BATCH = 32
SEQ = 256
DEPTH = 2
DEC_BATCH = 8
DEC_SEQ = 1024
PAST_LEN = 512

GRID_W = 64
HEAD_DIM = 64
N_BRANCH = 4
BRANCH_W = D_MODEL // N_BRANCH
ATT_HEADS = BRANCH_W // HEAD_DIM
ATT_KV_HEADS = ATT_HEADS // 2
GDN_HEADS = BRANCH_W // HEAD_DIM
RET_HEADS = BRANCH_W // HEAD_DIM
NA_HEADS = BRANCH_W // HEAD_DIM
SHORT_CONV = 5
CHUNK = 64
Q_BLOCK = 128
NA_ROWS = 8
NA_COLS = 16
NA_KCOLS = 2 * NA_COLS
ROPE_THETA = 10000.0
RET_DECAY_BASE_FWD = 5.0
RET_DECAY_BASE_BWD = 5.5
EPS = 1e-6
IN_SPLITS = (
    ATT_HEADS * HEAD_DIM, ATT_KV_HEADS * HEAD_DIM, ATT_KV_HEADS * HEAD_DIM, BRANCH_W,
    3 * GDN_HEADS * HEAD_DIM, 4 * GDN_HEADS, BRANCH_W,
    RET_HEADS * HEAD_DIM, RET_HEADS * HEAD_DIM, RET_HEADS * HEAD_DIM, BRANCH_W,
    NA_HEADS * HEAD_DIM, NA_HEADS * HEAD_DIM, NA_HEADS * HEAD_DIM, BRANCH_W,
    N_BRANCH * D_MODEL,
)
IN_W = sum(IN_SPLITS)

kernel_name = "hybrid_diffusion_parallel_mixer_step"


def _rmsnorm(x, g):
    xf = x.astype(jnp.float32)
    y = xf * lax.rsqrt(jnp.mean(xf * xf, axis=-1, keepdims=True) + EPS)
    return (y * g.astype(jnp.float32)).astype(x.dtype)


def _l2norm(x):
    return x * lax.rsqrt(jnp.sum(x * x, axis=-1, keepdims=True) + EPS)


def _heads(x, h):
    return x.reshape(x.shape[0], x.shape[1], h, HEAD_DIM)


def _split_proj(p):
    offs = np.cumsum(IN_SPLITS)[:-1].tolist()
    return jnp.split(p, offs, axis=-1)


def _axial_rope(x):
    s = x.shape[1]
    t = jnp.arange(s)
    row = (t // GRID_W).astype(jnp.float32)
    col = (t % GRID_W).astype(jnp.float32)
    half = HEAD_DIM // 2
    quarter = half // 2
    inv = ROPE_THETA ** (-jnp.arange(quarter, dtype=jnp.float32) / quarter)

    def rot(xp, pos):
        ang = pos[:, None] * inv
        cos = jnp.cos(ang)[None, :, None, :]
        sin = jnp.sin(ang)[None, :, None, :]
        x1, x2 = xp[..., :quarter], xp[..., quarter:]
        return jnp.concatenate([x1 * cos - x2 * sin, x2 * cos + x1 * sin], axis=-1)

    xf = x.astype(jnp.float32)
    out = jnp.concatenate([rot(xf[..., :half], row), rot(xf[..., half:], col)], axis=-1)
    return out.astype(x.dtype)


def _block_attention(q, k, v):
    b, s, hq, d = q.shape
    hkv = k.shape[2]
    rep = hq // hkv
    nblk = s // Q_BLOCK
    qb = q.reshape(b, nblk, Q_BLOCK, hkv, rep, d).transpose(1, 0, 2, 3, 4, 5)
    scale = d ** -0.5

    def one(qi):
        sc = jnp.einsum('bqgrd,bkgd->bgrqk', qi, k, preferred_element_type=jnp.float32) * scale
        p = jax.nn.softmax(sc, axis=-1).astype(v.dtype)
        return jnp.einsum('bgrqk,bkgd->bqgrd', p, v)

    o = lax.map(one, qb)
    return o.transpose(1, 0, 2, 3, 4, 5).reshape(b, s, hq * d)


def _neighbourhood_attention(q, k, v, ctx_k, ctx_v, bias_table):
    b, n, h, d = q.shape
    rows = n // GRID_W
    wr = min(NA_ROWS, rows)
    ncb = GRID_W // NA_COLS
    r = jnp.arange(rows)
    rs = jnp.clip(r - wr // 2, 0, rows - wr)
    row_idx = rs[:, None] + jnp.arange(wr)[None, :]
    j = jnp.arange(ncb)
    bs = jnp.clip(j * NA_COLS - NA_COLS // 2, 0, GRID_W - NA_KCOLS)
    col_idx = bs[:, None] + jnp.arange(NA_KCOLS)[None, :]
    kg = k.reshape(b, rows, GRID_W, h, d)[:, row_idx][:, :, :, col_idx]
    vg = v.reshape(b, rows, GRID_W, h, d)[:, row_idx][:, :, :, col_idx]
    qg = q.reshape(b, rows, ncb, NA_COLS, h, d)
    scale = d ** -0.5
    s_loc = jnp.einsum('brjqhd,brwjkhd->brjhqwk', qg, kg, preferred_element_type=jnp.float32) * scale
    qc = j[:, None] * NA_COLS + jnp.arange(NA_COLS)[None, :]
    cs = jnp.clip(qc - NA_COLS // 2, 0, GRID_W - NA_COLS)
    kc = col_idx[:, None, :]
    col_ok = (kc >= cs[:, :, None]) & (kc < cs[:, :, None] + NA_COLS)
    dc_i = jnp.clip(kc - qc[:, :, None] + NA_COLS - 1, 0, 2 * NA_COLS - 2)
    dr_i = row_idx - r[:, None] + NA_ROWS - 1
    bias = bias_table[:, dr_i[:, None, None, :, None], dc_i[None, :, :, None, :]].astype(jnp.float32)
    bias = bias.transpose(1, 2, 0, 3, 4, 5)
    s_loc = jnp.where(col_ok[None, None, :, None, :, None, :], s_loc + bias[None], -jnp.inf)
    s_loc = s_loc.reshape(b, rows, ncb, h, NA_COLS, wr * NA_KCOLS)
    s_ctx = jnp.einsum('brjqhd,blhd->brjhql', qg, ctx_k.astype(q.dtype), preferred_element_type=jnp.float32) * scale
    p = jax.nn.softmax(jnp.concatenate([s_loc, s_ctx], axis=-1), axis=-1).astype(v.dtype)
    p_loc = p[..., :wr * NA_KCOLS].reshape(b, rows, ncb, h, NA_COLS, wr, NA_KCOLS)
    p_ctx = p[..., wr * NA_KCOLS:]
    o = (jnp.einsum('brjhqwk,brwjkhd->brjqhd', p_loc, vg)
         + jnp.einsum('brjhql,blhd->brjqhd', p_ctx, ctx_v.astype(v.dtype)))
    return o.reshape(b, n, h * d)


def _short_conv(x, w):
    ch = x.shape[-1]
    pad = SHORT_CONV // 2
    y = lax.conv_general_dilated(x, w[:, None, :].astype(x.dtype), window_strides=(1,),
                                 padding=((pad, pad),), dimension_numbers=('NWC', 'WIO', 'NWC'),
                                 feature_group_count=ch)
    return jax.nn.silu(y)


def _to_chunks(x):
    b, s = x.shape[:2]
    x = x.reshape((b, s // CHUNK, CHUNK) + x.shape[2:])
    return x.transpose((1, 0, 3, 2) + tuple(range(4, x.ndim)))


def _from_chunks(o, b, s):
    return o.transpose(1, 0, 3, 2, 4).reshape(b, s, o.shape[2], o.shape[4])


def _gated_delta_chunked(q, k, v, beta, log_a, s0):
    b, s = q.shape[:2]
    qc, kc, vc = _to_chunks(q), _to_chunks(k), _to_chunks(v)
    bc = _to_chunks(beta)
    gc = jnp.cumsum(_to_chunks(log_a), axis=-1)
    idx = jnp.arange(CHUNK)
    causal = idx[:, None] >= idx[None, :]
    strict = idx[:, None] > idx[None, :]
    gdiff = gc[..., :, None] - gc[..., None, :]
    decay_incl = jnp.exp(jnp.where(causal, gdiff, -jnp.inf))
    decay_strict = jnp.where(strict, decay_incl, 0.0)
    kb = kc * bc[..., None]
    a_mat = jnp.einsum('nbhid,nbhjd->nbhij', kb, kc) * decay_strict
    u = lax.linalg.triangular_solve(a_mat, vc * bc[..., None], left_side=True, lower=True, unit_diagonal=True)
    w = lax.linalg.triangular_solve(a_mat, kb * jnp.exp(gc)[..., None], left_side=True, lower=True, unit_diagonal=True)
    qk = jnp.einsum('nbhid,nbhjd->nbhij', qc, kc) * decay_incl
    q_dec = qc * jnp.exp(gc)[..., None]
    g_last = gc[..., -1]
    k_dec = kc * jnp.exp(g_last[..., None] - gc)[..., None]

    def step(state, xs):
        u_i, w_i, qk_i, qd_i, kd_i, gl_i = xs
        v_new = u_i - jnp.einsum('bhck,bhkv->bhcv', w_i, state)
        o = jnp.einsum('bhck,bhkv->bhcv', qd_i, state) + jnp.einsum('bhij,bhjv->bhiv', qk_i, v_new)
        state = state * jnp.exp(gl_i)[..., None, None] + jnp.einsum('bhck,bhcv->bhkv', kd_i, v_new)
        return state, o

    s_fin, o = lax.scan(step, s0, (u, w, qk, q_dec, k_dec, g_last))
    return _from_chunks(o, b, s), s_fin


def _retention_chunked(q, k, v, log_gamma, s0):
    b, s = q.shape[:2]
    qc, kc, vc = _to_chunks(q), _to_chunks(k), _to_chunks(v)
    idx = jnp.arange(CHUNK, dtype=jnp.float32)
    diff = idx[:, None] - idx[None, :]
    decay = jnp.where(diff >= 0, jnp.exp(jnp.maximum(diff, 0.0)[None] * log_gamma[:, None, None]), 0.0)
    q_dec = jnp.exp((idx + 1.0)[None, :] * log_gamma[:, None])
    k_dec = jnp.exp((CHUNK - 1.0 - idx)[None, :] * log_gamma[:, None])
    c_dec = jnp.exp(CHUNK * log_gamma)
    intra = jnp.einsum('nbhij,nbhjv->nbhiv', jnp.einsum('nbhid,nbhjd->nbhij', qc, kc) * decay, vc)
    qd = qc * q_dec[:, :, None]
    kd = kc * k_dec[:, :, None]

    def step(state, xs):
        intra_i, qd_i, kd_i, v_i = xs
        o = intra_i + jnp.einsum('bhck,bhkv->bhcv', qd_i, state)
        state = state * c_dec[:, None, None] + jnp.einsum('bhck,bhcv->bhkv', kd_i, v_i)
        return state, o

    s_fin, o = lax.scan(step, s0, (intra, qd, kd, vc))
    return _from_chunks(o, b, s), s_fin


def _flip(x):
    return jnp.flip(x, axis=1)


def _gdn_branch(qkv_raw, ab_raw, z, conv_w, a_log, dt_bias, norm_g, s0):
    f32 = jnp.float32
    b, s, _ = qkv_raw.shape
    qkv = _short_conv(qkv_raw, conv_w).astype(f32)
    q, k, v = jnp.split(qkv, 3, axis=-1)
    q = _l2norm(_heads(q, GDN_HEADS)) * HEAD_DIM ** -0.5
    k = _l2norm(_heads(k, GDN_HEADS))
    v = _heads(v, GDN_HEADS)
    ab = ab_raw.astype(f32).reshape(b, s, 4, GDN_HEADS)
    beta = jax.nn.sigmoid(ab[:, :, 0:2])
    log_a = -jnp.exp(a_log.astype(f32)) * jax.nn.softplus(ab[:, :, 2:4] + dt_bias.astype(f32))
    s0 = s0.astype(f32)
    o_f, st_f = _gated_delta_chunked(q, k, v, beta[:, :, 0], log_a[:, :, 0], s0[:, 0])
    o_b, st_b = _gated_delta_chunked(_flip(q), _flip(k), _flip(v), _flip(beta[:, :, 1]),
                                     _flip(log_a[:, :, 1]), s0[:, 1])
    o = _rmsnorm(o_f + _flip(o_b), norm_g).reshape(b, s, BRANCH_W).astype(z.dtype)
    return o * jax.nn.silu(z), jnp.stack([st_f, st_b], axis=1)


def _ret_log_gamma(base):
    return jnp.log1p(-jnp.exp2(-(base + jnp.arange(RET_HEADS, dtype=jnp.float32))))


def _ret_branch(q_raw, k_raw, v_raw, z, norm_g, s0):
    f32 = jnp.float32
    b, s, _ = q_raw.shape
    q = _heads(q_raw.astype(f32), RET_HEADS) * HEAD_DIM ** -0.5
    k = _heads(k_raw.astype(f32), RET_HEADS)
    v = _heads(v_raw.astype(f32), RET_HEADS)
    s0 = s0.astype(f32)
    o_f, st_f = _retention_chunked(q, k, v, _ret_log_gamma(RET_DECAY_BASE_FWD), s0[:, 0])
    o_b, st_b = _retention_chunked(_flip(q), _flip(k), _flip(v), _ret_log_gamma(RET_DECAY_BASE_BWD), s0[:, 1])
    o = _rmsnorm(o_f + _flip(o_b), norm_g).reshape(b, s, BRANCH_W).astype(z.dtype)
    return o * jax.nn.silu(z), jnp.stack([st_f, st_b], axis=1)


def _layer(h, cond, ctx, w_ada, b_ada, norm_g, w_in, conv_w, gdn_a_log, gdn_dt_bias, gdn_norm,
           attn_q_norm, attn_k_norm, ret_norm, na_bias, w_branch, w_out):
    b, s, _ = h.shape
    mod = jax.nn.silu(cond) @ w_ada + b_ada
    shift, scale, gate = jnp.split(mod, 3, axis=-1)
    hn = _rmsnorm(h, norm_g) * (1 + scale[:, None]) + shift[:, None]
    (aq, ak, av, az, gqkv, gab, gz, rq, rk, rv, rz, nq, nk, nv, nz, mg) = _split_proj(hn @ w_in)
    qa = _rmsnorm(_heads(aq, ATT_HEADS), attn_q_norm)
    ka = _rmsnorm(_heads(ak, ATT_KV_HEADS), attn_k_norm)
    va = _heads(av, ATT_KV_HEADS)
    qn, kn, vn = _heads(nq, NA_HEADS), _heads(nk, NA_HEADS), _heads(nv, NA_HEADS)
    if ctx is None:
        oa = _block_attention(qa, ka, va)
        od = _block_attention(qn, kn, vn)
        sg0 = jnp.zeros((b, 2, GDN_HEADS, HEAD_DIM, HEAD_DIM), jnp.float32)
        sr0 = jnp.zeros((b, 2, RET_HEADS, HEAD_DIM, HEAD_DIM), jnp.float32)
    else:
        ctx_ka, ctx_va, ctx_kn, ctx_vn, sg0, sr0 = ctx
        keys = jnp.concatenate([_axial_rope(ka), ctx_ka.astype(ka.dtype)], axis=1)
        vals = jnp.concatenate([va, ctx_va.astype(va.dtype)], axis=1)
        oa = _block_attention(_axial_rope(qa), keys, vals)
        od = _neighbourhood_attention(qn, kn, vn, ctx_kn, ctx_vn, na_bias)
    oa = oa * jax.nn.silu(az)
    od = od * jax.nn.silu(nz)
    ob, sg = _gdn_branch(gqkv, gab, gz, conv_w, gdn_a_log, gdn_dt_bias, gdn_norm, sg0)
    oc, sr = _ret_branch(rq, rk, rv, rz, ret_norm, sr0)
    gates = jax.nn.sigmoid(mg.astype(jnp.float32)).astype(h.dtype).reshape(b, s, N_BRANCH, D_MODEL)
    branches = jnp.stack([oa, ob, oc, od], axis=2)
    up = jnp.einsum('bsnw,nwd->bsnd', branches, w_branch)
    out = jnp.einsum('bsnd,bsnd->bsd', gates, up) @ w_out
    return h + gate[:, None] * out, (ka, va, kn, vn, sg, sr)


def setup_inputs(seed: int = 0) -> dict:
    key = jax.random.key(seed)
    ks = jax.random.split(key, 26)
    f32 = jnp.float32

    def nrm(k, shape, sd):
        return jax.random.normal(k, shape, f32) * sd

    dt = jnp.exp(jax.random.uniform(ks[16], (DEPTH, 2, GDN_HEADS), f32, math.log(1e-3), math.log(1e-1)))
    return {
        "x_prompt": nrm(ks[0], (BATCH, SEQ, D_MODEL), 1.0),
        "x_sample": nrm(ks[1], (DEC_BATCH, DEC_SEQ, D_MODEL), 1.0),
        "cache_attn_k": nrm(ks[2], (DEC_BATCH, DEPTH, PAST_LEN, ATT_KV_HEADS, HEAD_DIM), 1.0),
        "cache_attn_v": nrm(ks[3], (DEC_BATCH, DEPTH, PAST_LEN, ATT_KV_HEADS, HEAD_DIM), 1.0),
        "cache_na_k": nrm(ks[4], (DEC_BATCH, DEPTH, PAST_LEN, NA_HEADS, HEAD_DIM), 1.0),
        "cache_na_v": nrm(ks[5], (DEC_BATCH, DEPTH, PAST_LEN, NA_HEADS, HEAD_DIM), 1.0),
        "state_gdn": nrm(ks[6], (DEC_BATCH, DEPTH, 2, GDN_HEADS, HEAD_DIM, HEAD_DIM), 0.5),
        "state_ret": nrm(ks[7], (DEC_BATCH, DEPTH, 2, RET_HEADS, HEAD_DIM, HEAD_DIM), 1.0),
        "c": nrm(ks[8], (DEC_BATCH, D_MODEL), 1.0),
        "c_ctx": nrm(ks[9], (D_MODEL,), 1.0),
        "w_ada": nrm(ks[10], (DEPTH, D_MODEL, 3 * D_MODEL), 0.5 * D_MODEL ** -0.5),
        "b_ada": nrm(ks[11], (DEPTH, 3 * D_MODEL), 0.01),
        "norm_g": 1.0 + nrm(ks[12], (DEPTH, D_MODEL), 0.02),
        "w_in": nrm(ks[13], (DEPTH, D_MODEL, IN_W), D_MODEL ** -0.5),
        "conv_w": nrm(ks[14], (DEPTH, SHORT_CONV, 3 * GDN_HEADS * HEAD_DIM), SHORT_CONV ** -0.5),
        "gdn_a_log": jnp.log(jax.random.uniform(ks[15], (DEPTH, 2, GDN_HEADS), f32, 1.0, 16.0)),
        "gdn_dt_bias": dt + jnp.log(-jnp.expm1(-dt)),
        "gdn_norm": 1.0 + nrm(ks[17], (DEPTH, HEAD_DIM), 0.02),
        "attn_q_norm": 1.0 + nrm(ks[18], (DEPTH, HEAD_DIM), 0.02),
        "attn_k_norm": 1.0 + nrm(ks[19], (DEPTH, HEAD_DIM), 0.02),
        "ret_norm": 1.0 + nrm(ks[20], (DEPTH, HEAD_DIM), 0.02),
        "na_bias": nrm(ks[21], (DEPTH, NA_HEADS, 2 * NA_ROWS - 1, 2 * NA_COLS - 1), 0.1),
        "w_branch": nrm(ks[22], (DEPTH, N_BRANCH, BRANCH_W, D_MODEL), BRANCH_W ** -0.5),
        "w_out": nrm(ks[23], (DEPTH, D_MODEL, D_MODEL), D_MODEL ** -0.5),
        "final_norm": 1.0 + nrm(ks[24], (D_MODEL,), 0.02),
    }


def reference(x_prompt, x_sample, cache_attn_k, cache_attn_v, cache_na_k, cache_na_v, state_gdn, state_ret,
              c, c_ctx, w_ada, b_ada, norm_g, w_in, conv_w, gdn_a_log, gdn_dt_bias, gdn_norm,
              attn_q_norm, attn_k_norm, ret_norm, na_bias, w_branch, w_out, final_norm):
    def params(l):
        return dict(w_ada=w_ada[l], b_ada=b_ada[l], norm_g=norm_g[l], w_in=w_in[l], conv_w=conv_w[l],
                    gdn_a_log=gdn_a_log[l], gdn_dt_bias=gdn_dt_bias[l], gdn_norm=gdn_norm[l],
                    attn_q_norm=attn_q_norm[l], attn_k_norm=attn_k_norm[l], ret_norm=ret_norm[l],
                    na_bias=na_bias[l], w_branch=w_branch[l], w_out=w_out[l])

    h = x_prompt
    cond_ctx = jnp.broadcast_to(c_ctx, (x_prompt.shape[0], D_MODEL))
    ka_l, va_l, kn_l, vn_l, sg_l, sr_l = [], [], [], [], [], []
    for l in range(DEPTH):
        h, (ka, va, kn, vn, sg, sr) = _layer(h, cond_ctx, None, **params(l))
        ka_l.append(ka); va_l.append(va); kn_l.append(kn); vn_l.append(vn); sg_l.append(sg); sr_l.append(sr)
    y_prompt = _rmsnorm(h, final_norm)
    dt = x_prompt.dtype
    new_attn_k = jnp.stack(ka_l, axis=1).astype(dt)
    new_attn_v = jnp.stack(va_l, axis=1).astype(dt)
    new_na_k = jnp.stack(kn_l, axis=1).astype(dt)
    new_na_v = jnp.stack(vn_l, axis=1).astype(dt)
    new_state_gdn = jnp.stack(sg_l, axis=1).astype(dt)
    new_state_ret = jnp.stack(sr_l, axis=1).astype(dt)

    h = x_sample
    for l in range(DEPTH):
        ctx = (cache_attn_k[:, l], cache_attn_v[:, l], cache_na_k[:, l], cache_na_v[:, l],
               state_gdn[:, l], state_ret[:, l])
        h, _ = _layer(h, c, ctx, **params(l))
    y_sample = _rmsnorm(h, final_norm)
    return (y_prompt, y_sample, new_attn_k, new_attn_v, new_na_k, new_na_v, new_state_gdn, new_state_ret)
```

```cpp
#include <hip/hip_runtime.h>
#include <cstdio>
#include <cstdint>

#ifndef CFG_NB
#define CFG_NB 32
#endif
#ifndef CFG_DB
#define CFG_DB 8
#endif

#ifdef EMU
#define LAS
#define GAS
#define ASMV(x)
#else
#define LAS __attribute__((address_space(3)))
#define GAS __attribute__((address_space(1)))
#define ASMV(x) asm volatile(x ::: "memory")
#endif
#define DEV __device__ __forceinline__
#ifdef EMU
#define CFENCE()
#else
#define CFENCE() asm volatile("" ::: "memory")
#endif
#ifdef EMU
#define OPAQUE(x)
#else
#define OPAQUE(x) asm volatile("" : "+v"(x))
#endif
#ifdef EMU
#define WAVE_SYNC() emu::wave_sync()
#else
#define WAVE_SYNC() __builtin_amdgcn_wave_barrier()
#endif

typedef unsigned short bf16;
typedef short bf16x8 __attribute__((ext_vector_type(8)));
typedef float f32x4 __attribute__((ext_vector_type(4)));
typedef float f32x2 __attribute__((ext_vector_type(2)));
typedef unsigned u32x4 __attribute__((ext_vector_type(4)));
typedef unsigned u32x2 __attribute__((ext_vector_type(2)));

constexpr int D = 1024, DEPTH = 2, HD = 64, NB = CFG_NB, SEQ = 256, DB = CFG_DB, DSEQ = 1024, PAST = 512;
constexpr int TC = NB * SEQ, TS = DB * DSEQ, T = TC + TS, NCOND = 1 + DB, NSEQ = NB + DB;
constexpr int INW = 7952, NPERM = 8192, NIN = 4096;
constexpr float EPS = 1e-6f;
static_assert(T % 256 == 0 && TC % 256 == 0, "token tiles");

constexpr size_t O_Y = 0;
constexpr size_t O_AK = (size_t)T * D;
constexpr size_t O_AV = O_AK + (size_t)NB * DEPTH * SEQ * 128;
constexpr size_t O_NK = O_AV + (size_t)NB * DEPTH * SEQ * 128;
constexpr size_t O_NV = O_NK + (size_t)NB * DEPTH * SEQ * 256;
constexpr size_t O_SG = O_NV + (size_t)NB * DEPTH * SEQ * 256;
constexpr size_t O_SR = O_SG + (size_t)NB * DEPTH * 2 * 4 * 4096;
constexpr size_t O_END = O_SR + (size_t)NB * DEPTH * 2 * 4 * 4096;

constexpr size_t al256(size_t x) { return (x + 255) & ~(size_t)255; }
constexpr size_t WS_CTL = 0, CTL_BYTES = 65536;
constexpr size_t WS_MODT = WS_CTL + CTL_BYTES;
constexpr size_t WS_ROPE = al256(WS_MODT + (size_t)DEPTH * NCOND * 3072 * 4);
constexpr size_t WS_WIN = al256(WS_ROPE + 2 * 64 * 16 * 4);
constexpr size_t WS_WBR = WS_WIN + (size_t)NPERM * D * 2;
constexpr size_t WS_WOUT = WS_WBR + (size_t)4 * D * 256 * 2;
constexpr size_t WS_KAC = WS_WOUT + (size_t)D * D * 2;
constexpr size_t WS_VACT = WS_KAC + (size_t)DEPTH * DB * 2 * PAST * 64 * 2;
constexpr size_t WS_NKC = WS_VACT + (size_t)DEPTH * DB * 2 * PAST * 64 * 2;
constexpr size_t WS_NVCT = WS_NKC + (size_t)DEPTH * DB * 4 * PAST * 64 * 2;
constexpr size_t WS_HN = WS_NVCT + (size_t)DEPTH * DB * 4 * PAST * 64 * 2;
constexpr size_t WS_QA = WS_HN + (size_t)T * D * 2;
constexpr size_t WS_GQKV = WS_QA + (size_t)T * 256 * 2;
constexpr size_t WS_RQKV = WS_GQKV + (size_t)T * 768 * 2;
constexpr size_t WS_NQ = WS_RQKV + (size_t)T * 768 * 2;
constexpr size_t WS_KA = WS_NQ + (size_t)T * 256 * 2;
constexpr size_t WS_VAT = WS_KA + (size_t)T * 128 * 2;
constexpr size_t WS_NK = WS_VAT + (size_t)T * 128 * 2;
constexpr size_t WS_NVT = WS_NK + (size_t)T * 256 * 2;
constexpr size_t WS_AZ = WS_NVT + (size_t)T * 256 * 2;
constexpr size_t WS_GZ = WS_AZ + (size_t)T * 256 * 2;
constexpr size_t WS_RZ = WS_GZ + (size_t)T * 256 * 2;
constexpr size_t WS_NZ = WS_RZ + (size_t)T * 256 * 2;
constexpr size_t WS_GAB = WS_NZ + (size_t)T * 256 * 2;
constexpr size_t WS_TMAT = WS_GAB + (size_t)T * 16 * 4;
constexpr size_t WS_O = WS_TMAT + (size_t)(T / 64) * 8 * 4096 * 4;
constexpr size_t WS_END = WS_O + (size_t)4 * T * 256 * 2;
constexpr size_t WS_MERGED = WS_QA, WS_GATE = WS_RQKV;
static_assert(WS_END <= (size_t)256 * 1024 * 1024, "d_ws map exceeds 256 MiB");

constexpr int LDS_BYTES = 147456;
constexpr int LDS_MISC = 146432;

struct Params { const float* in[25]; float* out; unsigned char* ws; };
#ifdef EMU
typedef const Params* PP;
#else
typedef const __attribute__((address_space(4))) Params* PP;
#endif

DEV unsigned f2bf(float f) { unsigned u = __builtin_bit_cast(unsigned, f); return (u + 0x7fffu + ((u >> 16) & 1u)) >> 16; }
DEV float bf2f(unsigned h) { return __builtin_bit_cast(float, h << 16); }
DEV unsigned pk2(float lo, float hi) {
#ifdef EMU
    return f2bf(lo) | (f2bf(hi) << 16);
#else
    unsigned r; asm volatile("v_cvt_pk_bf16_f32 %0, %1, %2" : "=v"(r) : "v"(lo), "v"(hi)); return r;
#endif
}
DEV float silu_f(float x) { return x / (1.f + __expf(-x)); }
DEV float sigmoid_f(float x) { return 1.f / (1.f + __expf(-x)); }
DEV float softplus_f(float x) { return fmaxf(x, 0.f) + __logf(1.0f + __expf(-fabsf(x))); }
#ifdef EMU
DEV float shx(float v, int mask, int lane) { return __shfl_xor(v, mask); }
DEV float shf(float v, int src) { return __shfl(v, src); }
#else
DEV float shx(float v, int mask, int lane) { return __builtin_bit_cast(float, __builtin_amdgcn_ds_bpermute((lane ^ mask) << 2, __builtin_bit_cast(int, v))); }
DEV float shf(float v, int src) { return __builtin_bit_cast(float, __builtin_amdgcn_ds_bpermute(src << 2, __builtin_bit_cast(int, v))); }
#endif
DEV float wave_sum(float v, int lane) {
#pragma unroll
    for (int o = 1; o < 64; o <<= 1) v += shx(v, o, lane);
    return v;
}

#ifdef EMU
struct XcdBarrier { unsigned* bar; };
DEV XcdBarrier xcd_barrier_post(unsigned* bar, volatile unsigned* st) { XcdBarrier b; b.bar = bar; return b; }
DEV void xcd_barrier(const XcdBarrier& b) {
    __syncthreads();
    if (threadIdx.x == 0) { const unsigned G = gridDim.x; const unsigned old = __atomic_fetch_add(&b.bar[0], 1u, __ATOMIC_SEQ_CST); const unsigned gen = old / G;
        while (__atomic_load_n(&b.bar[0], __ATOMIC_SEQ_CST) < (gen + 1u) * G) emu::yield(); }
    __syncthreads();
}
#else
#define XB_TMO      128
#define XB_XCNT(j)  (256  + 64 * (j))
#define XB_XSUB(j)  (1280 + 64 * (j))
#define XB_XGEN(j)  (2304 + 64 * (j))
#define XB_TOP      3328
#define XB_TOPGEN   3392
#define XCD_BAR_WORDS 3456
#define XB_SPIN_CAP (1u << 18)
__device__ __forceinline__ unsigned xb_ld(unsigned* p)              { return __hip_atomic_load(p, __ATOMIC_RELAXED, __HIP_MEMORY_SCOPE_AGENT); }
__device__ __forceinline__ unsigned xb_add(unsigned* p, unsigned v) { return __hip_atomic_fetch_add(p, v, __ATOMIC_RELAXED, __HIP_MEMORY_SCOPE_AGENT); }
__device__ __forceinline__ unsigned xb_xcc_id() { return (unsigned)__builtin_amdgcn_s_getreg((3 << 11) | 20) & 0xFu; }
#define XB_SPIN(cond, bar) do { unsigned _sp = 0; while (cond) { __builtin_amdgcn_s_sleep(1); \
    if ((++_sp & 255u) == 0u) { if (xb_ld(&(bar)[XB_TMO])) break; if (_sp > XB_SPIN_CAP) { atomicAdd(&(bar)[XB_TMO], 1u); break; } } } } while (0)
struct XcdBarrier { unsigned* bar; unsigned x; volatile LAS unsigned* st; };
__device__ __forceinline__ XcdBarrier xcd_barrier_post(unsigned* bar, volatile LAS unsigned* st) {
    XcdBarrier b; b.bar = bar; b.x = xb_xcc_id(); b.st = st;
    if (threadIdx.x == 0) (void)xb_add(&bar[XB_XCNT(b.x)], 1u);
    return b;
}
__device__ __forceinline__ void xcd_barrier_complete(unsigned* bar, unsigned x, unsigned& nloc, unsigned& nx) {
    const unsigned G = gridDim.x * gridDim.y * gridDim.z;
    unsigned sum, cnt, mine, sp = 0u;
    for (;;) {
        sum = 0u; cnt = 0u; mine = 0u;
#pragma unroll
        for (unsigned j = 0; j < 16; ++j) { const unsigned c = xb_ld(&bar[XB_XCNT(j)]); sum += c; cnt += (c > 0u) ? 1u : 0u; mine = (j == x) ? c : mine; }
        if (sum == G) break;
        __builtin_amdgcn_s_sleep(1);
        if ((++sp & 255u) == 0u) { if (xb_ld(&bar[XB_TMO])) break; if (sp > XB_SPIN_CAP) { atomicAdd(&bar[XB_TMO], 1u); break; } }
    }
    nloc = mine > 0u ? mine : 1u; nx = cnt > 0u ? cnt : 1u;
}
__device__ __forceinline__ void xcd_barrier(const XcdBarrier& b) {
    asm volatile("s_waitcnt vmcnt(0)" ::: "memory");
    __syncthreads();
    int tb_ = threadIdx.x; asm volatile("" : "+v"(tb_));
    if (tb_ == 0) {
        unsigned* bar = b.bar; asm volatile("" : "+s"(bar));
        unsigned bx_ = xb_xcc_id(); asm volatile("" : "+s"(bx_));
        __builtin_amdgcn_s_waitcnt(0);
        unsigned nloc = b.st[0], nx = b.st[1];
        if (nloc == 0u) { xcd_barrier_complete(bar, bx_, nloc, nx); b.st[0] = nloc; b.st[1] = nx; }
        const unsigned old = xb_add(&bar[XB_XSUB(bx_)], 1u);
        const unsigned gen = old / nloc;
        if (old + 1u == (gen + 1u) * nloc) {
            __builtin_amdgcn_fence(__ATOMIC_RELEASE, "agent");
            asm volatile("s_waitcnt vmcnt(0)" ::: "memory");
            const unsigned og = xb_add(&bar[XB_TOP], 1u);
            const unsigned tg = og / nx;
            if (og + 1u == (tg + 1u) * nx) xb_add(&bar[XB_TOPGEN], 1u);
            else XB_SPIN(xb_ld(&bar[XB_TOPGEN]) == tg, bar);
            __builtin_amdgcn_fence(__ATOMIC_ACQUIRE, "agent");
            xb_add(&bar[XB_XGEN(bx_)], 1u);
            asm volatile("s_waitcnt vmcnt(0)" ::: "memory");
        } else {
            XB_SPIN(xb_ld(&bar[XB_XGEN(bx_)]) == gen, bar);
            __builtin_amdgcn_fence(__ATOMIC_ACQUIRE, "agent");
            asm volatile("s_waitcnt vmcnt(0)" ::: "memory");
        }
    }
    __syncthreads();
}
#endif

namespace pg8 {
#define PG8_LAS LAS
constexpr int BM = 256, BK = 64, HALF = 128, HTB = HALF * BK * 2, STAGE_BYTES = 8 * HTB, NXCD = 8, WGM = 8;
__host__ __device__ __forceinline__ int lds_byte(int r, int c) { const int st = (r >> 4) * 2 + (c >> 5), rr = r & 15, cc = c & 31, ob = rr * 64 + cc * 2; return st * 1024 + (ob ^ (((ob >> 9) & 1) << 5)); }
__host__ __device__ __forceinline__ void stage_rc(int b, int& R, int& C) { const int st = b / 1024, sb = b % 1024, swz = sb ^ (((sb >> 9) & 1) << 5); R = (st >> 1) * 16 + swz / 64; C = (st & 1) * 32 + (swz % 64) / 2; }
__host__ __device__ __forceinline__ int perm32(int rho) { const int n = rho >> 4, i = rho & 15; return 8 * (i >> 2) + 4 * n + (i & 3); }
struct Unit { int pm, pn; };
struct Gemm { const bf16* A; const bf16* Bt; int M, N, K; };
struct StaticOrder {
    int nM, nN, nwg, G, c;
    __host__ __device__ void init(int M, int N, int G_, int c_) { nM = M / BM; nN = N / BM; nwg = nM * nN; G = G_; c = c_; }
    __host__ __device__ bool next(int i, Unit& u) const {
        const long L = (long)i * G + c; if (L >= nwg) return false;
        int wgid = (int)L; { const int q = nwg / NXCD, r = nwg % NXCD, xcd = wgid % NXCD, off = wgid / NXCD; wgid = (xcd < r ? xcd * (q + 1) : r * (q + 1) + (xcd - r) * q) + off; }
        const int nig = WGM * nN, gid = wgid / nig, fm = gid * WGM, gsz = (nM - fm) < WGM ? (nM - fm) : WGM;
        u.pm = fm + ((wgid % nig) % gsz); u.pn = (wgid % nig) / gsz; return true;
    }
    __device__ __forceinline__ void a_ready(const Unit&) const {}
    __device__ __forceinline__ void done(const Unit&) const {}
};
struct OneUnit {
    int pm, pn;
    __device__ __forceinline__ bool next(int i, Unit& u) const { if (i != 0) return false; u.pm = pm; u.pn = pn; return true; }
    __device__ __forceinline__ void a_ready(const Unit&) const {}
    __device__ __forceinline__ void done(const Unit&) const {}
};
#ifdef EMU
#define PG8_WAIT_V(n)
#define PG8_WAIT_L(n)
#else
#define PG8_WAIT_V(n) asm volatile("s_waitcnt vmcnt(" #n ")" ::: "memory")
#define PG8_WAIT_L(n) asm volatile("s_waitcnt lgkmcnt(" #n ")" ::: "memory")
#endif
template <class Epi, class Sched, bool ALIGN_EPI = false, bool SP2 = false>
__device__ __forceinline__ void gemm_phase(PG8_LAS unsigned char* lds, const Gemm g, const Sched& S, const Epi& E) {
    int tid_ = threadIdx.x; OPAQUE(tid_);
    const int tid = tid_, wid = __builtin_amdgcn_readfirstlane(tid >> 6), lane = tid & 63, wr = wid >> 2, wc = wid & 3, fr = lane & 15, fq = lane >> 4;
    const int K = g.K, nt = K / BK;
    unsigned voffA[2], voffB[2];
#pragma unroll
    for (int i = 0; i < 2; ++i) { int R, C; stage_rc(tid * 16 + i * 8192, R, C); const int Rb = Epi::PERM ? ((R & ~31) + perm32(R & 31)) : R;
        voffA[i] = (unsigned)(R * K + C) * 2u; voffB[i] = (unsigned)(Rb * K + C) * 2u; }
    const size_t kstep = (size_t)(BK * 2);
    const size_t hstep = (size_t)HALF * K * 2;
    const size_t tstep = 2 * hstep;
    const unsigned ldsw = (unsigned)wid * 1024u;
    const int aoff = lds_byte(wr * 64 + fr, fq * 8), boff = lds_byte(wc * 32 + fr, fq * 8);
#define PG8_SA(b, h) (((b) * 2 + (h)) * HTB)
#define PG8_SB(b, h) ((4 + (b) * 2 + (h)) * HTB)
#define PG8_STAGE(bufoff, gbase, voff) do { _Pragma("unroll") for (int _i = 0; _i < 2; ++_i) \
        __builtin_amdgcn_global_load_lds((const unsigned*)((const char*)(gbase) + (voff)[_i]), (PG8_LAS unsigned*)(lds + (bufoff) + ldsw + _i * 8192), 16, 0, 0); } while (0)
#define PG8_LDA(dst, b, h) do { _Pragma("unroll") for (int m = 0; m < 4; ++m) _Pragma("unroll") for (int k = 0; k < 2; ++k) dst[m][k] = *(const PG8_LAS bf16x8*)(lds + PG8_SA(b, h) + aoff + m * 2048 + k * 1024); } while (0)
#define PG8_LDB(dst, b, h) do { _Pragma("unroll") for (int n = 0; n < 2; ++n) _Pragma("unroll") for (int k = 0; k < 2; ++k) dst[n][k] = *(const PG8_LAS bf16x8*)(lds + PG8_SB(b, h) + boff + n * 2048 + k * 1024); } while (0)
#define PG8_MMA(ai, bj, At, Bt) do { __builtin_amdgcn_s_setprio(1); _Pragma("unroll") for (int m = 0; m < 4; ++m) _Pragma("unroll") for (int n = 0; n < 2; ++n) _Pragma("unroll") for (int k = 0; k < 2; ++k) \
        acc[ai][bj][m][n] = __builtin_amdgcn_mfma_f32_16x16x32_bf16(Bt[n][k], At[m][k], acc[ai][bj][m][n], 0, 0, 0); __builtin_amdgcn_s_setprio(0); } while (0)
#define PG8_BAR __builtin_amdgcn_s_barrier()
#define PG8_SCHED __builtin_amdgcn_sched_barrier(0)
    Unit cur, nxt; int ui = 0;
    if (!S.next(0, cur)) return;
    f32x4 acc[2][2][4][2];
#pragma unroll
    for (int a = 0; a < 2; ++a)
#pragma unroll
        for (int b = 0; b < 2; ++b)
#pragma unroll
            for (int m = 0; m < 4; ++m)
#pragma unroll
                for (int n = 0; n < 2; ++n) acc[a][b][m][n] = (f32x4){0.f, 0.f, 0.f, 0.f};
    bf16x8 At[4][2], B0[2][2], B1[2][2];
    const char* cA = (const char*)g.A + (size_t)cur.pm * tstep; const char* cB = (const char*)g.Bt + (size_t)cur.pn * tstep;
    S.a_ready(cur);
    if constexpr (SP2) {
        PG8_STAGE(PG8_SB(0, 0), cB, voffB); PG8_STAGE(PG8_SB(0, 1), cB + hstep, voffB); PG8_STAGE(PG8_SA(0, 0), cA, voffA); PG8_STAGE(PG8_SA(0, 1), cA + hstep, voffA);
        if (wr == 1) PG8_BAR;
        PG8_WAIT_V(2); PG8_BAR;
        PG8_STAGE(PG8_SB(1, 0), cB + kstep, voffB); PG8_STAGE(PG8_SA(1, 0), cA + kstep, voffA); PG8_STAGE(PG8_SB(1, 1), cB + hstep + kstep, voffB);
        PG8_WAIT_V(6); PG8_BAR;
    } else {
        PG8_STAGE(PG8_SB(0, 0), cB, voffB); PG8_STAGE(PG8_SA(0, 0), cA, voffA); PG8_STAGE(PG8_SB(0, 1), cB + hstep, voffB); PG8_STAGE(PG8_SA(0, 1), cA + hstep, voffA);
        if (wr == 1) PG8_BAR;
        PG8_WAIT_V(4); PG8_BAR;
        PG8_STAGE(PG8_SB(1, 0), cB + kstep, voffB); PG8_STAGE(PG8_SA(1, 0), cA + kstep, voffA); PG8_STAGE(PG8_SB(1, 1), cB + hstep + kstep, voffB);
        PG8_WAIT_V(6); PG8_BAR;
    }
    for (;;) {
        const bool has_next = S.next(ui + 1, nxt);
        const char* nA = has_next ? (const char*)g.A + (size_t)nxt.pm * tstep : cA; const char* nB = has_next ? (const char*)g.Bt + (size_t)nxt.pn * tstep : cB;
        for (int t = 0; t < nt; t += 2) {
            const bool last = (t == nt - 2);
            const char* a1 = cA + (size_t)(t + 1) * kstep;
            const char* a2 = last ? nA : cA + (size_t)(t + 2) * kstep; const char* b2 = last ? nB : cB + (size_t)(t + 2) * kstep;
            const char* a3 = a2 + kstep; const char* b3 = b2 + kstep;
            if (last && has_next) S.a_ready(nxt);
            if constexpr (SP2) {
            PG8_LDB(B0, 0, 0); PG8_LDB(B1, 0, 1); PG8_SCHED; PG8_LDA(At, 0, 0); PG8_STAGE(PG8_SA(1, 1), a1 + hstep, voffA);
            PG8_WAIT_V(8); PG8_WAIT_L(0); PG8_BAR; PG8_MMA(0, 0, At, B0); PG8_MMA(0, 1, At, B1); PG8_BAR; PG8_SCHED;
            PG8_LDA(At, 0, 1); PG8_STAGE(PG8_SB(0, 0), b2, voffB); PG8_STAGE(PG8_SB(0, 1), b2 + hstep, voffB); PG8_STAGE(PG8_SA(0, 0), a2, voffA);
            PG8_WAIT_V(8); PG8_WAIT_L(0); PG8_BAR; PG8_MMA(1, 0, At, B0); PG8_MMA(1, 1, At, B1); PG8_BAR; PG8_SCHED;
            PG8_LDB(B0, 1, 0); PG8_LDB(B1, 1, 1); PG8_SCHED; PG8_LDA(At, 1, 0); PG8_STAGE(PG8_SA(0, 1), a2 + hstep, voffA);
            PG8_WAIT_V(8); PG8_WAIT_L(0); PG8_BAR; PG8_MMA(0, 0, At, B0); PG8_MMA(0, 1, At, B1); PG8_BAR; PG8_SCHED;
            PG8_LDA(At, 1, 1); PG8_STAGE(PG8_SB(1, 0), b3, voffB); PG8_STAGE(PG8_SB(1, 1), b3 + hstep, voffB); PG8_STAGE(PG8_SA(1, 0), a3, voffA);
            PG8_WAIT_V(8); PG8_WAIT_L(0); PG8_BAR; PG8_MMA(1, 0, At, B0); PG8_MMA(1, 1, At, B1); PG8_BAR; PG8_SCHED;
            } else {
            PG8_LDB(B0, 0, 0); PG8_SCHED; PG8_LDA(At, 0, 0); PG8_STAGE(PG8_SA(1, 1), a1 + hstep, voffA);
            PG8_WAIT_L(8); PG8_BAR; PG8_WAIT_L(0); PG8_MMA(0, 0, At, B0); PG8_BAR; PG8_SCHED;
            PG8_LDB(B1, 0, 1); PG8_STAGE(PG8_SB(0, 0), b2, voffB);
            PG8_BAR; PG8_WAIT_L(0); PG8_MMA(0, 1, At, B1); PG8_BAR;
            PG8_LDA(At, 0, 1); PG8_STAGE(PG8_SA(0, 0), a2, voffA);
            PG8_BAR; PG8_WAIT_L(0); PG8_MMA(1, 0, At, B0); PG8_BAR; PG8_SCHED;
            PG8_STAGE(PG8_SB(0, 1), b2 + hstep, voffB);
            PG8_WAIT_V(6); PG8_BAR; PG8_MMA(1, 1, At, B1); PG8_BAR;
            PG8_LDB(B0, 1, 0); PG8_SCHED; PG8_LDA(At, 1, 0); PG8_STAGE(PG8_SA(0, 1), a2 + hstep, voffA);
            PG8_WAIT_L(8); PG8_BAR; PG8_WAIT_L(0); PG8_MMA(0, 0, At, B0); PG8_BAR; PG8_SCHED;
            PG8_LDB(B1, 1, 1); PG8_STAGE(PG8_SB(1, 0), b3, voffB);
            PG8_BAR; PG8_WAIT_L(0); PG8_MMA(0, 1, At, B1); PG8_BAR;
            PG8_LDA(At, 1, 1); PG8_STAGE(PG8_SA(1, 0), a3, voffA);
            PG8_BAR; PG8_WAIT_L(0); PG8_MMA(1, 0, At, B0); PG8_BAR; PG8_SCHED;
            PG8_STAGE(PG8_SB(1, 1), b3 + hstep, voffB);
            PG8_WAIT_V(6); PG8_BAR; PG8_MMA(1, 1, At, B1); PG8_BAR;
            }
        }
        if constexpr (ALIGN_EPI) { if (wr == 0) PG8_BAR; }
        E(acc, cur, wr, wc, fr, fq);
        if (!has_next) break;
#pragma unroll
        for (int a = 0; a < 2; ++a)
#pragma unroll
            for (int b = 0; b < 2; ++b)
#pragma unroll
                for (int m = 0; m < 4; ++m)
#pragma unroll
                    for (int n = 0; n < 2; ++n) acc[a][b][m][n] = (f32x4){0.f, 0.f, 0.f, 0.f};
        cur = nxt; cA = nA; cB = nB; ++ui;
        if constexpr (ALIGN_EPI) { if (wr == 1) PG8_BAR; }
    }
    PG8_WAIT_V(0);
    if constexpr (!ALIGN_EPI) { if (wr == 0) PG8_BAR; }
    PG8_BAR;
#undef PG8_SA
#undef PG8_SB
#undef PG8_STAGE
#undef PG8_LDA
#undef PG8_LDB
#undef PG8_MMA
#undef PG8_BAR
#undef PG8_SCHED
}
}

struct Frame {
    unsigned char* lds; PP P; unsigned char* ws; float* out;
    int tid, lane, wave, G, bx;
};
DEV int tok_cond(int t) { return t < TC ? 0 : 1 + (t - TC) / DSEQ; }

DEV int hperm(int p) { const int bj = p >> 7, wc = (p >> 5) & 3, c5 = p & 31; return wc * 64 + 32 * bj + 16 * ((c5 >> 2) & 1) + 4 * (c5 >> 3) + (c5 & 3); }
DEV int win_src_col(int r) {
    if (r < 512) return (r & ~255) + hperm(r & 255);
    if (r < 1536) return r;
    if (r < 3840) return r + 16;
    if (r < 3856) return 1536 + (r - 3840);
    if (r < 4096) return -1;
    return r - 240;
}
DEV void transpose_item(const float* W, int ldw, int srccol, bf16* WT, int ldt, int drow0, int k0, float* scr, int lane) {
#pragma unroll 8
    for (int i = 0; i < 32; ++i) { const int kk = 2 * i + (lane >> 5); scr[kk * 33 + (lane & 31)] = srccol >= 0 ? W[(size_t)(k0 + kk) * ldw + srccol] : 0.f; }
    WAVE_SYNC();
    const int c = lane & 7;
#pragma unroll
    for (int j = 0; j < 4; ++j) { const int n = (lane >> 3) + 8 * j; const float* s = scr + (8 * c) * 33 + n;
        u32x4 o; o.x = pk2(s[0 * 33], s[1 * 33]); o.y = pk2(s[2 * 33], s[3 * 33]); o.z = pk2(s[4 * 33], s[5 * 33]); o.w = pk2(s[6 * 33], s[7 * 33]);
        *(u32x4*)(WT + (size_t)(drow0 + n) * ldt + k0 + 8 * c) = o; }
    WAVE_SYNC();
}
DEV void convert_weights(Frame& F, int l) {
    float* scr = (float*)(F.lds + F.wave * 8448);
    const int gw = F.bx * 8 + F.wave, NGW = F.G * 8;
    const float* w_in = F.P->in[13] + (size_t)l * D * INW;
    const float* w_br = F.P->in[22] + (size_t)l * 4 * 256 * D;
    const float* w_out = F.P->in[23] + (size_t)l * D * D;
    bf16* WIN = (bf16*)(F.ws + WS_WIN); bf16* WBR = (bf16*)(F.ws + WS_WBR); bf16* WOUT = (bf16*)(F.ws + WS_WOUT);
    constexpr int I_IN = 16 * (NPERM / 32), I_BR = 4 * 4 * (D / 32), I_OUT = 16 * (D / 32);
    for (int it = gw; it < I_IN + I_BR + I_OUT; it += NGW) {
        int r = it;
        if (r < I_IN) { const int kb = r / (NPERM / 32), nb = r % (NPERM / 32); transpose_item(w_in, INW, win_src_col(nb * 32 + (F.lane & 31)), WIN, D, nb * 32, kb * 64, scr, F.lane); continue; }
        r -= I_IN;
        if (r < I_BR) { const int n = r / (4 * (D / 32)), q = r % (4 * (D / 32)), kb = q / (D / 32), nb = q % (D / 32);
            transpose_item(w_br + (size_t)n * 256 * D, D, nb * 32 + (F.lane & 31), WBR + (size_t)n * D * 256, 256, nb * 32, kb * 64, scr, F.lane); continue; }
        r -= I_BR;
        { const int kb = r / (D / 32), nb = r % (D / 32); transpose_item(w_out, D, nb * 32 + (F.lane & 31), WOUT, D, nb * 32, kb * 64, scr, F.lane); }
    }
}
DEV void p0_prologue(Frame& F) {
    float* red = (float*)F.lds;
    float* MODT = (float*)(F.ws + WS_MODT);
    for (int it = F.bx; it < DEPTH * 48; it += F.G) {
        const int l = it / 48, c0 = (it % 48) * 64;
        const float* wa = F.P->in[10] + (size_t)l * D * 3072;
        float acc[NCOND];
#pragma unroll
        for (int j = 0; j < NCOND; ++j) acc[j] = 0.f;
        for (int k = F.wave * 128; k < F.wave * 128 + 128; ++k) {
            const float wv = wa[(size_t)k * 3072 + c0 + F.lane];
            acc[0] += silu_f(F.P->in[9][k]) * wv;
#pragma unroll
            for (int j = 1; j < NCOND; ++j) acc[j] += silu_f(F.P->in[8][(size_t)(j - 1) * D + k]) * wv;
        }
#pragma unroll
        for (int j = 0; j < NCOND; ++j) red[(F.wave * NCOND + j) * 64 + F.lane] = acc[j];
        __syncthreads();
        for (int e = F.tid; e < NCOND * 64; e += 512) { const int j = e >> 6, ln = e & 63; float s = F.P->in[11][(size_t)l * 3072 + c0 + ln];
            for (int w = 0; w < 8; ++w) s += red[(w * NCOND + j) * 64 + ln];
            MODT[((size_t)l * NCOND + j) * 3072 + c0 + ln] = s; }
        __syncthreads();
    }
    if (F.bx == F.G - 1) {
        float* RC = (float*)(F.ws + WS_ROPE); float* RS = RC + 1024;
        for (int e = F.tid; e < 1024; e += 512) { const int pos = e >> 4, i = e & 15; const float inv = powf(10000.0f, -(float)i / 16.0f); const float ang = (float)pos * inv; RC[e] = cosf(ang); RS[e] = sinf(ang); }
    }
    __syncthreads();
    convert_weights(F, 0);
    const size_t gt = (size_t)F.bx * 512 + F.tid, NT = (size_t)F.G * 512;
    { bf16* KAC = (bf16*)(F.ws + WS_KAC); bf16* VACT = (bf16*)(F.ws + WS_VACT);
      const size_t n = (size_t)DEPTH * DB * 2 * PAST * 64;
      for (size_t e = gt; e < n; e += NT) { const int d = e & 63; size_t q = e >> 6; const int s = q % PAST; q /= PAST; const int h = q % 2; q /= 2; const int b = q % DB; const int l = q / DB;
          KAC[e] = (bf16)f2bf(F.P->in[2][((((size_t)b * DEPTH + l) * PAST + s) * 2 + h) * 64 + d]); }
      for (size_t e = gt; e < n; e += NT) { const int s = e % PAST; size_t q = e / PAST; const int d = q & 63; q >>= 6; const int h = q % 2; q /= 2; const int b = q % DB; const int l = q / DB;
          VACT[e] = (bf16)f2bf(F.P->in[3][((((size_t)b * DEPTH + l) * PAST + s) * 2 + h) * 64 + d]); } }
    { bf16* NKC = (bf16*)(F.ws + WS_NKC); bf16* NVCT = (bf16*)(F.ws + WS_NVCT);
      const size_t n = (size_t)DEPTH * DB * 4 * PAST * 64;
      for (size_t e = gt; e < n; e += NT) { const int d = e & 63; size_t q = e >> 6; const int s = q % PAST; q /= PAST; const int h = q % 4; q /= 4; const int b = q % DB; const int l = q / DB;
          NKC[e] = (bf16)f2bf(F.P->in[4][((((size_t)b * DEPTH + l) * PAST + s) * 4 + h) * 64 + d]); }
      for (size_t e = gt; e < n; e += NT) { const int s = e % PAST; size_t q = e / PAST; const int d = q & 63; q >>= 6; const int h = q % 4; q /= 4; const int b = q % DB; const int l = q / DB;
          NVCT[e] = (bf16)f2bf(F.P->in[5][((((size_t)b * DEPTH + l) * PAST + s) * 4 + h) * 64 + d]); } }
}

DEV void p1_norm(Frame& F, int l) {
    const float* MODT = (const float*)(F.ws + WS_MODT) + (size_t)l * NCOND * 3072;
    const float* ng = F.P->in[12] + (size_t)l * D;
    bf16* HN = (bf16*)(F.ws + WS_HN);
    const int gw = F.bx * 8 + F.wave, NGW = F.G * 8;
    for (int t = gw; t < T; t += NGW) {
        const float* xrow = (l == 0) ? (t < TC ? F.P->in[0] + (size_t)t * D : F.P->in[1] + (size_t)(t - TC) * D) : F.out + (size_t)t * D;
        const float* md = MODT + (size_t)tok_cond(t) * 3072;
        f32x4 v[4]; float s = 0.f;
#pragma unroll
        for (int j = 0; j < 4; ++j) { v[j] = *(const f32x4*)(xrow + 4 * F.lane + 256 * j); s += (v[j].x * v[j].x + v[j].y * v[j].y) + (v[j].z * v[j].z + v[j].w * v[j].w); }
        const float rstd = 1.0f / sqrtf(wave_sum(s, F.lane) * (1.0f / D) + EPS);
#pragma unroll
        for (int j = 0; j < 4; ++j) { const int c = 4 * F.lane + 256 * j;
            const f32x4 g = *(const f32x4*)(ng + c), sh = *(const f32x4*)(md + c), sc = *(const f32x4*)(md + 1024 + c);
            const f32x4 o = v[j] * rstd * g * (sc + 1.0f) + sh;
            u32x2 w; w.x = pk2(o.x, o.y); w.y = pk2(o.z, o.w); *(u32x2*)(HN + (size_t)t * D + c) = w; }
    }
}

struct EpiIn {
    static constexpr bool PERM = true;
    unsigned char* ws; float* out; const float* qn; const float* kn; const float* alog_; const float* dtb_; int l;
    DEV void operator()(const f32x4 (&acc)[2][2][4][2], const pg8::Unit& u, int wr, int wc, int fr, int fq) const {
        OPAQUE(fr); OPAQUE(fq);
        const int t0 = u.pm * 256; const bool ctx = t0 < TC;
        const int b = ctx ? t0 / SEQ : (t0 - TC) / DSEQ, sb = ctx ? t0 % SEQ : (t0 - TC) % DSEQ, L = ctx ? SEQ : DSEQ;
        const int rl0 = wr * 64 + fr;
        const int pn = u.pn;
        auto plain = [&](bf16* base, int ld, int coloff, int act, float scale) {
#pragma unroll
            for (int ai = 0; ai < 2; ++ai)
#pragma unroll
                for (int m = 0; m < 4; ++m) { const int t = t0 + rl0 + ai * 128 + m * 16; bf16* rowp = base + (size_t)t * ld + coloff + wc * 32 + 8 * fq;
#pragma unroll
                    for (int bj = 0; bj < 2; ++bj) { f32x4 v0 = acc[ai][bj][m][0], v1 = acc[ai][bj][m][1];
                        if (act == 1) { v0.x = silu_f(v0.x); v0.y = silu_f(v0.y); v0.z = silu_f(v0.z); v0.w = silu_f(v0.w); v1.x = silu_f(v1.x); v1.y = silu_f(v1.y); v1.z = silu_f(v1.z); v1.w = silu_f(v1.w); }
                        v0 = v0 * scale; v1 = v1 * scale;
                        u32x4 w; w.x = pk2(v0.x, v0.y); w.y = pk2(v0.z, v0.w); w.z = pk2(v1.x, v1.y); w.w = pk2(v1.z, v1.w);
                        *(u32x4*)(rowp + bj * 128) = w; } CFENCE(); }
        };
        if (pn == 0 || pn == 1) {
            const bool isq = (pn == 0), isv = (pn == 1 && wc >= 2);
            const float* gn = isq ? qn : kn;
            const float* RC = (const float*)(ws + WS_ROPE); const float* RS = RC + 1024;
#pragma unroll
            for (int ai = 0; ai < 2; ++ai)
#pragma unroll
                for (int m = 0; m < 4; ++m) {
                    const int rl = rl0 + ai * 128 + m * 16, t = t0 + rl, s = sb + rl;
                    f32x4 x[2][2];
#pragma unroll
                    for (int bj = 0; bj < 2; ++bj)
#pragma unroll
                        for (int n = 0; n < 2; ++n) x[bj][n] = acc[ai][bj][m][n];
                    if (!isv) {
                        float ss = 0.f;
#pragma unroll
                        for (int bj = 0; bj < 2; ++bj)
#pragma unroll
                            for (int n = 0; n < 2; ++n) ss += (x[bj][n].x * x[bj][n].x + x[bj][n].y * x[bj][n].y) + (x[bj][n].z * x[bj][n].z + x[bj][n].w * x[bj][n].w);
                        ss += shx(ss, 16, fr + 16 * fq); ss += shx(ss, 32, fr + 16 * fq);
                        const float rstd = 1.0f / sqrtf(ss * (1.0f / 64.0f) + EPS);
#pragma unroll
                        for (int bj = 0; bj < 2; ++bj)
#pragma unroll
                            for (int n = 0; n < 2; ++n) { const f32x4 g = *(const f32x4*)(gn + 32 * bj + 16 * n + 4 * fq); x[bj][n] = x[bj][n] * rstd * g; }
                    }
                    if (pn == 1 && ctx) {
                        float* dst = out + (wc < 2 ? O_AK : O_AV) + (((size_t)b * DEPTH + l) * SEQ + s) * 128 + (wc & 1) * 64;
#pragma unroll
                        for (int bj = 0; bj < 2; ++bj)
#pragma unroll
                            for (int n = 0; n < 2; ++n) *(f32x4*)(dst + 32 * bj + 16 * n + 4 * fq) = x[bj][n];
                    }
                    if (!isv && !ctx) {
#pragma unroll
                        for (int bj = 0; bj < 2; ++bj) { const int pos = bj == 0 ? (s >> 6) : (s & 63);
                            const f32x4 cs = *(const f32x4*)(RC + pos * 16 + 4 * fq), sn = *(const f32x4*)(RS + pos * 16 + 4 * fq);
                            const f32x4 x1 = x[bj][0], x2 = x[bj][1];
                            x[bj][0] = x1 * cs - x2 * sn; x[bj][1] = x2 * cs + x1 * sn; }
                    }
                    if (isq) {
                        bf16* dst = (bf16*)(ws + WS_QA) + (size_t)t * 256 + wc * 64;
#pragma unroll
                        for (int bj = 0; bj < 2; ++bj)
#pragma unroll
                            for (int n = 0; n < 2; ++n) { const f32x4 v = x[bj][n] * 0.125f; u32x2 w; w.x = pk2(v.x, v.y); w.y = pk2(v.z, v.w); *(u32x2*)(dst + 32 * bj + 16 * n + 4 * fq) = w; }
                    } else if (!isv) {
                        bf16* dst = (bf16*)(ws + WS_KA) + (ctx ? (size_t)0 : (size_t)TC * 128) + (((size_t)b * 2 + wc) * L + s) * 64;
#pragma unroll
                        for (int bj = 0; bj < 2; ++bj)
#pragma unroll
                            for (int n = 0; n < 2; ++n) { const f32x4 v = x[bj][n]; u32x2 w; w.x = pk2(v.x, v.y); w.y = pk2(v.z, v.w); *(u32x2*)(dst + 32 * bj + 16 * n + 4 * fq) = w; }
                    } else {
                        bf16* dst = (bf16*)(ws + WS_VAT) + (ctx ? (size_t)0 : (size_t)TC * 128) + ((size_t)b * 2 + (wc - 2)) * 64 * L + s;
#pragma unroll
                        for (int bj = 0; bj < 2; ++bj)
#pragma unroll
                            for (int n = 0; n < 2; ++n) { const int d0 = 32 * bj + 16 * n + 4 * fq;
                                dst[(size_t)(d0 + 0) * L] = (bf16)f2bf(x[bj][n].x); dst[(size_t)(d0 + 1) * L] = (bf16)f2bf(x[bj][n].y);
                                dst[(size_t)(d0 + 2) * L] = (bf16)f2bf(x[bj][n].z); dst[(size_t)(d0 + 3) * L] = (bf16)f2bf(x[bj][n].w); }
                    }
                    CFENCE();
                }
        } else if (pn == 2) plain((bf16*)(ws + WS_AZ), 256, 0, 1, 1.f);
        else if (pn >= 3 && pn <= 5) plain((bf16*)(ws + WS_GQKV), 768, (pn - 3) * 256, 0, 1.f);
        else if (pn == 6) plain((bf16*)(ws + WS_GZ), 256, 0, 1, 1.f);
        else if (pn >= 7 && pn <= 9) plain((bf16*)(ws + WS_RQKV), 768, (pn - 7) * 256, 0, pn == 7 ? 0.125f : 1.f);
        else if (pn == 10) plain((bf16*)(ws + WS_RZ), 256, 0, 1, 1.f);
        else if (pn == 11) plain((bf16*)(ws + WS_NQ), 256, 0, 0, 0.125f);
        else if (pn == 12 || pn == 13) {
            const bool isk = pn == 12;
#pragma unroll
            for (int ai = 0; ai < 2; ++ai)
#pragma unroll
                for (int m = 0; m < 4; ++m) { const int rl = rl0 + ai * 128 + m * 16, s = sb + rl;
#pragma unroll
                    for (int bj = 0; bj < 2; ++bj) { const int head = 2 * bj + (wc >> 1), d0 = 32 * (wc & 1) + 8 * fq;
                        const f32x4 v0 = acc[ai][bj][m][0], v1 = acc[ai][bj][m][1];
                        if (ctx) { float* dst = out + (isk ? O_NK : O_NV) + (((size_t)b * DEPTH + l) * SEQ + s) * 256 + head * 64 + d0; *(f32x4*)dst = v0; *(f32x4*)(dst + 4) = v1; }
                        if (isk) { bf16* dst = (bf16*)(ws + WS_NK) + (ctx ? (size_t)0 : (size_t)TC * 256) + (((size_t)b * 4 + head) * L + s) * 64 + d0;
                            u32x4 w; w.x = pk2(v0.x, v0.y); w.y = pk2(v0.z, v0.w); w.z = pk2(v1.x, v1.y); w.w = pk2(v1.z, v1.w); *(u32x4*)dst = w; }
                        else { bf16* dst = (bf16*)(ws + WS_NVT) + (ctx ? (size_t)0 : (size_t)TC * 256) + (((size_t)b * 4 + head) * 64 + d0) * L + s;
                            dst[0] = (bf16)f2bf(v0.x); dst[(size_t)L] = (bf16)f2bf(v0.y); dst[(size_t)2 * L] = (bf16)f2bf(v0.z); dst[(size_t)3 * L] = (bf16)f2bf(v0.w);
                            dst[(size_t)4 * L] = (bf16)f2bf(v1.x); dst[(size_t)5 * L] = (bf16)f2bf(v1.y); dst[(size_t)6 * L] = (bf16)f2bf(v1.z); dst[(size_t)7 * L] = (bf16)f2bf(v1.w); } } CFENCE(); }
        } else if (pn == 14) plain((bf16*)(ws + WS_NZ), 256, 0, 1, 1.f);
        else {
            if (wc == 0 && fq < 2) {
                const float* alog = alog_; const float* dtb = dtb_;
                float* GAB = (float*)(ws + WS_GAB);
#pragma unroll
                for (int ai = 0; ai < 2; ++ai)
#pragma unroll
                    for (int m = 0; m < 4; ++m) { const int t = t0 + rl0 + ai * 128 + m * 16;
#pragma unroll
                        for (int n = 0; n < 2; ++n) { const int c = 8 * fq + 4 * n; const f32x4 v = acc[ai][0][m][n]; f32x4 o;
                            if (c < 8) { o.x = sigmoid_f(v.x); o.y = sigmoid_f(v.y); o.z = sigmoid_f(v.z); o.w = sigmoid_f(v.w); }
                            else { const int dir = (c >> 2) - 2;
                                o.x = -__expf(alog[dir * 4 + 0]) * softplus_f(v.x + dtb[dir * 4 + 0]); o.y = -__expf(alog[dir * 4 + 1]) * softplus_f(v.y + dtb[dir * 4 + 1]);
                                o.z = -__expf(alog[dir * 4 + 2]) * softplus_f(v.z + dtb[dir * 4 + 2]); o.w = -__expf(alog[dir * 4 + 3]) * softplus_f(v.w + dtb[dir * 4 + 3]); }
                            *(f32x4*)(GAB + (size_t)t * 16 + c) = o; } CFENCE(); }
            }
        }
    }
};

DEV f32x4 mfma4(float a, float b, f32x4 c) { return __builtin_amdgcn_mfma_f32_16x16x4f32(a, b, c, 0, 0, 0); }
constexpr int LS = 65;

DEV void gdn_prep_task(Frame& F, int l, int chunk) {
    constexpr int PS = 68;
    const int head = F.wave >> 1, dir = F.wave & 1, lane = F.lane, li = lane & 15, lq = lane >> 4;
    float* Kw = (float*)F.lds + (size_t)F.wave * (64 * PS);
    float* gs = (float*)F.lds + 8 * (64 * PS) + F.wave * 128;
    float* bs = gs + 64;
    const int t0 = chunk * 64; const bool ctx = t0 < TC;
    const int L = ctx ? SEQ : DSEQ, s0 = ctx ? t0 % SEQ : (t0 - TC) % DSEQ, tseq = t0 - s0;
    const bf16* G = (const bf16*)(F.ws + WS_GQKV);
    const float* cw = F.P->in[14] + (size_t)l * 5 * 768 + 256 + head * 64 + lane;
    float w5[5];
#pragma unroll
    for (int j = 0; j < 5; ++j) w5[j] = cw[j * 768];
    for (int i = 0; i < 64; ++i) {
        const int s = s0 + (dir ? 63 - i : i); float y = 0.f;
#pragma unroll
        for (int j = 0; j < 5; ++j) { const int sp = s + j - 2; if (sp >= 0 && sp < L) y += bf2f(G[(size_t)(tseq + sp) * 768 + 256 + head * 64 + lane]) * w5[j]; }
        y = silu_f(y);
        const float ss = wave_sum(y * y, lane);
        Kw[i * PS + lane] = y / sqrtf(ss + EPS);
    }
    { const int s = s0 + (dir ? 63 - lane : lane); const float* ga = (const float*)(F.ws + WS_GAB) + (size_t)(tseq + s) * 16;
      float g = ga[8 + dir * 4 + head];
#pragma unroll
      for (int o = 1; o < 64; o <<= 1) { const float v = shf(g, lane >= o ? lane - o : lane); if (lane >= o) g += v; }
      gs[lane] = g; bs[lane] = ga[dir * 4 + head]; }
    WAVE_SYNC();
#pragma unroll
    for (int ti = 3; ti >= 0; --ti) {
        f32x4 at[4];
#pragma unroll
        for (int tj = 0; tj < 4; ++tj) { if (tj <= ti) { f32x4 c = {0.f, 0.f, 0.f, 0.f};
#pragma unroll 4
            for (int ks = 0; ks < 16; ++ks) c = mfma4(Kw[(16 * ti + li) * PS + 4 * ks + lq], Kw[(16 * tj + li) * PS + 4 * ks + lq], c);
            at[tj] = c; } }
        WAVE_SYNC();
#pragma unroll
        for (int tj = 0; tj < 4; ++tj) { if (tj <= ti) {
#pragma unroll
            for (int r = 0; r < 4; ++r) { const int i = 16 * ti + 4 * lq + r, j = 16 * tj + li;
                Kw[i * PS + j] = (i > j) ? at[tj][r] * bs[i] * __expf(gs[i] - gs[j]) : 0.f; } } }
        CFENCE();
    }
    WAVE_SYNC();
    float* TM = (float*)(F.ws + WS_TMAT) + ((size_t)chunk * 8 + F.wave) * 4096;
    {
        int cc = li; OPAQUE(cc);
        float* Ab = Kw + (16 * lq) * PS + 16 * lq;
        float x[16];
#pragma unroll
        for (int r = 0; r < 16; ++r) {
            float a0 = (r == cc) ? 1.f : 0.f, a1 = 0.f;
#pragma unroll
            for (int j4 = 0; j4 < (r + 3) / 4; ++j4) { const f32x4 a = *(const f32x4*)(Ab + r * PS + 4 * j4);
                if (4 * j4 + 0 < r) a0 -= a.x * x[4 * j4 + 0];
                if (4 * j4 + 1 < r) a1 -= a.y * x[4 * j4 + 1];
                if (4 * j4 + 2 < r) a0 -= a.z * x[4 * j4 + 2];
                if (4 * j4 + 3 < r) a1 -= a.w * x[4 * j4 + 3]; }
            x[r] = a0 + a1;
        }
        WAVE_SYNC();
#pragma unroll
        for (int r = 0; r < 16; ++r) { Ab[r * PS + li] = x[r]; TM[(16 * lq + r) * 64 + 16 * lq + li] = x[r]; }
    }
    WAVE_SYNC();
#pragma unroll
    for (int i = 1; i < 4; ++i)
#pragma unroll
        for (int j = 0; j < 4; ++j) { if (j < i) {
            f32x4 M = {0.f, 0.f, 0.f, 0.f};
#pragma unroll
            for (int k = 0; k < 4; ++k) { if (k >= j && k < i) {
#pragma unroll
                for (int ks = 0; ks < 4; ++ks) { const float av = Kw[(16 * i + li) * PS + 16 * k + 4 * ks + lq];
                    const float bv = (k == j) ? Kw[(16 * j + 4 * ks + lq) * PS + 16 * j + li] : Kw[(16 * j + li) * PS + 16 * k + 4 * ks + lq];
                    M = mfma4(av, bv, M); } } }
            f32x4 X = {0.f, 0.f, 0.f, 0.f};
#pragma unroll
            for (int r = 0; r < 4; ++r) X = mfma4(Kw[(16 * i + li) * PS + 16 * i + 4 * lq + r], M[r], X);
#pragma unroll
            for (int r = 0; r < 4; ++r) { Kw[(16 * j + li) * PS + 16 * i + 4 * lq + r] = -X[r]; TM[(16 * i + 4 * lq + r) * 64 + 16 * j + li] = -X[r];
                TM[(16 * j + 4 * lq + r) * 64 + 16 * i + li] = 0.f; }
            WAVE_SYNC();
        } }
    WAVE_SYNC();
}

struct AttnArgs { const bf16* kA; const bf16* vA; int skA, svA, ldA, nA; const bf16* kB; const bf16* vB; int ldB, nB; const float* bias; int bs, qc0, r, rs; };
template <bool NA>
DEV void attn_wave(const bf16* q  , const AttnArgs& A, bf16* gate_io  , int lane) {
    const int li = lane & 15, lq = lane >> 4;
    bf16x8 qf[2];
    qf[0] = *(const bf16x8*)(q + 8 * lq); qf[1] = *(const bf16x8*)(q + 32 + 8 * lq);
    f32x4 o[4];
#pragma unroll
    for (int dt = 0; dt < 4; ++dt) o[dt] = (f32x4){0.f, 0.f, 0.f, 0.f};
    float m_run = -1e30f, l_part = 0.f;
    const int nblk = A.nA + A.nB;
    for (int blk = 0; blk < nblk; ++blk) {
        const bool inA = blk < A.nA;
        const bf16* kb = inA ? A.kA + (size_t)blk * A.skA : A.kB + (size_t)(blk - A.nA) * 2048;
        const bf16* vb = inA ? A.vA + (size_t)blk * A.svA : A.vB + (size_t)(blk - A.nA) * 32;
        const int ld = inA ? A.ldA : A.ldB;
        f32x4 st[2];
#pragma unroll
        for (int kt = 0; kt < 2; ++kt) { st[kt] = (f32x4){0.f, 0.f, 0.f, 0.f};
#pragma unroll
            for (int ks = 0; ks < 2; ++ks) { const bf16x8 kf = *(const bf16x8*)(kb + (size_t)(16 * kt + li) * 64 + 32 * ks + 8 * lq);
                st[kt] = __builtin_amdgcn_mfma_f32_16x16x32_bf16(kf, qf[ks], st[kt], 0, 0, 0); } }
        if (NA && inA) {
            const int qc = A.qc0 + li, cs = qc - 8 < 0 ? 0 : (qc - 8 > 48 ? 48 : qc - 8), dr = A.rs + blk - A.r + 7;
#pragma unroll
            for (int kt = 0; kt < 2; ++kt)
#pragma unroll
                for (int r = 0; r < 4; ++r) { const int kc = A.bs + 16 * kt + 4 * lq + r; int dc = kc - qc + 15; dc = dc < 0 ? 0 : (dc > 30 ? 30 : dc);
                    const bool ok = kc >= cs && kc < cs + 16;
                    st[kt][r] = ok ? st[kt][r] + A.bias[dr * 31 + dc] : -1e30f; }
        }
        float mb = fmaxf(fmaxf(fmaxf(st[0].x, st[0].y), fmaxf(st[0].z, st[0].w)), fmaxf(fmaxf(st[1].x, st[1].y), fmaxf(st[1].z, st[1].w)));
        mb = fmaxf(mb, shx(mb, 16, lane)); mb = fmaxf(mb, shx(mb, 32, lane));
        const float m_new = fmaxf(m_run, mb), alpha = __expf(m_run - m_new);
        m_run = m_new;
        float ps = 0.f; float pv[8];
#pragma unroll
        for (int kt = 0; kt < 2; ++kt)
#pragma unroll
            for (int r = 0; r < 4; ++r) { const float p = __expf(st[kt][r] - m_new); pv[kt * 4 + r] = p; ps += p; }
        l_part = l_part * alpha + ps;
        u32x4 pu; pu.x = pk2(pv[0], pv[1]); pu.y = pk2(pv[2], pv[3]); pu.z = pk2(pv[4], pv[5]); pu.w = pk2(pv[6], pv[7]);
        const bf16x8 pf = __builtin_bit_cast(bf16x8, pu);
#pragma unroll
        for (int dt = 0; dt < 4; ++dt) { o[dt] = o[dt] * alpha;
            const bf16* vp = vb + (size_t)(16 * dt + li) * ld + 4 * lq;
            const u32x2 v0 = *(const u32x2*)vp, v1 = *(const u32x2*)(vp + 16);
            u32x4 vu; vu.x = v0.x; vu.y = v0.y; vu.z = v1.x; vu.w = v1.y;
            o[dt] = __builtin_amdgcn_mfma_f32_16x16x32_bf16(__builtin_bit_cast(bf16x8, vu), pf, o[dt], 0, 0, 0); }
    }
    float lsum = l_part; lsum += shx(lsum, 16, lane); lsum += shx(lsum, 32, lane);
    const float inv = 1.0f / lsum;
#pragma unroll
    for (int dt = 0; dt < 4; ++dt) { bf16* gp = gate_io + 16 * dt + 4 * lq; const u32x2 g = *(const u32x2*)gp;
        const float r0 = o[dt].x * inv * bf2f(g.x & 0xffffu), r1 = o[dt].y * inv * bf2f(g.x >> 16), r2 = o[dt].z * inv * bf2f(g.y & 0xffffu), r3 = o[dt].w * inv * bf2f(g.y >> 16);
        u32x2 w; w.x = pk2(r0, r1); w.y = pk2(r2, r3); *(u32x2*)gp = w; }
}

DEV void attn_unit(Frame& F, int l, int u) {
    const int lane = F.lane, li = lane & 15, w = F.wave;
    const bf16* QA = (const bf16*)(F.ws + WS_QA); const bf16* NQ = (const bf16*)(F.ws + WS_NQ);
    AttnArgs A; A.kB = nullptr; A.vB = nullptr; A.ldB = 0; A.nB = 0; A.bias = nullptr; A.bs = A.qc0 = A.r = A.rs = 0; A.skA = 2048; A.svA = 32;
    if (u < NB * 8) {
        const int b = u / 8, hq = (u % 8) / 2, qb = u % 2, kvh = hq >> 1; const int t = b * SEQ + qb * 128 + w * 16 + li;
        A.kA = (const bf16*)(F.ws + WS_KA) + ((size_t)b * 2 + kvh) * SEQ * 64; A.vA = (const bf16*)(F.ws + WS_VAT) + ((size_t)b * 2 + kvh) * 64 * SEQ; A.ldA = SEQ; A.nA = SEQ / 32;
        attn_wave<false>(QA + (size_t)t * 256 + hq * 64, A, (bf16*)(F.ws + WS_AZ) + (size_t)t * 256 + hq * 64, lane); return; }
    u -= NB * 8;
    if (u < DB * 32) {
        const int b = u / 32, hq = (u % 32) / 8, qb = u % 8, kvh = hq >> 1; const int t = TC + b * DSEQ + qb * 128 + w * 16 + li;
        A.kA = (const bf16*)(F.ws + WS_KA) + (size_t)TC * 128 + ((size_t)b * 2 + kvh) * DSEQ * 64; A.vA = (const bf16*)(F.ws + WS_VAT) + (size_t)TC * 128 + ((size_t)b * 2 + kvh) * 64 * DSEQ; A.ldA = DSEQ; A.nA = DSEQ / 32;
        A.kB = (const bf16*)(F.ws + WS_KAC) + (((size_t)l * DB + b) * 2 + kvh) * PAST * 64; A.vB = (const bf16*)(F.ws + WS_VACT) + (((size_t)l * DB + b) * 2 + kvh) * 64 * PAST; A.ldB = PAST; A.nB = PAST / 32;
        attn_wave<false>(QA + (size_t)t * 256 + hq * 64, A, (bf16*)(F.ws + WS_AZ) + (size_t)t * 256 + hq * 64, lane); return; }
    u -= DB * 32;
    if (u < NB * 8) {
        const int b = u / 8, h = (u % 8) / 2, qb = u % 2; const int t = b * SEQ + qb * 128 + w * 16 + li;
        A.kA = (const bf16*)(F.ws + WS_NK) + ((size_t)b * 4 + h) * SEQ * 64; A.vA = (const bf16*)(F.ws + WS_NVT) + ((size_t)b * 4 + h) * 64 * SEQ; A.ldA = SEQ; A.nA = SEQ / 32;
        attn_wave<false>(NQ + (size_t)t * 256 + h * 64, A, (bf16*)(F.ws + WS_NZ) + (size_t)t * 256 + h * 64, lane); return; }
    u -= NB * 8;
    {
        const int b = u / 32, h = (u % 32) / 8, rp = u % 8; const int r = 2 * rp + (w >> 2), jb = w & 3;
        const int rs = r - 4 < 0 ? 0 : (r - 4 > 8 ? 8 : r - 4); const int bs = jb * 16 - 8 < 0 ? 0 : (jb * 16 - 8 > 32 ? 32 : jb * 16 - 8);
        const int t = TC + b * DSEQ + r * 64 + jb * 16 + li;
        const int tok0 = rs * 64 + bs;
        A.kA = (const bf16*)(F.ws + WS_NK) + (size_t)TC * 256 + (((size_t)b * 4 + h) * DSEQ + tok0) * 64;
        A.vA = (const bf16*)(F.ws + WS_NVT) + (size_t)TC * 256 + ((size_t)b * 4 + h) * 64 * DSEQ + tok0;
        A.skA = 64 * 64; A.svA = 64; A.ldA = DSEQ; A.nA = 8;
        A.kB = (const bf16*)(F.ws + WS_NKC) + (((size_t)l * DB + b) * 4 + h) * PAST * 64; A.vB = (const bf16*)(F.ws + WS_NVCT) + (((size_t)l * DB + b) * 4 + h) * 64 * PAST; A.ldB = PAST; A.nB = PAST / 32;
        A.bias = F.P->in[21] + ((size_t)l * 4 + h) * 15 * 31; A.bs = bs; A.qc0 = jb * 16; A.r = r; A.rs = rs;
        attn_wave<true>(NQ + (size_t)t * 256 + h * 64, A, (bf16*)(F.ws + WS_NZ) + (size_t)t * 256 + h * 64, lane);
    }
}
constexpr int N_ATTN_UNITS = NB * 8 + DB * 32 + NB * 8 + DB * 32;

DEV void chain_task(Frame& F, int l, int task) {
    const int type = task & 1; int q = task >> 1; const int dir = q & 1; q >>= 1; const int head = q & 3; q >>= 2;
    const int seq = q < DB ? NB + q : q - DB;
    const bool ctx = seq < NB; const int L = ctx ? SEQ : DSEQ, nch = L / 64, tseq = ctx ? seq * SEQ : TC + (seq - NB) * DSEQ;
    const int tid = F.tid, lane = F.lane, w = F.wave, li = lane & 15, lq = lane >> 4;
    float* Qs = (float*)F.lds; float* Ks = Qs + 64 * LS; float* Vs = Ks + 64 * LS; float* Ss = Vs + 64 * LS; float* Xs = Ss + 64 * LS; float* Vn = Xs + 64 * LS;
    float* QKs = Vn + 64 * LS;
    bf16* raw = (bf16*)QKs;
    float* gs = QKs + 6528; float* egs = gs + 64; float* bsv = egs + 64;
    const bf16* SRC = (const bf16*)(F.ws + (type == 0 ? WS_GQKV : WS_RQKV));
    { const float* s0 = ctx ? nullptr : ((type == 0 ? F.P->in[6] : F.P->in[7]) + ((((size_t)(seq - NB) * DEPTH + l) * 2 + dir) * 4 + head) * 4096);
      for (int e = tid; e < 4096; e += 512) Ss[(e >> 6) * LS + (e & 63)] = s0 ? s0[e] : 0.f; }
    float lgam = 0.f; if (type == 1) { const float uu = exp2f(-((dir ? 5.5f : 5.0f) + (float)head)); lgam = -uu * (1.f + uu * (0.5f + uu * (1.f / 3.f + uu * (0.25f + uu * (0.2f + uu * (1.f / 6.f)))))); }
    const int tj = w & 3, ti0 = 2 * (w >> 2);
    for (int n = 0; n < nch; ++n) {
        const int c = dir ? nch - 1 - n : n, s0 = c * 64;
        float tA[2][16];
        if (type == 0) { const float* TM = (const float*)(F.ws + WS_TMAT) + (((size_t)(tseq + s0) / 64) * 8 + head * 2 + dir) * 4096;
#pragma unroll
            for (int a = 0; a < 2; ++a)
#pragma unroll
                for (int ks = 0; ks < 16; ++ks) tA[a][ks] = TM[(16 * (ti0 + a) + li) * 64 + 4 * ks + lq]; }
        for (int e = tid; e < 68 * 24; e += 512) { const int rr = e / 24, c8 = e % 24; const int sp = s0 - 2 + rr; u32x4 v = {0u, 0u, 0u, 0u};
            if (sp >= 0 && sp < L) v = *(const u32x4*)(SRC + (size_t)(tseq + sp) * 768 + (c8 >> 3) * 256 + head * 64 + (c8 & 7) * 8);
            *(u32x4*)(raw + rr * 192 + c8 * 8) = v; }
        if (w == 0) {
            float g, be = 1.f;
            if (type == 0) { const int s = s0 + (dir ? 63 - lane : lane); const float* ga = (const float*)(F.ws + WS_GAB) + (size_t)(tseq + s) * 16; g = ga[8 + dir * 4 + head]; be = ga[dir * 4 + head];
#pragma unroll
                for (int o = 1; o < 64; o <<= 1) { const float v = shf(g, lane >= o ? lane - o : lane); if (lane >= o) g += v; } }
            else g = (float)(lane + 1) * lgam;
            gs[lane] = g; egs[lane] = __expf(g); bsv[lane] = be;
        }
        __syncthreads();
        for (int e = tid; e < 64 * 192; e += 512) { const int i = e / 192, ch = e % 192; const int rr = (dir ? 63 - i : i) + 2; float y;
            if (type == 0) { const float* cw = F.P->in[14] + (size_t)l * 5 * 768 + (ch >> 6) * 256 + head * 64 + (ch & 63); y = 0.f;
#pragma unroll
                for (int j = 0; j < 5; ++j) y += bf2f(raw[(rr + j - 2) * 192 + ch]) * cw[j * 768];
                y = silu_f(y); }
            else y = bf2f(raw[rr * 192 + ch]);
            float* dst = ch < 64 ? Qs : (ch < 128 ? Ks : Vs); dst[i * LS + (ch & 63)] = y; }
        __syncthreads();
        if (type == 0) {
            for (int rr = w * 16; rr < w * 16 + 16; ++rr) { float* row = (rr < 64 ? Qs + rr * LS : Ks + (rr - 64) * LS); const float y = row[lane]; const float ss = wave_sum(y * y, lane);
                row[lane] = y / sqrtf(ss + EPS) * (rr < 64 ? 0.125f : 1.f); }
            __syncthreads();
        }
        f32x4 qs[2];
        {
            f32x4 qk[2] = {{0.f, 0.f, 0.f, 0.f}, {0.f, 0.f, 0.f, 0.f}}; qs[0] = qk[0]; qs[1] = qk[0]; f32x4 kS[2] = {qk[0], qk[0]};
#pragma unroll 4
            for (int ks = 0; ks < 16; ++ks) { const int kk = 4 * ks + lq;
                const float bK = Ks[(16 * tj + li) * LS + kk];
                const float bS = Ss[kk * LS + 16 * tj + li];
#pragma unroll
                for (int a = 0; a < 2; ++a) { const int i = 16 * (ti0 + a) + li; const float qa = Qs[i * LS + kk];
                    qk[a] = mfma4(qa, bK, qk[a]); qs[a] = mfma4(qa * egs[i], bS, qs[a]);
                    if (type == 0) kS[a] = mfma4(Ks[i * LS + kk] * egs[i], bS, kS[a]); } }
#pragma unroll
            for (int a = 0; a < 2; ++a)
#pragma unroll
                for (int r = 0; r < 4; ++r) { const int i = 16 * (ti0 + a) + 4 * lq + r, j = 16 * tj + li;
                    QKs[i * LS + j] = (i >= j) ? qk[a][r] * __expf(gs[i] - gs[j]) : 0.f;
                    if (type == 0) Xs[i * LS + j] = bsv[i] * (Vs[i * LS + j] - kS[a][r]); }
        }
        __syncthreads();
        const float* VN = type == 0 ? Vn : Vs;
        if (type == 0) {
            f32x4 vn[2] = {{0.f, 0.f, 0.f, 0.f}, {0.f, 0.f, 0.f, 0.f}};
#pragma unroll
            for (int ks = 0; ks < 16; ++ks) { const float bX = Xs[(4 * ks + lq) * LS + 16 * tj + li];
#pragma unroll
                for (int a = 0; a < 2; ++a) vn[a] = mfma4(tA[a][ks], bX, vn[a]); }
#pragma unroll
            for (int a = 0; a < 2; ++a)
#pragma unroll
                for (int r = 0; r < 4; ++r) Vn[(16 * (ti0 + a) + 4 * lq + r) * LS + 16 * tj + li] = vn[a][r];
            __syncthreads();
        }
        f32x4 sn[2] = {{0.f, 0.f, 0.f, 0.f}, {0.f, 0.f, 0.f, 0.f}};
        {
            const float gl = gs[63];
#pragma unroll 4
            for (int ks = 0; ks < 16; ++ks) { const int cc = 4 * ks + lq; const float bV = VN[cc * LS + 16 * tj + li]; const float kd = __expf(gl - gs[cc]);
#pragma unroll
                for (int a = 0; a < 2; ++a) { const int i = 16 * (ti0 + a) + li;
                    qs[a] = mfma4(QKs[i * LS + cc], bV, qs[a]);
                    sn[a] = mfma4(Ks[cc * LS + i] * kd, bV, sn[a]); } }
            bf16* O = (bf16*)(F.ws + WS_O) + ((size_t)(type * 2 + dir) * T) * 256;
            const float egl = __expf(gl);
#pragma unroll
            for (int a = 0; a < 2; ++a)
#pragma unroll
                for (int r = 0; r < 4; ++r) { const int i = 16 * (ti0 + a) + 4 * lq + r, j = 16 * tj + li; const int s = s0 + (dir ? 63 - i : i);
                    O[(size_t)(tseq + s) * 256 + head * 64 + j] = (bf16)f2bf(qs[a][r]);
                    sn[a][r] += egl * Ss[i * LS + j]; }
        }
        __syncthreads();
#pragma unroll
        for (int a = 0; a < 2; ++a)
#pragma unroll
            for (int r = 0; r < 4; ++r) Ss[(16 * (ti0 + a) + 4 * lq + r) * LS + 16 * tj + li] = sn[a][r];
        __syncthreads();
    }
    if (ctx) { float* dst = F.out + (type == 0 ? O_SG : O_SR) + ((((size_t)seq * DEPTH + l) * 2 + dir) * 4 + head) * 4096;
        for (int e = tid; e < 4096; e += 512) dst[e] = Ss[(e >> 6) * LS + (e & 63)]; }
    __syncthreads();
}
constexpr int N_CHAIN_TASKS = NSEQ * 16;

DEV void p5_finish(Frame& F, int l) {
    const int gw = F.bx * 8 + F.wave, NGW = F.G * 8, lane = F.lane;
    for (int it = gw; it < 2 * T; it += NGW) {
        const int type = it & 1, t = it >> 1;
        const bf16* O0 = (const bf16*)(F.ws + WS_O) + ((size_t)(type * 2) * T + t) * 256 + 4 * lane; const bf16* O1 = O0 + (size_t)T * 256;
        const u32x2 a = *(const u32x2*)O0, b = *(const u32x2*)O1;
        float v0 = bf2f(a.x & 0xffffu) + bf2f(b.x & 0xffffu), v1 = bf2f(a.x >> 16) + bf2f(b.x >> 16), v2 = bf2f(a.y & 0xffffu) + bf2f(b.y & 0xffffu), v3 = bf2f(a.y >> 16) + bf2f(b.y >> 16);
        float ss = (v0 * v0 + v1 * v1) + (v2 * v2 + v3 * v3);
        ss += shx(ss, 1, lane); ss += shx(ss, 2, lane); ss += shx(ss, 4, lane); ss += shx(ss, 8, lane);
        const float rstd = 1.0f / sqrtf(ss * (1.0f / 64.0f) + EPS);
        const f32x4 g = *(const f32x4*)((type == 0 ? F.P->in[17] : F.P->in[20]) + l * 64 + 4 * (lane & 15));
        bf16* z = (bf16*)(F.ws + (type == 0 ? WS_GZ : WS_RZ)) + (size_t)t * 256 + 4 * lane; const u32x2 zz = *(const u32x2*)z;
        u32x2 w; w.x = pk2(v0 * rstd * g.x * bf2f(zz.x & 0xffffu), v1 * rstd * g.y * bf2f(zz.x >> 16)); w.y = pk2(v2 * rstd * g.z * bf2f(zz.y & 0xffffu), v3 * rstd * g.w * bf2f(zz.y >> 16));
        *(u32x2*)z = w;
    }
}

struct EpiGate {
    static constexpr bool PERM = true;
    bf16* G; int pd;
    DEV void operator()(const f32x4 (&acc)[2][2][4][2], const pg8::Unit& u, int wr, int wc, int fr, int fq) const {
        OPAQUE(fr); OPAQUE(fq);
#pragma unroll
        for (int ai = 0; ai < 2; ++ai)
#pragma unroll
            for (int m = 0; m < 4; ++m) { bf16* rowp = G + (size_t)(u.pm * 256 + wr * 64 + fr + ai * 128 + m * 16) * D + pd * 256 + wc * 32 + 8 * fq;
#pragma unroll
                for (int bj = 0; bj < 2; ++bj) { const f32x4 v0 = acc[ai][bj][m][0], v1 = acc[ai][bj][m][1];
                    u32x4 w; w.x = pk2(sigmoid_f(v0.x), sigmoid_f(v0.y)); w.y = pk2(sigmoid_f(v0.z), sigmoid_f(v0.w)); w.z = pk2(sigmoid_f(v1.x), sigmoid_f(v1.y)); w.w = pk2(sigmoid_f(v1.z), sigmoid_f(v1.w));
                    *(u32x4*)(rowp + bj * 128) = w; } CFENCE(); }
    }
};
struct EpiMerge {
    static constexpr bool PERM = true;
    const bf16* G; bf16* Mg; int first;
    DEV void operator()(const f32x4 (&acc)[2][2][4][2], const pg8::Unit& u, int wr, int wc, int fr, int fq) const {
        OPAQUE(fr); OPAQUE(fq);
#pragma unroll
        for (int ai = 0; ai < 2; ++ai)
#pragma unroll
            for (int m = 0; m < 4; ++m) { const size_t off = (size_t)(u.pm * 256 + wr * 64 + fr + ai * 128 + m * 16) * D + u.pn * 256 + wc * 32 + 8 * fq;
#pragma unroll
                for (int bj = 0; bj < 2; ++bj) { const f32x4 v0 = acc[ai][bj][m][0], v1 = acc[ai][bj][m][1];
                    const u32x4 g = *(const u32x4*)(G + off + bj * 128); u32x4 o = {0u, 0u, 0u, 0u}; if (!first) o = *(const u32x4*)(Mg + off + bj * 128);
                    u32x4 w;
                    w.x = pk2(bf2f(o.x & 0xffffu) + bf2f(g.x & 0xffffu) * v0.x, bf2f(o.x >> 16) + bf2f(g.x >> 16) * v0.y);
                    w.y = pk2(bf2f(o.y & 0xffffu) + bf2f(g.y & 0xffffu) * v0.z, bf2f(o.y >> 16) + bf2f(g.y >> 16) * v0.w);
                    w.z = pk2(bf2f(o.z & 0xffffu) + bf2f(g.z & 0xffffu) * v1.x, bf2f(o.z >> 16) + bf2f(g.z >> 16) * v1.y);
                    w.w = pk2(bf2f(o.w & 0xffffu) + bf2f(g.w & 0xffffu) * v1.z, bf2f(o.w >> 16) + bf2f(g.w >> 16) * v1.w);
                    *(u32x4*)(Mg + off + bj * 128) = w; } CFENCE(); }
    }
};
struct EpiOut {
    static constexpr bool PERM = false;
    const float* x0; const float* x1; float* H; const float* modt; int l;
    DEV void operator()(const f32x4 (&acc)[2][2][4][2], const pg8::Unit& u, int wr, int wc, int fr, int fq) const {
        OPAQUE(fr); OPAQUE(fq);
        const int t0 = u.pm * 256; const float* gm = modt + (size_t)tok_cond(t0) * 3072 + 2048;
        const int col0 = u.pn * 256 + wc * 32 + 4 * fq;
        f32x4 gv[2][2];
#pragma unroll
        for (int bj = 0; bj < 2; ++bj)
#pragma unroll
            for (int n = 0; n < 2; ++n) gv[bj][n] = *(const f32x4*)(gm + col0 + bj * 128 + n * 16);
#pragma unroll
        for (int ai = 0; ai < 2; ++ai)
#pragma unroll
            for (int m = 0; m < 4; ++m) { const int t = t0 + wr * 64 + fr + ai * 128 + m * 16;
                const float* src = (l == 0) ? (t < TC ? x0 + (size_t)t * D : x1 + (size_t)(t - TC) * D) : H + (size_t)t * D;
                float* dst = H + (size_t)t * D;
#pragma unroll
                for (int bj = 0; bj < 2; ++bj)
#pragma unroll
                    for (int n = 0; n < 2; ++n) { const int c = col0 + bj * 128 + n * 16; *(f32x4*)(dst + c) = *(const f32x4*)(src + c) + gv[bj][n] * acc[ai][bj][m][n]; } CFENCE(); }
    }
};

DEV void pf_final(Frame& F) {
    const float* fg = F.P->in[24];
    const int gw = F.bx * 8 + F.wave, NGW = F.G * 8;
    for (int t = gw; t < T; t += NGW) {
        float* row = F.out + (size_t)t * D;
        f32x4 v[4]; float s = 0.f;
#pragma unroll
        for (int j = 0; j < 4; ++j) { v[j] = *(const f32x4*)(row + 4 * F.lane + 256 * j); s += (v[j].x * v[j].x + v[j].y * v[j].y) + (v[j].z * v[j].z + v[j].w * v[j].w); }
        const float rstd = 1.0f / sqrtf(wave_sum(s, F.lane) * (1.0f / D) + EPS);
#pragma unroll
        for (int j = 0; j < 4; ++j) { const int c = 4 * F.lane + 256 * j; *(f32x4*)(row + c) = v[j] * rstd * *(const f32x4*)(fg + c); }
    }
}

#ifdef EMU
#define DECL_LDS unsigned char* lds = emu::smem();
#else
#define DECL_LDS extern __shared__ __attribute__((aligned(16))) unsigned char lds_raw[]; unsigned char* lds = lds_raw;
#endif

#ifndef PH_LIMIT
#define PH_LIMIT 1000
#endif
#ifndef PH_MASK
#define PH_MASK 0xFFFF
#endif
#define PH_ON(k) ((PH_MASK >> (k)) & 1)

__global__ void __launch_bounds__(512, 2) fwd_kernel(Params prm) {
    DECL_LDS
    Frame F; F.lds = lds; F.ws = prm.ws; F.out = prm.out;
#ifdef EMU
    F.P = &prm;
#else
    F.P = (PP)__builtin_amdgcn_kernarg_segment_ptr();
#endif
    F.tid = threadIdx.x; F.lane = F.tid & 63; F.wave = __builtin_amdgcn_readfirstlane(F.tid >> 6); F.G = gridDim.x; F.bx = blockIdx.x;
    volatile LAS unsigned* misc = (volatile LAS unsigned*)(LAS unsigned char*)(lds + LDS_MISC);
    if (F.tid < 64) misc[F.tid] = 0u;
    __syncthreads();
    XcdBarrier bar = xcd_barrier_post((unsigned*)(F.ws + WS_CTL), misc + 8);
    int phase = 0;
#define GRID_BAR() do { xcd_barrier(bar); if (++phase >= PH_LIMIT) return; } while (0)
    LAS unsigned char* glds = (LAS unsigned char*)lds;
#ifdef EMU
#define REFRESH() do { F.tid = threadIdx.x; F.lane = F.tid & 63; } while (0)
#else
#define REFRESH() do { int t_ = threadIdx.x; OPAQUE(t_); F.tid = t_; F.lane = t_ & 63; PP kp_ = (PP)__builtin_amdgcn_kernarg_segment_ptr(); asm volatile("" : "+s"(kp_)); F.P = kp_; } while (0)
#endif

    REFRESH(); if (PH_ON(0)) p0_prologue(F);
    GRID_BAR();
    for (int l = 0; l < DEPTH; ++l) {
        REFRESH(); if (PH_ON(1)) { if (l > 0) convert_weights(F, l);
        p1_norm(F, l); }
        GRID_BAR();
        if (PH_ON(2)) { pg8::Gemm g{(const bf16*)(F.ws + WS_HN), (const bf16*)(F.ws + WS_WIN), T, NIN, D}; pg8::StaticOrder S; S.init(T, NIN, F.G, F.bx);
          EpiIn E{F.ws, F.out, F.P->in[18] + l * 64, F.P->in[19] + l * 64, F.P->in[15] + l * 8, F.P->in[16] + l * 8, l};
          pg8::gemm_phase<EpiIn, pg8::StaticOrder, true, true>(glds, g, S, E); }
        GRID_BAR();
        REFRESH(); if (PH_ON(3)) for (int c = F.bx; c < T / 64; c += F.G) gdn_prep_task(F, l, c);
        REFRESH(); if (PH_ON(4)) for (int u = F.bx; u < N_ATTN_UNITS; u += F.G) attn_unit(F, l, u);
        GRID_BAR();
        REFRESH(); if (PH_ON(5)) for (int k = F.bx; k < N_CHAIN_TASKS; k += F.G) chain_task(F, l, k);
        GRID_BAR();
        REFRESH(); if (PH_ON(6)) p5_finish(F, l);
        GRID_BAR();
        if (PH_ON(7)) for (int u = F.bx; u < (T / 256) * 4; u += F.G) {
            const int pm = u >> 2, pd = u & 3;
#pragma unroll 1
            for (int n = 0; n < 4; ++n) {
                { pg8::Gemm g{(const bf16*)(F.ws + WS_HN), (const bf16*)(F.ws + WS_WIN) + (size_t)(NIN + n * D) * D, T, D, D}; pg8::OneUnit S{pm, pd};
                  EpiGate E{(bf16*)(F.ws + WS_GATE), pd};
                  pg8::gemm_phase<EpiGate, pg8::OneUnit, false, true>(glds, g, S, E); }
                { pg8::Gemm g{(const bf16*)(F.ws + WS_AZ + (size_t)n * T * 256 * 2), (const bf16*)(F.ws + WS_WBR) + (size_t)n * D * 256, T, D, 256}; pg8::OneUnit S{pm, pd};
                  EpiMerge E{(const bf16*)(F.ws + WS_GATE), (bf16*)(F.ws + WS_MERGED), n == 0 ? 1 : 0};
                  pg8::gemm_phase<EpiMerge, pg8::OneUnit, false, true>(glds, g, S, E); }
            }
        }
        GRID_BAR();
        if (PH_ON(8)) { pg8::Gemm g{(const bf16*)(F.ws + WS_MERGED), (const bf16*)(F.ws + WS_WOUT), T, D, D}; pg8::StaticOrder S; S.init(T, D, F.G, F.bx);
          EpiOut E{F.P->in[0], F.P->in[1], F.out, (const float*)(F.ws + WS_MODT) + (size_t)l * NCOND * 3072, l};
          pg8::gemm_phase<EpiOut, pg8::StaticOrder, true, true>(glds, g, S, E); }
        GRID_BAR();
    }
    REFRESH(); if (PH_ON(9)) pf_final(F);
}

extern "C" void kernel_launch(void* const* d_in, const int* in_sizes, int n_in, void* d_out, int out_size, void* d_ws, size_t ws_size, hipStream_t stream) {
    static int grid = 0;
    if (grid == 0) {
        if (n_in != 25 || (size_t)out_size != O_END || ws_size < WS_END) { fprintf(stderr, "kernel_launch: unexpected shapes (n_in %d out %d ws %zu)\n", n_in, out_size, ws_size); grid = -1; return; }
        int dev = 0, cus = 0;
        if (hipGetDevice(&dev) != hipSuccess || hipDeviceGetAttribute(&cus, hipDeviceAttributeMultiprocessorCount, dev) != hipSuccess) { grid = -1; return; }
        if (hipFuncSetAttribute((const void*)fwd_kernel, hipFuncAttributeMaxDynamicSharedMemorySize, LDS_BYTES) != hipSuccess) { fprintf(stderr, "kernel_launch: hipFuncSetAttribute failed\n"); grid = -1; return; }
        (void)hipGetLastError();
        grid = cus;
    }
    if (grid < 0) return;
    (void)hipMemsetAsync((char*)d_ws + WS_CTL, 0, CTL_BYTES, stream);
    Params p{};
    for (int i = 0; i < 25; ++i) p.in[i] = (const float*)d_in[i];
    p.out = (float*)d_out; p.ws = (unsigned char*)d_ws;
    hipLaunchKernelGGL(fwd_kernel, dim3(grid), dim3(512), LDS_BYTES, stream, p);
}

#ifdef EMU
size_t emu_out_size() { return O_END; }
size_t emu_ws_size() { return (size_t)256 * 1024 * 1024; }
size_t emu_ws_used() { return WS_END; }
#endif
```

```cpp
#include <hip/hip_runtime.h>
#include <cstdio>
#include <cstdint>

#define REP_BAR 0
#define REP_P0 0
#define REP_P7 0
#define REP_P1 0
#define REP_GDNA 0
#define REP_P2 0
#define REP_P6 0
#define REP_P4 0
#define REP_GDNC 0
#define REP_ATTN 0
#define REP_GEMM 0
#ifndef CFG_NB
#define CFG_NB 32
#endif
#ifndef CFG_DB
#define CFG_DB 8
#endif

#ifdef EMU
#define LAS
#define GAS
#define ASMV(x)
#else
#define LAS __attribute__((address_space(3)))
#if defined(__HIP_DEVICE_COMPILE__)
#define GAS __attribute__((address_space(1)))
#else
#define GAS
#endif
#define ASMV(x) asm volatile(x ::: "memory")
#endif
#define DEV __device__ __forceinline__
#ifdef EMU
#define CFENCE()
#else
#define CFENCE() asm volatile("" ::: "memory")
#endif
#ifdef EMU
#define OPAQUE(x)
#else
#define OPAQUE(x) asm volatile("" : "+v"(x))
#endif
#ifdef EMU
#define FRESH_LANE() ((int)(threadIdx.x & 63))
#else
DEV int fresh_lane_() { unsigned z = 0; asm volatile("" : "+v"(z)); return (int)__builtin_amdgcn_mbcnt_hi(~0u, __builtin_amdgcn_mbcnt_lo(~0u, z)); }
#define FRESH_LANE() fresh_lane_()
#endif
#ifdef EMU
#define WAVE_SYNC() emu::wave_sync()
#else
#define WAVE_SYNC() __builtin_amdgcn_wave_barrier()
#endif

typedef unsigned short bf16;
typedef short bf16x8 __attribute__((ext_vector_type(8)));
typedef float f32x4 __attribute__((ext_vector_type(4)));
typedef float f32x2 __attribute__((ext_vector_type(2)));
typedef unsigned u32x4 __attribute__((ext_vector_type(4)));
typedef unsigned u32x2 __attribute__((ext_vector_type(2)));

constexpr int D = 1024, DEPTH = 2, HD = 64, NB = CFG_NB, SEQ = 256, DB = CFG_DB, DSEQ = 1024, PAST = 512;
constexpr int TC = NB * SEQ, TS = DB * DSEQ, T = TC + TS, NCOND = 1 + DB, NSEQ = NB + DB;
constexpr int INW = 7952, NPERM = 8192, NIN = 4096;
constexpr float EPS = 1e-6f;
static_assert(T % 256 == 0 && TC % 256 == 0, "token tiles");

constexpr size_t O_Y = 0;
constexpr size_t O_AK = (size_t)T * D;
constexpr size_t O_AV = O_AK + (size_t)NB * DEPTH * SEQ * 128;
constexpr size_t O_NK = O_AV + (size_t)NB * DEPTH * SEQ * 128;
constexpr size_t O_NV = O_NK + (size_t)NB * DEPTH * SEQ * 256;
constexpr size_t O_SG = O_NV + (size_t)NB * DEPTH * SEQ * 256;
constexpr size_t O_SR = O_SG + (size_t)NB * DEPTH * 2 * 4 * 4096;
constexpr size_t O_END = O_SR + (size_t)NB * DEPTH * 2 * 4 * 4096;

constexpr size_t al256(size_t x) { return (x + 255) & ~(size_t)255; }
constexpr size_t WS_CTL = 0, CTL_BYTES = 65536;
constexpr size_t WS_MODT = WS_CTL + CTL_BYTES;
constexpr size_t WS_ROPE = al256(WS_MODT + (size_t)DEPTH * NCOND * 3072 * 4);
constexpr size_t WS_WIN = al256(WS_ROPE + 2 * 64 * 16 * 4);
constexpr size_t WS_WBR = WS_WIN + (size_t)NPERM * D * 2;
constexpr size_t WS_WOUT = WS_WBR + (size_t)4 * D * 256 * 2;
constexpr size_t WS_KAC = WS_WOUT + (size_t)D * D * 2;
constexpr size_t WS_VACT = WS_KAC + (size_t)DEPTH * DB * 2 * PAST * 64 * 2;
constexpr size_t WS_NKC = WS_VACT + (size_t)DEPTH * DB * 2 * PAST * 64 * 2;
constexpr size_t WS_NVCT = WS_NKC + (size_t)DEPTH * DB * 4 * PAST * 64 * 2;
constexpr size_t WS_HN = WS_NVCT + (size_t)DEPTH * DB * 4 * PAST * 64 * 2;
constexpr size_t WS_QA = WS_HN + (size_t)T * D * 2;
constexpr size_t WS_GQKV = WS_QA + (size_t)T * 256 * 2;
constexpr size_t WS_RQKV = WS_GQKV + (size_t)T * 768 * 2;
constexpr size_t WS_NQ = WS_RQKV + (size_t)T * 512 * 2;
constexpr size_t WS_KA = WS_NQ + (size_t)T * 256 * 2;
constexpr size_t WS_VAT = WS_KA + (size_t)T * 128 * 2;
constexpr size_t WS_NK = WS_VAT + (size_t)T * 128 * 2;
constexpr size_t WS_NVT = WS_NK + (size_t)T * 256 * 2;
constexpr size_t WS_AZ = WS_NVT + (size_t)T * 256 * 2;
constexpr size_t WS_BR = WS_AZ;
constexpr size_t WS_GAB = WS_AZ + (size_t)T * 1024 * 2;
constexpr size_t WS_MB = WS_GAB + (size_t)T * 16 * 4;
constexpr size_t WS_BS = WS_MB + (size_t)(T / 64) * 8 * 4096 * 4;
constexpr size_t WS_O = WS_BS;
constexpr size_t WS_RVT = WS_BS + (size_t)(T / 64) * 8 * 4096 * 4;
constexpr size_t WS_S0T = WS_RVT + (size_t)T * 256 * 2;
constexpr size_t WS_END = WS_S0T + (size_t)2 * DEPTH * DB * 8 * 4096 * 2;
constexpr size_t WS_MERGED = WS_QA, WS_GATE = WS_RQKV;
constexpr size_t TF_SLOT = 6144, TF_NA = ((size_t)NIN * D * 2) / TF_SLOT, TF_N = (size_t)(T / 64) * 4 * 2;
constexpr size_t WS_TFB = WS_END, WS_END2 = WS_TFB + (TF_N > TF_NA ? (TF_N - TF_NA) * TF_SLOT : 0);
static_assert(WS_END2 <= (size_t)256 * 1024 * 1024, "d_ws map exceeds 256 MiB");
static_assert(WS_GATE + (size_t)T * D * 2 <= WS_NK && WS_MERGED + (size_t)T * D * 2 <= WS_RQKV, "overlays");

constexpr int LDS_BYTES = 163840;
constexpr int LDS_MISC = 162816;

struct Params { const float* in[25]; float* out; unsigned char* ws; };
#ifdef EMU
typedef const Params* PP;
#else
typedef const __attribute__((address_space(4))) Params* PP;
#endif

DEV unsigned f2bf(float f) { unsigned u = __builtin_bit_cast(unsigned, f); return (u + 0x7fffu + ((u >> 16) & 1u)) >> 16; }
DEV float bf2f(unsigned h) { return __builtin_bit_cast(float, h << 16); }
DEV unsigned pk2(float lo, float hi) {
#ifdef EMU
    return f2bf(lo) | (f2bf(hi) << 16);
#else
    typedef __bf16 bfx2_ __attribute__((ext_vector_type(2))); typedef float flx2_ __attribute__((ext_vector_type(2)));
    const flx2_ v_ = {lo, hi}; return __builtin_bit_cast(unsigned, __builtin_convertvector(v_, bfx2_));
#endif
}
#ifdef EMU
#define NT_ST(p, v) (*(p) = (v))
#define NT_LD(p) (*(p))
#else
#define NT_ST(p, v) __builtin_nontemporal_store((v), (p))
#define NT_LD(p) __builtin_nontemporal_load(p)
#endif
DEV float sigmoid_f(float x) { return __builtin_amdgcn_rcpf(1.f + __builtin_amdgcn_exp2f(-1.4426950408889634f * x)); }
DEV float silu_f(float x) { return x * sigmoid_f(x); }
DEV float softplus_f(float x) { return fmaxf(x, 0.f) + __logf(1.0f + __expf(-fabsf(x))); }
#ifdef EMU
DEV float shx(float v, int mask, int lane) { return __shfl_xor(v, mask); }
DEV float shf(float v, int src) { return __shfl(v, src); }
#else
DEV float shx(float v, int mask, int lane) { return __builtin_bit_cast(float, __builtin_amdgcn_ds_bpermute((lane ^ mask) << 2, __builtin_bit_cast(int, v))); }
DEV float shf(float v, int src) { return __builtin_bit_cast(float, __builtin_amdgcn_ds_bpermute(src << 2, __builtin_bit_cast(int, v))); }
#endif
DEV float wave_sum(float v, int lane) {
#pragma unroll
    for (int o = 1; o < 64; o <<= 1) v += shx(v, o, lane);
    return v;
}

#ifdef EMU
struct XcdBarrier { unsigned* bar; int wave; };
DEV XcdBarrier xcd_barrier_post(unsigned* bar, volatile unsigned* st) { XcdBarrier b; b.bar = bar; return b; }
DEV void xcd_barrier(const XcdBarrier& b) {
    __syncthreads();
    if (threadIdx.x == 0) { const unsigned G = gridDim.x; const unsigned old = __atomic_fetch_add(&b.bar[0], 1u, __ATOMIC_SEQ_CST); const unsigned gen = old / G;
        while (__atomic_load_n(&b.bar[0], __ATOMIC_SEQ_CST) < (gen + 1u) * G) emu::yield(); }
    __syncthreads();
}
#else
#define XB_TMO      128
#define XB_XCNT(j)  (256  + 64 * (j))
#define XB_XSUB(j)  (1280 + 64 * (j))
#define XB_XGEN(j)  (2304 + 64 * (j))
#define XB_TOP      3328
#define XB_TOPGEN   3392
#define XCD_BAR_WORDS 3456
#define XB_SPIN_CAP (1u << 18)
__device__ __forceinline__ unsigned xb_ld(unsigned* p)              { return __hip_atomic_load(p, __ATOMIC_RELAXED, __HIP_MEMORY_SCOPE_AGENT); }
__device__ __forceinline__ unsigned xb_add(unsigned* p, unsigned v) { return __hip_atomic_fetch_add(p, v, __ATOMIC_RELAXED, __HIP_MEMORY_SCOPE_AGENT); }
__device__ __forceinline__ unsigned xb_xcc_id() { return (unsigned)__builtin_amdgcn_s_getreg((3 << 11) | 20) & 0xFu; }
#define XB_SPIN(cond, bar) do { unsigned _sp = 0; while (cond) { __builtin_amdgcn_s_sleep(1); \
    if ((++_sp & 255u) == 0u) { if (xb_ld(&(bar)[XB_TMO])) break; if (_sp > XB_SPIN_CAP) { atomicAdd(&(bar)[XB_TMO], 1u); break; } } } } while (0)
struct XcdBarrier { unsigned* bar; unsigned x; volatile LAS unsigned* st; int wave; };
__device__ __forceinline__ XcdBarrier xcd_barrier_post(unsigned* bar, volatile LAS unsigned* st) {
    XcdBarrier b; b.bar = bar; b.x = xb_xcc_id(); b.st = st;
    if (threadIdx.x == 0) (void)xb_add(&bar[XB_XCNT(b.x)], 1u);
    return b;
}
__device__ __forceinline__ void xcd_barrier_complete(unsigned* bar, unsigned x, unsigned& nloc, unsigned& nx) {
    const unsigned G = gridDim.x * gridDim.y * gridDim.z;
    unsigned sum, cnt, mine, sp = 0u;
    for (;;) {
        sum = 0u; cnt = 0u; mine = 0u;
#pragma unroll
        for (unsigned j = 0; j < 16; ++j) { const unsigned c = xb_ld(&bar[XB_XCNT(j)]); sum += c; cnt += (c > 0u) ? 1u : 0u; mine = (j == x) ? c : mine; }
        if (sum == G) break;
        __builtin_amdgcn_s_sleep(1);
        if ((++sp & 255u) == 0u) { if (xb_ld(&bar[XB_TMO])) break; if (sp > XB_SPIN_CAP) { atomicAdd(&bar[XB_TMO], 1u); break; } }
    }
    nloc = mine > 0u ? mine : 1u; nx = cnt > 0u ? cnt : 1u;
}
__device__ __forceinline__ void xcd_barrier(const XcdBarrier& b) {
    asm volatile("s_waitcnt vmcnt(0)" ::: "memory");
    __syncthreads();
    const int tb_ = b.wave * 64 + FRESH_LANE();
    if (tb_ == 0) {
        unsigned* bar = b.bar; asm volatile("" : "+s"(bar));
        unsigned bx_ = xb_xcc_id(); asm volatile("" : "+s"(bx_));
        __builtin_amdgcn_s_waitcnt(0);
        unsigned nloc = b.st[0], nx = b.st[1];
        if (nloc == 0u) { xcd_barrier_complete(bar, bx_, nloc, nx); b.st[0] = nloc; b.st[1] = nx; }
        const unsigned old = xb_add(&bar[XB_XSUB(bx_)], 1u);
        const unsigned gen = old / nloc;
        if (old + 1u == (gen + 1u) * nloc) {
            __builtin_amdgcn_fence(__ATOMIC_RELEASE, "agent");
            asm volatile("s_waitcnt vmcnt(0)" ::: "memory");
            const unsigned og = xb_add(&bar[XB_TOP], 1u);
            const unsigned tg = og / nx;
            if (og + 1u == (tg + 1u) * nx) xb_add(&bar[XB_TOPGEN], 1u);
            else XB_SPIN(xb_ld(&bar[XB_TOPGEN]) == tg, bar);
            __builtin_amdgcn_fence(__ATOMIC_ACQUIRE, "agent");
            xb_add(&bar[XB_XGEN(bx_)], 1u);
            asm volatile("s_waitcnt vmcnt(0)" ::: "memory");
        } else {
            XB_SPIN(xb_ld(&bar[XB_XGEN(bx_)]) == gen, bar);
            __builtin_amdgcn_fence(__ATOMIC_ACQUIRE, "agent");
            asm volatile("s_waitcnt vmcnt(0)" ::: "memory");
        }
    }
    __syncthreads();
}
#endif

namespace pg8 {
#define PG8_LAS LAS
constexpr int BM = 256, BK = 64, HALF = 128, HTB = HALF * BK * 2, STAGE_BYTES = 8 * HTB, NXCD = 8, WGM = 8;
__host__ __device__ __forceinline__ int lds_byte(int r, int c) { const int st = (r >> 4) * 2 + (c >> 5), rr = r & 15, cc = c & 31, ob = rr * 64 + cc * 2; return st * 1024 + (ob ^ (((ob >> 9) & 1) << 5)); }
__host__ __device__ __forceinline__ void stage_rc(int b, int& R, int& C) { const int st = b / 1024, sb = b % 1024, swz = sb ^ (((sb >> 9) & 1) << 5); R = (st >> 1) * 16 + swz / 64; C = (st & 1) * 32 + (swz % 64) / 2; }
__host__ __device__ __forceinline__ int perm32(int rho) { const int n = rho >> 4, i = rho & 15; return 8 * (i >> 2) + 4 * n + (i & 3); }
struct Unit { int pm, pn; const char* a; const char* b; int nt, kind; };
struct Gemm { const bf16* A; const bf16* Bt; int M, N, K; };
struct StaticOrder {
    int nM, nN, nwg, G, c;
    __host__ __device__ void init(int M, int N, int G_, int c_) { nM = M / BM; nN = N / BM; nwg = nM * nN; G = G_; c = c_; }
    __host__ __device__ bool next(int i, Unit& u, const Gemm& g) const {
        const long L = (long)i * G + c; if (L >= nwg) return false;
        int wgid = (int)L; { const int q = nwg / NXCD, r = nwg % NXCD, xcd = wgid % NXCD, off = wgid / NXCD; wgid = (xcd < r ? xcd * (q + 1) : r * (q + 1) + (xcd - r) * q) + off; }
        const int nig = WGM * nN, gid = wgid / nig, fm = gid * WGM, gsz = (nM - fm) < WGM ? (nM - fm) : WGM;
        u.pm = fm + ((wgid % nig) % gsz); u.pn = (wgid % nig) / gsz;
        u.a = (const char*)g.A + (size_t)u.pm * 256 * g.K * 2; u.b = (const char*)g.Bt + (size_t)u.pn * 256 * g.K * 2; u.nt = g.K / 64; u.kind = 0; return true;
    }
    __device__ __forceinline__ void a_ready(const Unit&) const {}
    __device__ __forceinline__ void done(const Unit&) const {}
};
struct P6Order {
    const char* hn; const char* wmg; const char* br; const char* wbr; int ntiles, G, c;
    __device__ __forceinline__ bool next(int i, Unit& u, const Gemm&) const {
        int tile = c + (i >> 3) * G; if (tile >= ntiles) return false;
        if (G == 256 && ntiles == 256) { const int xcd = c & 7, idx = c >> 3; tile = (xcd * 8 + (idx >> 2)) * 4 + (idx & 3); }
        const int sub = i & 7, n = sub >> 1; u.pm = tile >> 2; u.pn = tile & 3; u.kind = sub;
        if ((sub & 1) == 0) { u.a = hn + (size_t)u.pm * 256 * 2048; u.b = wmg + ((size_t)n * 1024 + u.pn * 256) * 2048; u.nt = 16; }
        else { u.a = br + (size_t)u.pm * 256 * 2048 + n * 512; u.b = wbr + (size_t)u.pn * 256 * 2048 + n * 512; u.nt = 4; }
        return true;
    }
    __device__ __forceinline__ void a_ready(const Unit&) const {}
    __device__ __forceinline__ void done(const Unit&) const {}
};
#ifdef EMU
#define PG8_WAIT_V(n)
#define PG8_WAIT_L(n)
#else
#define PG8_WAIT_V(n) asm volatile("s_waitcnt vmcnt(" #n ")" ::: "memory")
#define PG8_WAIT_L(n) asm volatile("s_waitcnt lgkmcnt(" #n ")" ::: "memory")
#endif
template <class Epi, class Sched, bool ALIGN_EPI = false, bool SP2 = false>
__device__ __forceinline__ void gemm_phase(PG8_LAS unsigned char* lds, const Gemm g, const Sched& S, const Epi& E, const int wid) {
    const int lane = FRESH_LANE(), tid = wid * 64 + lane, wr = wid >> 2, wc = wid & 3, fr = lane & 15, fq = lane >> 4;
    const int K = g.K;
    unsigned voffA[2], voffB[2];
#pragma unroll
    for (int i = 0; i < 2; ++i) { int R, C; stage_rc(tid * 16 + i * 8192, R, C); const int Rb = Epi::PERM ? ((R & ~31) + perm32(R & 31)) : R;
        voffA[i] = (unsigned)(R * K + C) * 2u; voffB[i] = (unsigned)(Rb * K + C) * 2u; }
    const size_t kstep = (size_t)(BK * 2);
    const size_t hstep = (size_t)HALF * K * 2;
    const unsigned ldsw = (unsigned)wid * 1024u;
    const int aoff = lds_byte(wr * 64 + fr, fq * 8), boff = lds_byte(wc * 32 + fr, fq * 8);
#define PG8_SA(b, h) (((b) * 2 + (h)) * HTB)
#define PG8_SB(b, h) ((4 + (b) * 2 + (h)) * HTB)
#define PG8_STAGE(bufoff, gbase, voff) do { _Pragma("unroll") for (int _i = 0; _i < 2; ++_i) \
        __builtin_amdgcn_global_load_lds((const unsigned*)((const char*)(gbase) + (voff)[_i]), (PG8_LAS unsigned*)(lds + (bufoff) + ldsw + _i * 8192), 16, 0, 0); } while (0)
#define PG8_LDA(dst, b, h) do { _Pragma("unroll") for (int m = 0; m < 4; ++m) _Pragma("unroll") for (int k = 0; k < 2; ++k) dst[m][k] = *(const PG8_LAS bf16x8*)(lds + PG8_SA(b, h) + aoff + m * 2048 + k * 1024); } while (0)
#define PG8_LDB(dst, b, h) do { _Pragma("unroll") for (int n = 0; n < 2; ++n) _Pragma("unroll") for (int k = 0; k < 2; ++k) dst[n][k] = *(const PG8_LAS bf16x8*)(lds + PG8_SB(b, h) + boff + n * 2048 + k * 1024); } while (0)
#define PG8_MMA(ai, bj, At, Bt) do { __builtin_amdgcn_s_setprio(1); _Pragma("unroll") for (int m = 0; m < 4; ++m) _Pragma("unroll") for (int n = 0; n < 2; ++n) _Pragma("unroll") for (int k = 0; k < 2; ++k) \
        acc[ai][bj][m][n] = __builtin_amdgcn_mfma_f32_16x16x32_bf16(Bt[n][k], At[m][k], acc[ai][bj][m][n], 0, 0, 0); __builtin_amdgcn_s_setprio(0); } while (0)
#define PG8_BAR __builtin_amdgcn_s_barrier()
#define PG8_SCHED __builtin_amdgcn_sched_barrier(0)
    Unit cur, nxt; int ui = 0;
    if (!S.next(0, cur, g)) return;
    f32x4 acc[2][2][4][2];
#pragma unroll
    for (int a = 0; a < 2; ++a)
#pragma unroll
        for (int b = 0; b < 2; ++b)
#pragma unroll
            for (int m = 0; m < 4; ++m)
#pragma unroll
                for (int n = 0; n < 2; ++n) acc[a][b][m][n] = (f32x4){0.f, 0.f, 0.f, 0.f};
    bf16x8 At[4][2], B0[2][2], B1[2][2];
    const char* cA = cur.a; const char* cB = cur.b;
    S.a_ready(cur);
    if constexpr (SP2) {
        PG8_STAGE(PG8_SB(0, 0), cB, voffB); PG8_STAGE(PG8_SB(0, 1), cB + hstep, voffB); PG8_STAGE(PG8_SA(0, 0), cA, voffA); PG8_STAGE(PG8_SA(0, 1), cA + hstep, voffA);
        if (wr == 1) PG8_BAR;
        PG8_WAIT_V(2); PG8_BAR;
        PG8_STAGE(PG8_SB(1, 0), cB + kstep, voffB); PG8_STAGE(PG8_SA(1, 0), cA + kstep, voffA); PG8_STAGE(PG8_SB(1, 1), cB + hstep + kstep, voffB);
        PG8_WAIT_V(6); PG8_BAR;
    } else {
        PG8_STAGE(PG8_SB(0, 0), cB, voffB); PG8_STAGE(PG8_SA(0, 0), cA, voffA); PG8_STAGE(PG8_SB(0, 1), cB + hstep, voffB); PG8_STAGE(PG8_SA(0, 1), cA + hstep, voffA);
        if (wr == 1) PG8_BAR;
        PG8_WAIT_V(4); PG8_BAR;
        PG8_STAGE(PG8_SB(1, 0), cB + kstep, voffB); PG8_STAGE(PG8_SA(1, 0), cA + kstep, voffA); PG8_STAGE(PG8_SB(1, 1), cB + hstep + kstep, voffB);
        PG8_WAIT_V(6); PG8_BAR;
    }
    for (;;) {
        const bool has_next = S.next(ui + 1, nxt, g);
        const char* nA = has_next ? nxt.a : cA; const char* nB = has_next ? nxt.b : cB;
        const int nt = cur.nt;
        for (int t = 0; t < nt; t += 2) {
            const bool last = (t == nt - 2);
            const char* a1 = cA + (size_t)(t + 1) * kstep;
            const char* a2 = last ? nA : cA + (size_t)(t + 2) * kstep; const char* b2 = last ? nB : cB + (size_t)(t + 2) * kstep;
            const char* a3 = a2 + kstep; const char* b3 = b2 + kstep;
            if (last && has_next) S.a_ready(nxt);
            if constexpr (SP2) {
            PG8_LDB(B0, 0, 0); PG8_LDB(B1, 0, 1); PG8_SCHED; PG8_LDA(At, 0, 0); PG8_STAGE(PG8_SA(1, 1), a1 + hstep, voffA);
            PG8_WAIT_V(8); PG8_WAIT_L(0); PG8_BAR; PG8_MMA(0, 0, At, B0); PG8_MMA(0, 1, At, B1); PG8_BAR; PG8_SCHED;
            PG8_LDA(At, 0, 1); PG8_STAGE(PG8_SB(0, 0), b2, voffB); PG8_STAGE(PG8_SB(0, 1), b2 + hstep, voffB); PG8_STAGE(PG8_SA(0, 0), a2, voffA);
            PG8_WAIT_V(8); PG8_WAIT_L(0); PG8_BAR; PG8_MMA(1, 0, At, B0); PG8_MMA(1, 1, At, B1); PG8_BAR; PG8_SCHED;
            PG8_LDB(B0, 1, 0); PG8_LDB(B1, 1, 1); PG8_SCHED; PG8_LDA(At, 1, 0); PG8_STAGE(PG8_SA(0, 1), a2 + hstep, voffA);
            PG8_WAIT_V(8); PG8_WAIT_L(0); PG8_BAR; PG8_MMA(0, 0, At, B0); PG8_MMA(0, 1, At, B1); PG8_BAR; PG8_SCHED;
            PG8_LDA(At, 1, 1); PG8_STAGE(PG8_SB(1, 0), b3, voffB); PG8_STAGE(PG8_SB(1, 1), b3 + hstep, voffB); PG8_STAGE(PG8_SA(1, 0), a3, voffA);
            PG8_WAIT_V(8); PG8_WAIT_L(0); PG8_BAR; PG8_MMA(1, 0, At, B0); PG8_MMA(1, 1, At, B1); PG8_BAR; PG8_SCHED;
            } else {
            PG8_LDB(B0, 0, 0); PG8_SCHED; PG8_LDA(At, 0, 0); PG8_STAGE(PG8_SA(1, 1), a1 + hstep, voffA);
            PG8_WAIT_L(8); PG8_BAR; PG8_WAIT_L(0); PG8_MMA(0, 0, At, B0); PG8_BAR; PG8_SCHED;
            PG8_LDB(B1, 0, 1); PG8_STAGE(PG8_SB(0, 0), b2, voffB);
            PG8_BAR; PG8_WAIT_L(0); PG8_MMA(0, 1, At, B1); PG8_BAR;
            PG8_LDA(At, 0, 1); PG8_STAGE(PG8_SA(0, 0), a2, voffA);
            PG8_BAR; PG8_WAIT_L(0); PG8_MMA(1, 0, At, B0); PG8_BAR; PG8_SCHED;
            PG8_STAGE(PG8_SB(0, 1), b2 + hstep, voffB);
            PG8_WAIT_V(6); PG8_BAR; PG8_MMA(1, 1, At, B1); PG8_BAR;
            PG8_LDB(B0, 1, 0); PG8_SCHED; PG8_LDA(At, 1, 0); PG8_STAGE(PG8_SA(0, 1), a2 + hstep, voffA);
            PG8_WAIT_L(8); PG8_BAR; PG8_WAIT_L(0); PG8_MMA(0, 0, At, B0); PG8_BAR; PG8_SCHED;
            PG8_LDB(B1, 1, 1); PG8_STAGE(PG8_SB(1, 0), b3, voffB);
            PG8_BAR; PG8_WAIT_L(0); PG8_MMA(0, 1, At, B1); PG8_BAR;
            PG8_LDA(At, 1, 1); PG8_STAGE(PG8_SA(1, 0), a3, voffA);
            PG8_BAR; PG8_WAIT_L(0); PG8_MMA(1, 0, At, B0); PG8_BAR; PG8_SCHED;
            PG8_STAGE(PG8_SB(1, 1), b3 + hstep, voffB);
            PG8_WAIT_V(6); PG8_BAR; PG8_MMA(1, 1, At, B1); PG8_BAR;
            }
        }
        if constexpr (ALIGN_EPI) { if (wr == 0) PG8_BAR; }
        E(acc, cur, wr, wc, fr, fq);
        PG8_WAIT_V(0);
        if (!has_next) break;
#pragma unroll
        for (int a = 0; a < 2; ++a)
#pragma unroll
            for (int b = 0; b < 2; ++b)
#pragma unroll
                for (int m = 0; m < 4; ++m)
#pragma unroll
                    for (int n = 0; n < 2; ++n) acc[a][b][m][n] = (f32x4){0.f, 0.f, 0.f, 0.f};
        cur = nxt; cA = nA; cB = nB; ++ui;
        if constexpr (ALIGN_EPI) { if (wr == 1) PG8_BAR; }
    }
    PG8_WAIT_V(0);
    if constexpr (!ALIGN_EPI) { if (wr == 0) PG8_BAR; }
    PG8_BAR;
#undef PG8_SA
#undef PG8_SB
#undef PG8_STAGE
#undef PG8_LDA
#undef PG8_LDB
#undef PG8_MMA
#undef PG8_BAR
#undef PG8_SCHED
}
}

struct Frame {
    unsigned char* lds; LAS unsigned char* ldsl; PP P; GAS unsigned char* ws; GAS float* out;
    int tid, lane, wave, G, bx;
};
DEV int tok_cond(int t) { return t < TC ? 0 : 1 + (t - TC) / DSEQ; }

DEV int hperm(int p) { const int bj = p >> 7, wc = (p >> 5) & 3, c5 = p & 31; return wc * 64 + 32 * bj + 16 * ((c5 >> 2) & 1) + 4 * (c5 >> 3) + (c5 & 3); }
DEV int win_src_col(int r) {
    if (r < 512) return (r & ~255) + hperm(r & 255);
    if (r < 1536) return r;
    if (r < 3840) return r + 16;
    if (r < 3856) return 1536 + (r - 3840);
    if (r < 4096) return -1;
    return r - 240;
}
DEV void transpose_item(const float* W, int ldw, int srccol, bf16* WT, int ldt, int drow0, int k0, float* scr, int lane) {
#pragma unroll 8
    for (int i = 0; i < 32; ++i) { const int kk = 2 * i + (lane >> 5); scr[kk * 33 + (lane & 31)] = srccol >= 0 ? NT_LD(W + (size_t)(k0 + kk) * ldw + srccol) : 0.f; }
    WAVE_SYNC();
    const int c = lane & 7;
#pragma unroll
    for (int j = 0; j < 4; ++j) { const int n = (lane >> 3) + 8 * j; const float* s = scr + (8 * c) * 33 + n;
        u32x4 o; o.x = pk2(s[0 * 33], s[1 * 33]); o.y = pk2(s[2 * 33], s[3 * 33]); o.z = pk2(s[4 * 33], s[5 * 33]); o.w = pk2(s[6 * 33], s[7 * 33]);
        *(u32x4*)(WT + (size_t)(drow0 + n) * ldt + k0 + 8 * c) = o; }
    WAVE_SYNC();
}
DEV void transpose_item64(const float* W, int ldw, int srccol0, bf16* WT, int ldt, int drow0, int k0, int dcol0, float* scr, int lane) {
    const int c4 = (lane & 15) * 4, r4 = lane >> 4;
#pragma unroll 8
    for (int i = 0; i < 16; ++i) { const int kk = 4 * i + r4; const f32x4 v = NT_LD((const f32x4*)(W + (size_t)(k0 + kk) * ldw + srccol0 + c4));
        float* d = scr + kk * 65 + c4; d[0] = v.x; d[1] = v.y; d[2] = v.z; d[3] = v.w; }
    WAVE_SYNC();
    const int c = lane & 7;
#pragma unroll
    for (int j = 0; j < 8; ++j) { const int n = (lane >> 3) + 8 * j; const float* sp = scr + (8 * c) * 65 + n;
        u32x4 o; o.x = pk2(sp[0 * 65], sp[1 * 65]); o.y = pk2(sp[2 * 65], sp[3 * 65]); o.z = pk2(sp[4 * 65], sp[5 * 65]); o.w = pk2(sp[6 * 65], sp[7 * 65]);
        *(u32x4*)(WT + (size_t)(drow0 + n) * ldt + dcol0 + 8 * c) = o; }
    WAVE_SYNC();
}
constexpr int CW_IN = 16 * (NPERM / 64), CW_BR = 4 * 4 * (D / 64), CW_OUT = 16 * (D / 64), CW_ITEMS = CW_IN + CW_BR + CW_OUT;
DEV void convert_item(Frame& F, int l, int it, float* scr) {
    const float* w_in = F.P->in[13] + (size_t)l * D * INW;
    const float* w_br = F.P->in[22] + (size_t)l * 4 * 256 * D;
    const float* w_out = F.P->in[23] + (size_t)l * D * D;
    bf16* WIN = (bf16*)(F.ws + WS_WIN); bf16* WBR = (bf16*)(F.ws + WS_WBR); bf16* WOUT = (bf16*)(F.ws + WS_WOUT);
    int r = it;
    if (r < CW_IN) { const int kb = r / (NPERM / 64), nb = r % (NPERM / 64), r0 = nb * 64;
        if (r0 < 512 || (r0 >= 3840 && r0 < 4096)) {
            transpose_item(w_in, INW, win_src_col(r0 + (F.lane & 31)), WIN, D, r0, kb * 64, scr, F.lane);
            transpose_item(w_in, INW, win_src_col(r0 + 32 + (F.lane & 31)), WIN, D, r0 + 32, kb * 64, scr, F.lane);
        } else transpose_item64(w_in, INW, win_src_col(r0), WIN, D, r0, kb * 64, kb * 64, scr, F.lane);
        return; }
    r -= CW_IN;
    if (r < CW_BR) { const int n = r / (4 * (D / 64)), q = r % (4 * (D / 64)), kb = q / (D / 64), nb = q % (D / 64);
        transpose_item64(w_br + (size_t)n * 256 * D, D, nb * 64, WBR, D, nb * 64, kb * 64, n * 256 + kb * 64, scr, F.lane); return; }
    r -= CW_BR;
    { const int kb = r / (D / 64), nb = r % (D / 64); transpose_item64(w_out, D, nb * 64, WOUT, D, nb * 64, kb * 64, kb * 64, scr, F.lane); }
}
DEV void convert_weights(Frame& F, int l) {
    float* scr = (float*)(F.lds + F.wave * 16640);
    const int gw = F.bx * 8 + F.wave, NGW = F.G * 8;
    for (int it = gw; it < CW_ITEMS; it += NGW) convert_item(F, l, it, scr);
}
constexpr int CT_AV = DEPTH * DB * 2 * (PAST / 64), CT_NV = DEPTH * DB * 4 * (PAST / 64), CT_S0 = 2 * DEPTH * DB * 8, CT_ITEMS = CT_AV + CT_NV + CT_S0;
DEV void cache_item(Frame& F, int it, float* scr) {
    int r = it;
    if (r < CT_AV) { const int sb = r % (PAST / 64); int q = r / (PAST / 64); const int h = q % 2; q /= 2; const int b = q % DB; const int l = q / DB;
        transpose_item64(F.P->in[3] + (((size_t)b * DEPTH + l) * PAST) * 128 + h * 64, 128, 0, (bf16*)(F.ws + WS_VACT) + (((size_t)l * DB + b) * 2 + h) * 64 * PAST, PAST, 0, sb * 64, sb * 64, scr, F.lane); return; }
    r -= CT_AV;
    if (r < CT_NV) { const int sb = r % (PAST / 64); int q = r / (PAST / 64); const int h = q % 4; q /= 4; const int b = q % DB; const int l = q / DB;
        transpose_item64(F.P->in[5] + (((size_t)b * DEPTH + l) * PAST) * 256 + h * 64, 256, 0, (bf16*)(F.ws + WS_NVCT) + (((size_t)l * DB + b) * 4 + h) * 64 * PAST, PAST, 0, sb * 64, sb * 64, scr, F.lane); return; }
    r -= CT_NV;
    { const int hd = r % 8; int q = r / 8; const int b = q % DB; q /= DB; const int l = q % DEPTH; const int type = q / DEPTH;
      const float* src = (type == 0 ? F.P->in[6] : F.P->in[7]) + (((size_t)b * DEPTH + l) * 8 + hd) * 4096;
      transpose_item64(src, 64, 0, (bf16*)(F.ws + WS_S0T) + (size_t)r * 4096, 64, 0, 0, 0, scr, F.lane); }
}
DEV void mod_item(Frame& F, int it, float* red, const float* scond) {
    float* MODT = (float*)(F.ws + WS_MODT);
    const int l = it / 48, c0 = (it % 48) * 64;
    const float* wa = F.P->in[10] + (size_t)l * D * 3072 + c0 + F.lane;
    float acc[NCOND];
#pragma unroll
    for (int j = 0; j < NCOND; ++j) acc[j] = 0.f;
    for (int k0 = F.wave * 128; k0 < F.wave * 128 + 128; k0 += 32) {
        float wv[32];
#pragma unroll
        for (int i = 0; i < 32; ++i) wv[i] = NT_LD(wa + (size_t)(k0 + i) * 3072);
#pragma unroll
        for (int i = 0; i < 32; ++i)
#pragma unroll
            for (int j = 0; j < NCOND; ++j) acc[j] += scond[j * D + k0 + i] * wv[i];
    }
#pragma unroll
    for (int j = 0; j < NCOND; ++j) red[(F.wave * NCOND + j) * 64 + F.lane] = acc[j];
    __syncthreads();
    for (int e = F.tid; e < NCOND * 64; e += 512) { const int j = e >> 6, ln = e & 63; float sm = F.P->in[11][(size_t)l * 3072 + c0 + ln];
        for (int w = 0; w < 8; ++w) sm += red[(w * NCOND + j) * 64 + ln];
        MODT[((size_t)l * NCOND + j) * 3072 + c0 + ln] = sm; }
    __syncthreads();
}
DEV void p0_prologue(Frame& F) {
    float* red = (float*)F.lds;
    float* scond = (float*)F.lds + 8 * NCOND * 64;
    float* scr = (float*)(F.lds + F.wave * 16640);
    volatile LAS unsigned* misc = (volatile LAS unsigned*)(F.ldsl + LDS_MISC);
    constexpr int U_MOD = DEPTH * 48, U_CW = (CW_ITEMS + 7) / 8, U_CT = (CT_ITEMS + 7) / 8;
    bool have_scond = false;
    for (;;) {
        __syncthreads();
        if (F.tid == 0) misc[16] = atomicAdd((unsigned*)(F.ws + WS_CTL) + 4096 + 64 * 2, 1u);
        __syncthreads();
        int u = __builtin_amdgcn_readfirstlane((int)misc[16]);
        if (u < U_MOD) {
            if (!have_scond) { for (int e = F.tid; e < NCOND * D; e += 512) { const int j = e / D, k = e % D; scond[e] = silu_f(j == 0 ? F.P->in[9][k] : F.P->in[8][(size_t)(j - 1) * D + k]); }
                __syncthreads(); have_scond = true; }
            mod_item(F, u, red, scond); continue; }
        u -= U_MOD; have_scond = false;
        if (u < U_CW) { const int it = u * 8 + F.wave; if (it < CW_ITEMS) convert_item(F, 0, it, scr); continue; }
        u -= U_CW;
        if (u < U_CT) { const int it = u * 8 + F.wave; if (it < CT_ITEMS) cache_item(F, it, scr); continue; }
        break;
    }
    if (F.bx == F.G - 1) {
        float* RC = (float*)(F.ws + WS_ROPE); float* RS = RC + 1024;
        for (int e = F.tid; e < 1024; e += 512) { const int pos = e >> 4, i = e & 15; const float inv = powf(10000.0f, -(float)i / 16.0f); const float ang = (float)pos * inv; RC[e] = cosf(ang); RS[e] = sinf(ang); }
    }
    const size_t gt = (size_t)F.bx * 512 + F.tid, NT = (size_t)F.G * 512;
    { bf16* KAC = (bf16*)(F.ws + WS_KAC); constexpr size_t n4 = (size_t)DEPTH * DB * 2 * PAST * 16;
#pragma unroll 4
      for (size_t e = gt; e < n4; e += NT) { const int d = (int)(e & 15) * 4; size_t q = e >> 4; const int sq = q % PAST; q /= PAST; const int h = q % 2; q /= 2; const int b = q % DB; const int l = q / DB;
          const f32x4 v = NT_LD((const f32x4*)(F.P->in[2] + ((((size_t)b * DEPTH + l) * PAST + sq) * 2 + h) * 64 + d)); u32x2 w; w.x = pk2(v.x, v.y); w.y = pk2(v.z, v.w); *(u32x2*)(KAC + e * 4) = w; } }
    { bf16* NKC = (bf16*)(F.ws + WS_NKC); constexpr size_t n4 = (size_t)DEPTH * DB * 4 * PAST * 16;
#pragma unroll 4
      for (size_t e = gt; e < n4; e += NT) { const int d = (int)(e & 15) * 4; size_t q = e >> 4; const int sq = q % PAST; q /= PAST; const int h = q % 4; q /= 4; const int b = q % DB; const int l = q / DB;
          const f32x4 v = NT_LD((const f32x4*)(F.P->in[4] + ((((size_t)b * DEPTH + l) * PAST + sq) * 4 + h) * 64 + d)); u32x2 w; w.x = pk2(v.x, v.y); w.y = pk2(v.z, v.w); *(u32x2*)(NKC + e * 4) = w; } }
}

DEV int norm_row0(const Frame& F, int i) { return (F.G * 64 == T && (F.G & 7) == 0) ? (F.bx & 7) * (T / 8) + ((F.bx >> 3) * 8 + F.wave) * 8 + 4 * i : -1; }
DEV void p1_norm(Frame& F, int l) {
    const float* MODT = (const float*)(F.ws + WS_MODT) + (size_t)l * NCOND * 3072;
    const float* ng = F.P->in[12] + (size_t)l * D;
    bf16* HN = (bf16*)(F.ws + WS_HN);
    const int gw = F.bx * 8 + F.wave, NGW = F.G * 8;
    if (F.G * 64 == T && (F.G & 7) == 0) {
        {
            const int t0 = norm_row0(F, 0);
            f32x4 v[8][4]; float s[8];
#pragma unroll
            for (int r = 0; r < 8; ++r) { const int t = t0 + r;
                const float* xrow = (l == 0) ? (t < TC ? F.P->in[0] + (size_t)t * D : F.P->in[1] + (size_t)(t - TC) * D) : F.out + (size_t)t * D;
#pragma unroll
                for (int j = 0; j < 4; ++j) v[r][j] = *(const f32x4*)(xrow + 4 * F.lane + 256 * j); }
#pragma unroll
            for (int r = 0; r < 8; ++r) { float a = 0.f;
#pragma unroll
                for (int j = 0; j < 4; ++j) a += (v[r][j].x * v[r][j].x + v[r][j].y * v[r][j].y) + (v[r][j].z * v[r][j].z + v[r][j].w * v[r][j].w);
                s[r] = 1.0f / sqrtf(wave_sum(a, F.lane) * (1.0f / D) + EPS); }
            const float* md = MODT + (size_t)tok_cond(t0) * 3072;
#pragma unroll
            for (int j = 0; j < 4; ++j) { const int c = 4 * F.lane + 256 * j;
                const f32x4 g = *(const f32x4*)(ng + c), sh = *(const f32x4*)(md + c), sc = *(const f32x4*)(md + 1024 + c); const f32x4 gs = g * (sc + 1.0f);
#pragma unroll
                for (int r = 0; r < 8; ++r) { const f32x4 o = v[r][j] * s[r] * gs + sh;
                    u32x2 w; w.x = pk2(o.x, o.y); w.y = pk2(o.z, o.w); *(u32x2*)(HN + (size_t)(t0 + r) * D + c) = w; } }
        }
        return;
    }
    for (int t = gw; t < T; t += NGW) {
        const float* xrow = (l == 0) ? (t < TC ? F.P->in[0] + (size_t)t * D : F.P->in[1] + (size_t)(t - TC) * D) : F.out + (size_t)t * D;
        const float* md = MODT + (size_t)tok_cond(t) * 3072;
        f32x4 v[4]; float s = 0.f;
#pragma unroll
        for (int j = 0; j < 4; ++j) { v[j] = *(const f32x4*)(xrow + 4 * F.lane + 256 * j); s += (v[j].x * v[j].x + v[j].y * v[j].y) + (v[j].z * v[j].z + v[j].w * v[j].w); }
        const float rstd = 1.0f / sqrtf(wave_sum(s, F.lane) * (1.0f / D) + EPS);
#pragma unroll
        for (int j = 0; j < 4; ++j) { const int c = 4 * F.lane + 256 * j;
            const f32x4 g = *(const f32x4*)(ng + c), sh = *(const f32x4*)(md + c), sc = *(const f32x4*)(md + 1024 + c);
            const f32x4 o = v[j] * rstd * g * (sc + 1.0f) + sh;
            u32x2 w; w.x = pk2(o.x, o.y); w.y = pk2(o.z, o.w); *(u32x2*)(HN + (size_t)t * D + c) = w; }
    }
}

struct EpiIn {
    static constexpr bool PERM = true;
    unsigned char* ws; float* out; const float* qn; const float* kn; const float* alog_; const float* dtb_; int l;
    DEV void operator()(const f32x4 (&acc)[2][2][4][2], const pg8::Unit& u, int wr, int wc, int fr, int fq) const {
        OPAQUE(fr); OPAQUE(fq);
        const int t0 = u.pm * 256; const bool ctx = t0 < TC;
        const int b = ctx ? t0 / SEQ : (t0 - TC) / DSEQ, sb = ctx ? t0 % SEQ : (t0 - TC) % DSEQ, L = ctx ? SEQ : DSEQ;
        const int rl0 = wr * 64 + fr;
        const int pn = u.pn;
        auto plain = [&](bf16* base, int ld, int coloff, int act, float scale) {
#pragma unroll
            for (int ai = 0; ai < 2; ++ai)
#pragma unroll
                for (int m = 0; m < 4; ++m) { const int t = t0 + rl0 + ai * 128 + m * 16; bf16* rowp = base + (size_t)t * ld + coloff + wc * 32 + 8 * fq;
#pragma unroll
                    for (int bj = 0; bj < 2; ++bj) { f32x4 v0 = acc[ai][bj][m][0], v1 = acc[ai][bj][m][1];
                        if (act == 1) { v0.x = silu_f(v0.x); v0.y = silu_f(v0.y); v0.z = silu_f(v0.z); v0.w = silu_f(v0.w); v1.x = silu_f(v1.x); v1.y = silu_f(v1.y); v1.z = silu_f(v1.z); v1.w = silu_f(v1.w); }
                        v0 = v0 * scale; v1 = v1 * scale;
                        u32x4 w; w.x = pk2(v0.x, v0.y); w.y = pk2(v0.z, v0.w); w.z = pk2(v1.x, v1.y); w.w = pk2(v1.z, v1.w);
                        *(u32x4*)(rowp + bj * 128) = w; } CFENCE(); }
        };
        if (pn == 0 || pn == 1) {
            const bool isq = (pn == 0), isv = (pn == 1 && wc >= 2);
            const float* gn = isq ? qn : kn;
            f32x4 gnv[2][2];
#pragma unroll
            for (int bj = 0; bj < 2; ++bj)
#pragma unroll
                for (int n = 0; n < 2; ++n) gnv[bj][n] = *(const f32x4*)(gn + 32 * bj + 16 * n + 4 * fq);
            const float* RC = (const float*)(ws + WS_ROPE); const float* RS = RC + 1024;
#pragma unroll
            for (int ai = 0; ai < 2; ++ai)
#pragma unroll
                for (int m = 0; m < 4; ++m) {
                    const int rl = rl0 + ai * 128 + m * 16, t = t0 + rl, s = sb + rl;
                    f32x4 x[2][2];
#pragma unroll
                    for (int bj = 0; bj < 2; ++bj)
#pragma unroll
                        for (int n = 0; n < 2; ++n) x[bj][n] = acc[ai][bj][m][n];
                    if (!isv) {
                        float ss = 0.f;
#pragma unroll
                        for (int bj = 0; bj < 2; ++bj)
#pragma unroll
                            for (int n = 0; n < 2; ++n) ss += (x[bj][n].x * x[bj][n].x + x[bj][n].y * x[bj][n].y) + (x[bj][n].z * x[bj][n].z + x[bj][n].w * x[bj][n].w);
                        ss += shx(ss, 16, fr + 16 * fq); ss += shx(ss, 32, fr + 16 * fq);
                        const float rstd = 1.0f / sqrtf(ss * (1.0f / 64.0f) + EPS);
#pragma unroll
                        for (int bj = 0; bj < 2; ++bj)
#pragma unroll
                            for (int n = 0; n < 2; ++n) x[bj][n] = x[bj][n] * rstd * gnv[bj][n];
                    }
                    if (pn == 1 && ctx) {
                        float* dst = out + (wc < 2 ? O_AK : O_AV) + (((size_t)b * DEPTH + l) * SEQ + s) * 128 + (wc & 1) * 64;
#pragma unroll
                        for (int bj = 0; bj < 2; ++bj)
#pragma unroll
                            for (int n = 0; n < 2; ++n) NT_ST((f32x4*)(dst + 32 * bj + 16 * n + 4 * fq), x[bj][n]);
                    }
                    if (!isv && !ctx) {
#pragma unroll
                        for (int bj = 0; bj < 2; ++bj) { const int pos = bj == 0 ? (s >> 6) : (s & 63);
                            const f32x4 cs = *(const f32x4*)(RC + pos * 16 + 4 * fq), sn = *(const f32x4*)(RS + pos * 16 + 4 * fq);
                            const f32x4 x1 = x[bj][0], x2 = x[bj][1];
                            x[bj][0] = x1 * cs - x2 * sn; x[bj][1] = x2 * cs + x1 * sn; }
                    }
                    if (isq) {
                        bf16* dst = (bf16*)(ws + WS_QA) + (size_t)t * 256 + wc * 64;
#pragma unroll
                        for (int bj = 0; bj < 2; ++bj)
#pragma unroll
                            for (int n = 0; n < 2; ++n) { const f32x4 v = x[bj][n] * (0.125f * 1.4426950408889634f); u32x2 w; w.x = pk2(v.x, v.y); w.y = pk2(v.z, v.w); *(u32x2*)(dst + 32 * bj + 16 * n + 4 * fq) = w; }
                    } else if (!isv) {
                        bf16* dst = (bf16*)(ws + WS_KA) + (ctx ? (size_t)0 : (size_t)TC * 128) + (((size_t)b * 2 + wc) * L + s) * 64;
#pragma unroll
                        for (int bj = 0; bj < 2; ++bj)
#pragma unroll
                            for (int n = 0; n < 2; ++n) { const f32x4 v = x[bj][n]; u32x2 w; w.x = pk2(v.x, v.y); w.y = pk2(v.z, v.w); *(u32x2*)(dst + 32 * bj + 16 * n + 4 * fq) = w; }
                    } else {
                        bf16* dst = (bf16*)(ws + WS_VAT) + (ctx ? (size_t)0 : (size_t)TC * 128) + ((size_t)b * 2 + (wc - 2)) * 64 * L + s;
#pragma unroll
                        for (int bj = 0; bj < 2; ++bj)
#pragma unroll
                            for (int n = 0; n < 2; ++n) { const int d0 = 32 * bj + 16 * n + 4 * fq;
                                dst[(size_t)(d0 + 0) * L] = (bf16)f2bf(x[bj][n].x); dst[(size_t)(d0 + 1) * L] = (bf16)f2bf(x[bj][n].y);
                                dst[(size_t)(d0 + 2) * L] = (bf16)f2bf(x[bj][n].z); dst[(size_t)(d0 + 3) * L] = (bf16)f2bf(x[bj][n].w); }
                    }
                    CFENCE();
                }
        } else if (pn == 2) plain((bf16*)(ws + WS_BR), 1024, 0, 1, 1.f);
        else if (pn >= 3 && pn <= 5) plain((bf16*)(ws + WS_GQKV), 768, (pn - 3) * 256, 0, 1.f);
        else if (pn == 6) plain((bf16*)(ws + WS_BR), 1024, 256, 1, 1.f);
        else if (pn == 7 || pn == 8) plain((bf16*)(ws + WS_RQKV), 512, (pn - 7) * 256, 0, pn == 7 ? 0.125f : 1.f);
        else if (pn == 10) plain((bf16*)(ws + WS_BR), 1024, 512, 1, 1.f);
        else if (pn == 11) plain((bf16*)(ws + WS_NQ), 256, 0, 0, 0.125f * 1.4426950408889634f);
        else if (pn == 12 || pn == 13 || pn == 9) {
            const bool isk = pn == 12; const bool isr = pn == 9;
#pragma unroll
            for (int ai = 0; ai < 2; ++ai)
#pragma unroll
                for (int m = 0; m < 4; ++m) { const int rl = rl0 + ai * 128 + m * 16, s = sb + rl;
#pragma unroll
                    for (int bj = 0; bj < 2; ++bj) { const int head = 2 * bj + (wc >> 1), d0 = 32 * (wc & 1) + 8 * fq;
                        const f32x4 v0 = acc[ai][bj][m][0], v1 = acc[ai][bj][m][1];
                        if (ctx && !isr) { float* dst = out + (isk ? O_NK : O_NV) + (((size_t)b * DEPTH + l) * SEQ + s) * 256 + head * 64 + d0; NT_ST((f32x4*)dst, v0); NT_ST((f32x4*)(dst + 4), v1); }
                        if (isk) { bf16* dst = (bf16*)(ws + WS_NK) + (ctx ? (size_t)0 : (size_t)TC * 256) + (((size_t)b * 4 + head) * L + s) * 64 + d0;
                            u32x4 w; w.x = pk2(v0.x, v0.y); w.y = pk2(v0.z, v0.w); w.z = pk2(v1.x, v1.y); w.w = pk2(v1.z, v1.w); *(u32x4*)dst = w; }
                        else { bf16* dst = (bf16*)(ws + (isr ? WS_RVT : WS_NVT)) + (ctx ? (size_t)0 : (size_t)TC * 256) + (((size_t)b * 4 + head) * 64 + d0) * L + s;
                            dst[0] = (bf16)f2bf(v0.x); dst[(size_t)L] = (bf16)f2bf(v0.y); dst[(size_t)2 * L] = (bf16)f2bf(v0.z); dst[(size_t)3 * L] = (bf16)f2bf(v0.w);
                            dst[(size_t)4 * L] = (bf16)f2bf(v1.x); dst[(size_t)5 * L] = (bf16)f2bf(v1.y); dst[(size_t)6 * L] = (bf16)f2bf(v1.z); dst[(size_t)7 * L] = (bf16)f2bf(v1.w); } } CFENCE(); }
        } else if (pn == 14) plain((bf16*)(ws + WS_BR), 1024, 768, 1, 1.f);
        else {
            if (wc == 0 && fq < 2) {
                const float* alog = alog_; const float* dtb = dtb_;
                float* GAB = (float*)(ws + WS_GAB);
#pragma unroll
                for (int ai = 0; ai < 2; ++ai)
#pragma unroll
                    for (int m = 0; m < 4; ++m) { const int t = t0 + rl0 + ai * 128 + m * 16;
#pragma unroll
                        for (int n = 0; n < 2; ++n) { const int c = 8 * fq + 4 * n; const f32x4 v = acc[ai][0][m][n]; f32x4 o;
                            if (c < 8) { o.x = sigmoid_f(v.x); o.y = sigmoid_f(v.y); o.z = sigmoid_f(v.z); o.w = sigmoid_f(v.w); }
                            else { const int dir = (c >> 2) - 2;
                                o.x = -__expf(alog[dir * 4 + 0]) * softplus_f(v.x + dtb[dir * 4 + 0]); o.y = -__expf(alog[dir * 4 + 1]) * softplus_f(v.y + dtb[dir * 4 + 1]);
                                o.z = -__expf(alog[dir * 4 + 2]) * softplus_f(v.z + dtb[dir * 4 + 2]); o.w = -__expf(alog[dir * 4 + 3]) * softplus_f(v.w + dtb[dir * 4 + 3]); }
                            *(f32x4*)(GAB + (size_t)t * 16 + c) = o; } CFENCE(); }
            }
        }
    }
};

DEV f32x4 mfma4(float a, float b, f32x4 c) { return __builtin_amdgcn_mfma_f32_16x16x4f32(a, b, c, 0, 0, 0); }
constexpr int GP = 72;
constexpr int TS_ = 68;
constexpr int G_TM = 0, G_KR = 17408, G_QR = G_KR + 9216, G_KT = G_QR + 9216, G_VT = G_KT + 9216, G_ST = G_VT + 9216, G_VEC = G_ST + 9216, G_HALF = G_VEC + 1536;
static_assert(2 * G_HALF <= 143360, "GDN LDS map");
DEV unsigned char* g_tm(unsigned char* lds, int half) { return lds + half * 17408; }
DEV unsigned char* g_half(unsigned char* lds, int half) { return lds + 2 * 17408 + half * (G_HALF - 17408); }
#define GOFF(x) ((x) - 17408)

DEV f32x4 bmma(bf16x8 a, bf16x8 b, f32x4 c) { return __builtin_amdgcn_mfma_f32_16x16x32_bf16(a, b, c, 0, 0, 0); }
DEV bf16x8 pack8(f32x4 lo, f32x4 hi) { u32x4 u; u.x = pk2(lo.x, lo.y); u.y = pk2(lo.z, lo.w); u.z = pk2(hi.x, hi.y); u.w = pk2(hi.z, hi.w); return __builtin_bit_cast(bf16x8, u); }
DEV bf16x8 ld8(const bf16* p) { return *(const bf16x8*)p; }
DEV bf16x8 ld44(const bf16* p0, const bf16* p1) { const u32x2 a = *(const u32x2*)p0, b = *(const u32x2*)p1; u32x4 u; u.x = a.x; u.y = a.y; u.z = b.x; u.w = b.y; return __builtin_bit_cast(bf16x8, u); }

constexpr int G_PB = 130048;
constexpr size_t WS_ZERO = WS_CTL + 32768;
constexpr int G_TB = G_PB + 26112;
DEV void gdn_dma(Frame& F, int l, int task) {
    const int chunk = task >> 2, head = task & 3, tid = F.tid;
    const int t0 = chunk * 64; const bool ctx = t0 < TC;
    const int L = ctx ? SEQ : DSEQ, s0 = ctx ? t0 % SEQ : (t0 - TC) % DSEQ, tseq = t0 - s0;
    const bf16* SRC = (const bf16*)(F.ws + WS_GQKV); const bf16* ZR = (const bf16*)(F.ws + WS_ZERO);
#pragma unroll
    for (int k = 0; k < 4; ++k) { const int e = tid + 512 * k; const int rr = e / 24, c8 = e % 24; const int sp = s0 - 2 + rr;
        const bf16* src = (sp >= 0 && sp < L) ? SRC + (size_t)(tseq + sp) * 768 + (c8 >> 3) * 256 + head * 64 + (c8 & 7) * 8 : ZR;
        if (e < 68 * 24) __builtin_amdgcn_global_load_lds((const unsigned*)src, (LAS unsigned*)(F.ldsl + G_PB + (F.wave * 64 + 512 * k) * 16), 16, 0, 0); }
#pragma unroll
    for (int rr = 0; rr < 2; ++rr) { const int r = F.wave * 2 + rr;
        if (r < 15) { const float* src = F.P->in[14] + (size_t)l * 5 * 768 + (r % 5) * 768 + (r / 5) * 256 + head * 64 + F.lane;
            __builtin_amdgcn_global_load_lds((const unsigned*)src, (LAS unsigned*)(F.ldsl + G_TB + r * 256), 4, 0, 0); } }
}
DEV void gdn_dma_wait() { PG8_WAIT_V(0); __syncthreads(); }
struct GdnPre { float ga[2]; };
template <bool NEEDQ>
DEV void gdn_prefetch(Frame& F, int l, int task, GdnPre& P) {
    const int chunk = task >> 2, head = task & 3, lane = F.lane, half = F.wave >> 2, wq = F.wave & 3;
    const int t0 = chunk * 64; const bool ctx = t0 < TC;
    const int s0 = ctx ? t0 % SEQ : (t0 - TC) % DSEQ, tseq = t0 - s0;
    P.ga[0] = 0.f; P.ga[1] = 0.f;
    if (wq == 3) { const int s = s0 + (half ? 63 - lane : lane); const float* ga = (const float*)(F.ws + WS_GAB) + (size_t)(tseq + s) * 16; P.ga[0] = ga[8 + half * 4 + head]; P.ga[1] = ga[half * 4 + head]; }
}
DEV bf16x8* gdn_tf(const Frame& F, int task, int half) { const size_t slot = (size_t)task * 2 + half; return (bf16x8*)(F.ws + (slot < TF_NA ? WS_WIN + slot * TF_SLOT : WS_TFB + (slot - TF_NA) * TF_SLOT)); }
template <bool NEEDQ, bool SKIPT = false>
DEV void gdn_front(Frame& F, int l, int chunk, int head, const GdnPre& P, int ntask, GdnPre& N) {
    const int tid = F.tid, lane = F.lane, li = lane & 15, lq = lane >> 4, half = F.wave >> 2, wq = F.wave & 3, dir = half;
    unsigned char* lds = F.lds;
    const int t0 = chunk * 64; const bool ctx = t0 < TC;
    const int L = ctx ? SEQ : DSEQ, s0 = ctx ? t0 % SEQ : (t0 - TC) % DSEQ, tseq = t0 - s0;
    const bf16* raw = (const bf16*)(lds + G_PB);
    float* Tm = (float*)g_tm(lds, half);
    unsigned char* hb = g_half(lds, half);
    bf16* kr = (bf16*)(hb + GOFF(G_KR)); bf16* qr = (bf16*)(hb + GOFF(G_QR)); bf16* kT = (bf16*)(hb + GOFF(G_KT)); bf16* vT = (bf16*)(hb + GOFF(G_VT));
    float* vec = (float*)(hb + GOFF(G_VEC)); float* gs = vec; float* bs = vec + 64; float* rnk = vec + 128; float* rnq = vec + 192; float* sc1 = vec + 256; float* scd = vec + 320;
    {
        LAS bf16* H0 = (LAS bf16*)(F.ldsl + 2 * 17408); LAS bf16* H1 = (LAS bf16*)(F.ldsl + 2 * 17408 + (G_HALF - 17408));
        const int pb = 32 * half + 8 * wq;
#pragma unroll
        for (int t = NEEDQ ? 0 : 1; t < 3; ++t) {
            const bf16* rc = raw + t * 64 + lane;
            float w5[5];
#pragma unroll
            for (int j = 0; j < 5; ++j) w5[j] = ((const float*)(lds + G_TB))[(t * 5 + j) * 64 + lane];
            const int orow = (t == 0 ? GOFF(G_QR) : GOFF(G_KR)) / 2, otr = (t == 1 ? GOFF(G_KT) : GOFF(G_VT)) / 2;
            float x0 = bf2f(rc[(pb + 0) * 192]), x1 = bf2f(rc[(pb + 1) * 192]), x2 = bf2f(rc[(pb + 2) * 192]), x3 = bf2f(rc[(pb + 3) * 192]);
            float yv[8];
#pragma unroll
            for (int e = 0; e < 8; ++e) { const int p = pb + e; const float x4 = bf2f(rc[(p + 4) * 192]);
                const float y = x0 * w5[0] + x1 * w5[1] + x2 * w5[2] + x3 * w5[3] + x4 * w5[4];
                x0 = x1; x1 = x2; x2 = x3; x3 = x4;
                yv[e] = silu_f(y);
                if (t < 2) { const bf16 yb = (bf16)f2bf(yv[e]); H0[orow + p * GP + lane] = yb; H1[orow + (63 - p) * GP + lane] = yb; } }
            if (t > 0) {
                u32x4 f, r; f.x = pk2(yv[0], yv[1]); f.y = pk2(yv[2], yv[3]); f.z = pk2(yv[4], yv[5]); f.w = pk2(yv[6], yv[7]);
                r.x = pk2(yv[7], yv[6]); r.y = pk2(yv[5], yv[4]); r.z = pk2(yv[3], yv[2]); r.w = pk2(yv[1], yv[0]);
                *(LAS u32x4*)(H0 + otr + lane * GP + pb) = f;
                *(LAS u32x4*)(H1 + otr + lane * GP + (56 - pb)) = r; }
        }
    }
    if (wq == 3) {
        float g = P.ga[0];
#pragma unroll
        for (int o = 1; o < 64; o <<= 1) { const float v = shf(g, lane >= o ? lane - o : lane); if (lane >= o) g += v; }
        gs[lane] = g; bs[lane] = P.ga[1];
    }
    __syncthreads();
    gdn_dma(F, l, ntask); gdn_prefetch<NEEDQ>(F, l, ntask, N);
    if (wq == 0 || (NEEDQ && wq == 1)) {
        const bf16* row = (wq == 0 ? kr : qr) + lane * GP; float ss = 0.f;
#pragma unroll
        for (int c = 0; c < 8; ++c) { const u32x4 v = *(const u32x4*)(row + 8 * c);
            const float a0 = bf2f(v.x & 0xffffu), a1 = bf2f(v.x >> 16), a2 = bf2f(v.y & 0xffffu), a3 = bf2f(v.y >> 16), a4 = bf2f(v.z & 0xffffu), a5 = bf2f(v.z >> 16), a6 = bf2f(v.w & 0xffffu), a7 = bf2f(v.w >> 16);
            ss += (a0 * a0 + a1 * a1) + (a2 * a2 + a3 * a3) + (a4 * a4 + a5 * a5) + (a6 * a6 + a7 * a7); }
        const float rn = 1.0f / sqrtf(ss + EPS);
        if (wq == 0) { rnk[lane] = rn; sc1[lane] = bs[lane] * __expf(gs[lane]) * rn; scd[lane] = rn * __expf(gs[63] - gs[lane]); }
        else rnq[lane] = rn * 0.125f;
    }
    __syncthreads();
    if constexpr (SKIPT) return;
    {
        auto a_tile = [&](int ti, int tj) {
            f32x4 c = {0.f, 0.f, 0.f, 0.f};
#pragma unroll
            for (int ks = 0; ks < 2; ++ks) c = bmma(ld8(kr + (16 * ti + li) * GP + 32 * ks + 8 * lq), ld8(kr + (16 * tj + li) * GP + 32 * ks + 8 * lq), c);
            const int j = 16 * tj + li; const float gj = gs[j], rj = rnk[j];
            const f32x4 gi4 = *(const f32x4*)(gs + 16 * ti + 4 * lq), bi4 = *(const f32x4*)(bs + 16 * ti + 4 * lq), ri4 = *(const f32x4*)(rnk + 16 * ti + 4 * lq);
#pragma unroll
            for (int r = 0; r < 4; ++r) { const int i = 16 * ti + 4 * lq + r; Tm[i * TS_ + j] = (i > j) ? c[r] * bi4[r] * ri4[r] * rj * __expf(gi4[r] - gj) : 0.f; }
        };
        auto z_tile = [&](int ti, int tj) {
#pragma unroll
            for (int r = 0; r < 4; ++r) Tm[(16 * ti + 4 * lq + r) * TS_ + 16 * tj + li] = 0.f; };
        if (wq == 0) { a_tile(0, 0); a_tile(3, 3); a_tile(3, 0); z_tile(0, 1); }
        else if (wq == 1) { a_tile(1, 1); a_tile(1, 0); a_tile(3, 1); z_tile(0, 2); }
        else if (wq == 2) { a_tile(2, 2); a_tile(2, 0); a_tile(3, 2); z_tile(0, 3); }
        else { a_tile(2, 1); z_tile(1, 2); z_tile(1, 3); z_tile(2, 3); }
    }
    __syncthreads();
    if (wq == half) {
        {   int cc = li; OPAQUE(cc);
            float* Ab = Tm + (16 * lq) * TS_ + 16 * lq;
            float x[16];
#pragma unroll
            for (int r = 0; r < 16; ++r) {
                float a0 = (r == cc) ? 1.f : 0.f, a1 = 0.f;
#pragma unroll
                for (int j4 = 0; j4 < (r + 3) / 4; ++j4) { const f32x4 a = *(const f32x4*)(Ab + r * TS_ + 4 * j4);
                    if (4 * j4 + 0 < r) a0 -= a.x * x[4 * j4 + 0];
                    if (4 * j4 + 1 < r) a1 -= a.y * x[4 * j4 + 1];
                    if (4 * j4 + 2 < r) a0 -= a.z * x[4 * j4 + 2];
                    if (4 * j4 + 3 < r) a1 -= a.w * x[4 * j4 + 3]; }
                x[r] = a0 + a1;
            }
            WAVE_SYNC();
#pragma unroll
            for (int r = 0; r < 16; ++r) Ab[r * TS_ + li] = x[r];
        }
        WAVE_SYNC();
#pragma unroll
        for (int i = 1; i < 4; ++i) {
            f32x4 Xr[3];
#pragma unroll
            for (int j = 0; j < 3; ++j) { if (j < i) {
                f32x4 M = {0.f, 0.f, 0.f, 0.f};
#pragma unroll
                for (int k = 0; k < 3; ++k) { if (k >= j && k < i) {
#pragma unroll
                    for (int ks = 0; ks < 4; ++ks) M = mfma4(Tm[(16 * i + li) * TS_ + 16 * k + 4 * ks + lq], Tm[(16 * k + 4 * ks + lq) * TS_ + 16 * j + li], M); } }
                f32x4 X = {0.f, 0.f, 0.f, 0.f};
#pragma unroll
                for (int r = 0; r < 4; ++r) X = mfma4(Tm[(16 * i + li) * TS_ + 16 * i + 4 * lq + r], M[r], X);
                Xr[j] = X; } }
            WAVE_SYNC();
#pragma unroll
            for (int j = 0; j < 3; ++j) { if (j < i) {
#pragma unroll
                for (int r = 0; r < 4; ++r) Tm[(16 * i + 4 * lq + r) * TS_ + 16 * j + li] = -Xr[j][r]; } }
            WAVE_SYNC();
        }
    }
    __syncthreads();
}

DEV void gdn_a_task(Frame& F, int l, int task, const GdnPre& pre, int ntask, GdnPre& nxt) {
    const int chunk = task >> 2, head = task & 3;
    gdn_dma_wait();
    gdn_front<false>(F, l, chunk, head, pre, ntask, nxt);
    if ((F.wave & 3) == 3) {
        const int li_ = F.lane & 15, lq_ = F.lane >> 4; const float* Tm_ = (const float*)g_tm(F.lds, F.wave >> 2); bf16x8* TF = gdn_tf(F, task, F.wave >> 2);
#pragma unroll
        for (int tc = 0; tc < 4; ++tc) { const float* tp = Tm_ + (16 * tc + li_) * TS_ + 4 * lq_; const int j0 = tc < 2 ? tc : 2 * tc - 2;
            TF[j0 * 64 + F.lane] = pack8(*(const f32x4*)tp, *(const f32x4*)(tp + 16));
            if (tc >= 2) TF[(j0 + 1) * 64 + F.lane] = pack8(*(const f32x4*)(tp + 32), *(const f32x4*)(tp + 48)); }
    }
    const int lane = F.lane, li = lane & 15, lq = lane >> 4, half = F.wave >> 2, tj = F.wave & 3, dir = half;
    const float* Tm = (const float*)g_tm(F.lds, half);
    unsigned char* hb = g_half(F.lds, half);
    const bf16* kT = (const bf16*)(hb + GOFF(G_KT)); const bf16* vT = (const bf16*)(hb + GOFF(G_VT));
    const float* vec = (const float*)(hb + GOFF(G_VEC)); const float* gs = vec; const float* bs = vec + 64; const float* sc1 = vec + 256; const float* scd = vec + 320;
    f32x4 w[4], u[4];
#pragma unroll
    for (int tc = 0; tc < 4; ++tc) { w[tc] = (f32x4){0.f, 0.f, 0.f, 0.f}; u[tc] = w[tc];
#pragma unroll
        for (int ks = 0; ks < 2; ++ks) { if (32 * ks <= 16 * tc + 15) {
            const float* tp = Tm + (16 * tc + li) * TS_ + 32 * ks + 8 * lq;
            const f32x4 t0 = *(const f32x4*)tp, t1 = *(const f32x4*)(tp + 4);
            const f32x4 s0 = *(const f32x4*)(sc1 + 32 * ks + 8 * lq), s1 = *(const f32x4*)(sc1 + 32 * ks + 8 * lq + 4);
            const f32x4 b0 = *(const f32x4*)(bs + 32 * ks + 8 * lq), b1 = *(const f32x4*)(bs + 32 * ks + 8 * lq + 4);
            w[tc] = bmma(pack8(t0 * s0, t1 * s1), ld8(kT + (16 * tj + li) * GP + 32 * ks + 8 * lq), w[tc]);
            u[tc] = bmma(pack8(t0 * b0, t1 * b1), ld8(vT + (16 * tj + li) * GP + 32 * ks + 8 * lq), u[tc]); } }
         }
#pragma unroll
    for (int tc = 0; tc < 4; ++tc) { const f32x4 sd = *(const f32x4*)(scd + 16 * tc + 4 * lq); w[tc] = w[tc] * sd; u[tc] = u[tc] * sd; }
    const bf16x8 wb0 = pack8(w[0], w[1]), wb1 = pack8(w[2], w[3]), ub0 = pack8(u[0], u[1]), ub1 = pack8(u[2], u[3]);
    const float egl = __expf(gs[63]);
    const size_t cell = ((size_t)chunk * 4 + head) * 2 + dir;
    float* Mb = (float*)(F.ws + WS_MB) + cell * 4096; float* Bb = (float*)(F.ws + WS_BS) + cell * 4096;
#pragma unroll
    for (int tk = 0; tk < 4; ++tk) {
        const bf16* kp = kT + (16 * tk + li) * GP + 4 * lq;
        const bf16x8 a0 = ld44(kp, kp + 16), a1 = ld44(kp + 32, kp + 48);
        f32x4 m = {0.f, 0.f, 0.f, 0.f}, bm = m;
        m = bmma(a0, wb0, m); m = bmma(a1, wb1, m); bm = bmma(a0, ub0, bm); bm = bmma(a1, ub1, bm);
#pragma unroll
        for (int r = 0; r < 4; ++r) { const int dk = 16 * tk + 4 * lq + r, dk2 = 16 * tj + li; Mb[dk * 64 + dk2] = (dk == dk2 ? egl : 0.f) - m[r]; }
        *(f32x4*)(Bb + ((tj * 4 + tk) * 64 + lane) * 4) = bm;

    }
    __syncthreads();
}
constexpr int N_GDN_TASKS = (T / 64) * 4;

DEV void gdn_b_wave(Frame& F, int l, int task) {
    const int lane = F.lane, li = lane & 15, lq = lane >> 4;
    const int tj = task & 3; int q = task >> 2; const int dir = q & 1; q >>= 1; const int head = q & 3; q >>= 2;
    const int seq = q < DB ? NB + q : q - DB;
    const bool ctx = seq < NB; const int L = ctx ? SEQ : DSEQ, nch = L / 64, tseq = ctx ? seq * SEQ : TC + (seq - NB) * DSEQ;
    f32x4 S[4];
    if (ctx) {
#pragma unroll
        for (int ti = 0; ti < 4; ++ti) S[ti] = (f32x4){0.f, 0.f, 0.f, 0.f};
    } else {
        const float* s0 = F.P->in[6] + ((((size_t)(seq - NB) * DEPTH + l) * 2 + dir) * 4 + head) * 4096;
#pragma unroll
        for (int ti = 0; ti < 4; ++ti)
#pragma unroll
            for (int r = 0; r < 4; ++r) S[ti][r] = s0[(16 * ti + 4 * lq + r) * 64 + 16 * tj + li];
    }
    f32x4 mf[4][4], bm[4];
    auto cell_of = [&](int n) { const int c = dir ? nch - 1 - n : n; return ((size_t)(tseq / 64 + c) * 4 + head) * 2 + dir; };
    auto load_step = [&](int n, f32x4 (&m)[4][4], f32x4 (&b)[4]) { const size_t cell = cell_of(n);
        const float* Mb = (const float*)(F.ws + WS_MB) + cell * 4096; const float* Bb = (const float*)(F.ws + WS_BS) + cell * 4096;
#pragma unroll
        for (int ti = 0; ti < 4; ++ti) { b[ti] = *(const f32x4*)(Bb + ((tj * 4 + ti) * 64 + lane) * 4);
#pragma unroll
            for (int kb = 0; kb < 4; ++kb) m[ti][kb] = *(const f32x4*)(Mb + (16 * ti + li) * 64 + 16 * kb + 4 * lq); } };
    load_step(0, mf, bm);
    for (int n = 0; n < nch; ++n) {
        f32x4 mfn[4][4], bmn[4];
        if (n + 1 < nch) load_step(n + 1, mfn, bmn);
        float* Bb = (float*)(F.ws + WS_BS) + cell_of(n) * 4096;
        f32x4 nS[4];
#pragma unroll
        for (int ti = 0; ti < 4; ++ti) { nS[ti] = bm[ti]; *(f32x4*)(Bb + ((tj * 4 + ti) * 64 + lane) * 4) = S[ti]; }
#pragma unroll
        for (int kb = 0; kb < 4; ++kb)
#pragma unroll
            for (int r = 0; r < 4; ++r)
#pragma unroll
                for (int ti = 0; ti < 4; ++ti) nS[ti] = mfma4(mf[ti][kb][r], S[kb][r], nS[ti]);
#pragma unroll
        for (int ti = 0; ti < 4; ++ti) { S[ti] = nS[ti]; bm[ti] = bmn[ti];
#pragma unroll
            for (int kb = 0; kb < 4; ++kb) mf[ti][kb] = mfn[ti][kb]; }
    }
    if (ctx) { float* dst = F.out + O_SG + ((((size_t)seq * DEPTH + l) * 2 + dir) * 4 + head) * 4096;
#pragma unroll
        for (int ti = 0; ti < 4; ++ti)
#pragma unroll
            for (int r = 0; r < 4; ++r) dst[(16 * ti + 4 * lq + r) * 64 + 16 * tj + li] = S[ti][r]; }
}
constexpr int N_GDNB_TASKS = NSEQ * 32;

template <bool DRY = false>
DEV void gdn_c_task(Frame& F, int l, int task, const GdnPre& pre, int ntask, GdnPre& nxt) {
    const int chunk = task >> 2, head = task & 3;
    const int tid = F.tid, lane = F.lane, li = lane & 15, lq = lane >> 4, half = F.wave >> 2, tj = F.wave & 3, dir = half;
    unsigned char* hb = g_half(F.lds, half);
    gdn_dma_wait();
    f32x4 sn[4]; u32x2 zc0, zc1;
    { const size_t cell = ((size_t)chunk * 4 + head) * 2 + half; const float* Sb = (const float*)(F.ws + WS_BS) + cell * 4096; const int ht = tid & 255;
#pragma unroll
      for (int e = 0; e < 4; ++e) sn[e] = *(const f32x4*)(Sb + (size_t)(ht + 256 * e) * 4);
      const bf16* zb = (const bf16*)(F.ws + WS_BR) + (size_t)(chunk * 64 + 8 * F.wave + (lane >> 4)) * 1024 + 256 + head * 64 + 4 * (lane & 15);
      zc0 = *(const u32x2*)zb; zc1 = *(const u32x2*)(zb + 4 * 1024); }
    const f32x4 gg = *(const f32x4*)(F.P->in[17] + l * 64 + 4 * li);
    bf16x8 tf[6];
    { const bf16x8* TF = gdn_tf(F, task, half);
#pragma unroll
      for (int j = 0; j < 6; ++j) tf[j] = TF[j * 64 + lane]; }
    gdn_front<true, true>(F, l, chunk, head, pre, ntask, nxt);
    {
        bf16* sT = (bf16*)(hb + GOFF(G_ST));
        const int ht = tid & 255;
#pragma unroll
        for (int e = 0; e < 4; ++e) { const int idx = ht + 256 * e;
            const f32x4 v = sn[e]; const int ln = idx & 63, ti2 = (idx >> 6) & 3, tj2 = idx >> 8;
            const int dv = 16 * tj2 + (ln & 15), dk = 16 * ti2 + 4 * (ln >> 4);
            u32x2 w; w.x = pk2(v.x, v.y); w.y = pk2(v.z, v.w); *(u32x2*)(sT + dv * GP + dk) = w; }
    }
    __syncthreads();
    float* Tm = (float*)g_tm(F.lds, half);
    const bf16* kr = (const bf16*)(hb + GOFF(G_KR)); const bf16* qr = (const bf16*)(hb + GOFF(G_QR)); const bf16* vT = (const bf16*)(hb + GOFF(G_VT)); const bf16* sT = (const bf16*)(hb + GOFF(G_ST));
    const float* vec = (const float*)(hb + GOFF(G_VEC)); const float* gs = vec; const float* bs = vec + 64; const float* rnk = vec + 128; const float* rnq = vec + 192;
    f32x4 X[4];
#pragma unroll
    for (int tc = 0; tc < 4; ++tc) { f32x4 a = {0.f, 0.f, 0.f, 0.f};
#pragma unroll
        for (int ks = 0; ks < 2; ++ks) a = bmma(ld8(kr + (16 * tc + li) * GP + 32 * ks + 8 * lq), ld8(sT + (16 * tj + li) * GP + 32 * ks + 8 * lq), a);
        const u32x2 vv = *(const u32x2*)(vT + (16 * tj + li) * GP + 16 * tc + 4 * lq);
        const f32x4 vf = {bf2f(vv.x & 0xffffu), bf2f(vv.x >> 16), bf2f(vv.y & 0xffffu), bf2f(vv.y >> 16)};
        const f32x4 g4 = *(const f32x4*)(gs + 16 * tc + 4 * lq), b4 = *(const f32x4*)(bs + 16 * tc + 4 * lq), r4 = *(const f32x4*)(rnk + 16 * tc + 4 * lq);
#pragma unroll
        for (int r = 0; r < 4; ++r) X[tc][r] = b4[r] * (vf[r] - __expf(g4[r]) * r4[r] * a[r]); }

    f32x4 vn[4];
    { const bf16x8 xb0 = pack8(X[0], X[1]), xb1 = pack8(X[2], X[3]);
#pragma unroll
      for (int tc = 0; tc < 4; ++tc) { const int j0 = tc < 2 ? tc : 2 * tc - 2; f32x4 a = {0.f, 0.f, 0.f, 0.f};
          a = bmma(tf[j0], xb0, a);
          if (tc >= 2) a = bmma(tf[j0 + 1], xb1, a);
          vn[tc] = a; } }
    const bf16x8 vb0 = pack8(vn[0], vn[1]), vb1 = pack8(vn[2], vn[3]);

    f32x4 o[4];
#pragma unroll
    for (int ti = 0; ti < 4; ++ti) { f32x4 a = {0.f, 0.f, 0.f, 0.f};
#pragma unroll
        for (int ks = 0; ks < 2; ++ks) a = bmma(ld8(qr + (16 * ti + li) * GP + 32 * ks + 8 * lq), ld8(sT + (16 * tj + li) * GP + 32 * ks + 8 * lq), a);
        const f32x4 g4 = *(const f32x4*)(gs + 16 * ti + 4 * lq), q4 = *(const f32x4*)(rnq + 16 * ti + 4 * lq);
#pragma unroll
        for (int r = 0; r < 4; ++r) a[r] *= q4[r] * __expf(g4[r]);
        o[ti] = a; }
    {
        bf16* QKL = (bf16*)g_tm(F.lds, half);
        auto qk_tile = [&](int ti, int tc) {
            f32x4 a = {0.f, 0.f, 0.f, 0.f};
#pragma unroll
            for (int ks = 0; ks < 2; ++ks) a = bmma(ld8(kr + (16 * tc + li) * GP + 32 * ks + 8 * lq), ld8(qr + (16 * ti + li) * GP + 32 * ks + 8 * lq), a);
            const int i = 16 * ti + li; const float gi = gs[i], rqi = rnq[i];
            const f32x4 gc = *(const f32x4*)(gs + 16 * tc + 4 * lq), rc = *(const f32x4*)(rnk + 16 * tc + 4 * lq);
#pragma unroll
            for (int r = 0; r < 4; ++r) { const int c = 16 * tc + 4 * lq + r; a[r] = (i >= c) ? a[r] * rc[r] * rqi * __expf(gi - gc[r]) : 0.f; }
            u32x2 w; w.x = pk2(a.x, a.y); w.y = pk2(a.z, a.w); *(u32x2*)(QKL + i * GP + 16 * tc + 4 * lq) = w; };
        if (tj == 0) { qk_tile(3, 0); qk_tile(3, 3); qk_tile(0, 0); }
        else if (tj == 1) { qk_tile(3, 1); qk_tile(1, 1); qk_tile(1, 0); }
        else if (tj == 2) { qk_tile(3, 2); qk_tile(2, 2); }
        else { qk_tile(2, 0); qk_tile(2, 1); }
        __syncthreads();
#pragma unroll
        for (int ti = 0; ti < 4; ++ti) { const bf16* rp = QKL + (16 * ti + li) * GP + 4 * lq;
            const u32x2 q0 = *(const u32x2*)rp, q1 = ti >= 1 ? *(const u32x2*)(rp + 16) : (u32x2){0u, 0u};
            u32x4 f0; f0.x = q0.x; f0.y = q0.y; f0.z = q1.x; f0.w = q1.y;
            o[ti] = bmma(__builtin_bit_cast(bf16x8, f0), vb0, o[ti]);
            if (ti >= 2) { const u32x2 q2 = *(const u32x2*)(rp + 32), q3 = ti >= 3 ? *(const u32x2*)(rp + 48) : (u32x2){0u, 0u};
                u32x4 f1; f1.x = q2.x; f1.y = q2.y; f1.z = q3.x; f1.w = q3.y;
                o[ti] = bmma(__builtin_bit_cast(bf16x8, f1), vb1, o[ti]); } }
    }
    __syncthreads();
#pragma unroll
    for (int ti = 0; ti < 4; ++ti)
#pragma unroll
        for (int r = 0; r < 4; ++r) { const int i = 16 * ti + 4 * lq + r; Tm[(dir ? 63 - i : i) * TS_ + 16 * tj + li] = o[ti][r]; }
    __syncthreads();
    {
        const float* O0 = (const float*)g_tm(F.lds, 0); const float* O1 = (const float*)g_tm(F.lds, 1);
#pragma unroll
        for (int it = 0; it < 2; ++it) { const int pos = 8 * F.wave + 4 * it + lq;
            const f32x4 a = *(const f32x4*)(O0 + pos * TS_ + 4 * li) + *(const f32x4*)(O1 + pos * TS_ + 4 * li);
            float ss = (a.x * a.x + a.y * a.y) + (a.z * a.z + a.w * a.w);
            ss += shx(ss, 1, lane); ss += shx(ss, 2, lane); ss += shx(ss, 4, lane); ss += shx(ss, 8, lane);
            const float rstd = 1.0f / sqrtf(ss * (1.0f / 64.0f) + EPS);
            bf16* z = (bf16*)(F.ws + WS_BR) + (size_t)(chunk * 64 + pos) * 1024 + 256 + head * 64 + 4 * li; const u32x2 zz = it == 0 ? zc0 : zc1;
            u32x2 wv; wv.x = pk2(a.x * rstd * gg.x * bf2f(zz.x & 0xffffu), a.y * rstd * gg.y * bf2f(zz.x >> 16)); wv.y = pk2(a.z * rstd * gg.z * bf2f(zz.y & 0xffffu), a.w * rstd * gg.w * bf2f(zz.y >> 16));
            if (DRY) *(volatile u32x2*)(F.lds + 143360 + lane * 8) = wv; else *(u32x2*)z = wv; }
    }
    __syncthreads();
}

constexpr int AT_BUF = 36864;
constexpr int AT_VP = 136;
struct AtSrc { const bf16* k; const bf16* vt; int kstr, vld, nst; };
struct AtState { f32x4 o[4]; float m, l; };

DEV float ret_lg2(int dir, int head) { const float uu = exp2f(-((dir ? 5.5f : 5.0f) + (float)head)); const float ln = -uu * (1.f + uu * (0.5f + uu * (1.f / 3.f + uu * (0.25f + uu * (0.2f + uu * (1.f / 6.f)))))); return ln * 1.4426950408889634f; }

DEV void sm_update(AtState& S, f32x4 (&st)[2], const bf16x8 (&vf)[4], int lane) {
    float mb = fmaxf(fmaxf(fmaxf(st[0].x, st[0].y), fmaxf(st[0].z, st[0].w)), fmaxf(fmaxf(st[1].x, st[1].y), fmaxf(st[1].z, st[1].w)));
    if (__any(mb > 8.0f)) {
        mb = fmaxf(mb, shx(mb, 16, lane)); mb = fmaxf(mb, shx(mb, 32, lane));
        const float dm = fmaxf(mb, 0.f), alpha = __builtin_amdgcn_exp2f(-dm);
        S.m += dm; S.l *= alpha;
#pragma unroll
        for (int dt = 0; dt < 4; ++dt) S.o[dt] = S.o[dt] * alpha;
#pragma unroll
        for (int kt = 0; kt < 2; ++kt) st[kt] = st[kt] - dm;
    }
    float ps = 0.f; float pv[8];
#pragma unroll
    for (int kt = 0; kt < 2; ++kt)
#pragma unroll
        for (int r = 0; r < 4; ++r) { const float p = __builtin_amdgcn_exp2f(st[kt][r]); pv[kt * 4 + r] = p; ps += p; }
    S.l += ps;
    u32x4 pu; pu.x = pk2(pv[0], pv[1]); pu.y = pk2(pv[2], pv[3]); pu.z = pk2(pv[4], pv[5]); pu.w = pk2(pv[6], pv[7]);
    const bf16x8 pf = __builtin_bit_cast(bf16x8, pu);
    __builtin_amdgcn_s_setprio(1);
#pragma unroll
    for (int dt = 0; dt < 4; ++dt) S.o[dt] = __builtin_amdgcn_mfma_f32_16x16x32_bf16(vf[dt], pf, S.o[dt], 0, 0, 0);
    __builtin_amdgcn_s_setprio(0);
}

template <int MODE>
DEV void at_stream(Frame& F, const bf16x8 (&qf)[2][2], const AtSrc& A, const AtSrc& B, AtState (&S)[2], int tq0, float lf2, float lb2) {
    const int tid = F.tid, lane = F.lane, li = lane & 15, lq = lane >> 4;
    const int ns = A.nst + B.nst;
    const int srow = tid >> 3, sch = (tid & 7) * 8;
    const int vrow = tid >> 4, vch = (tid & 15) * 8;
    struct StageRegs { u32x4 k0, k1, v0, v1; };
    StageRegs kra, krb; u32x4 vra, vrb;
    auto gload = [&](int st, StageRegs& R, u32x4&) { const bool a = st < A.nst; const bf16* kp = a ? A.k : B.k; const bf16* vp = a ? A.vt : B.vt; const int ks = a ? A.kstr : B.kstr, vl = a ? A.vld : B.vld, s2 = a ? st : st - A.nst;
        R.k0 = *(const u32x4*)(kp + (size_t)(s2 * 128 + srow) * ks + sch); R.k1 = *(const u32x4*)(kp + (size_t)(s2 * 128 + 64 + srow) * ks + sch);
        R.v0 = *(const u32x4*)(vp + (size_t)vrow * vl + s2 * 128 + vch); R.v1 = *(const u32x4*)(vp + (size_t)(vrow + 32) * vl + s2 * 128 + vch); };
    auto lstore = [&](int buf, const StageRegs& R, const u32x4&) { unsigned char* b = F.lds + buf * AT_BUF;
        *(u32x4*)(b + (srow * 72 + sch) * 2) = R.k0; *(u32x4*)(b + ((srow + 64) * 72 + sch) * 2) = R.k1;
        *(u32x4*)(b + 18432 + (vrow * AT_VP + vch) * 2) = R.v0; *(u32x4*)(b + 18432 + ((vrow + 32) * AT_VP + vch) * 2) = R.v1; };
    float cf[8], cb[8]; int q0w = 0;
    if (MODE == 1) {
#pragma unroll
        for (int e = 0; e < 8; ++e) { const float j = (float)(8 * lq + e); cf[e] = __builtin_amdgcn_exp2f(-lf2 * j); cb[e] = __builtin_amdgcn_exp2f(lb2 * j); }
        q0w = __builtin_amdgcn_readfirstlane(tq0 - li);
    }
    gload(0, kra, vra); if (ns > 1) gload(1, krb, vrb);
    lstore(0, kra, vra);
    __syncthreads();
    for (int st = 0; st < ns; ++st) {
        if (st + 2 < ns) gload(st + 2, kra, vra);
        const bf16* kl = (const bf16*)(F.lds + (st & 1) * AT_BUF); const bf16* vl = kl + 9216;
#pragma unroll 1
        for (int sub = 0; sub < 4; ++sub) {
            bf16x8 kf[2][2];
#pragma unroll
            for (int kt = 0; kt < 2; ++kt)
#pragma unroll
                for (int ks = 0; ks < 2; ++ks) kf[kt][ks] = *(const bf16x8*)(kl + (32 * sub + 8 * (li >> 2) + 4 * kt + (li & 3)) * 72 + 32 * ks + 8 * lq);
            bf16x8 vf[4];
#pragma unroll
            for (int dt = 0; dt < 4; ++dt) vf[dt] = *(const bf16x8*)(vl + (16 * dt + li) * AT_VP + 32 * sub + 8 * lq);
#pragma unroll
            for (int ti = 0; ti < 2; ++ti) {
                f32x4 sc[2];
                __builtin_amdgcn_s_setprio(1);
#pragma unroll
                for (int kt = 0; kt < 2; ++kt) { sc[kt] = (f32x4){0.f, 0.f, 0.f, 0.f};
#pragma unroll
                    for (int ks = 0; ks < 2; ++ks) sc[kt] = __builtin_amdgcn_mfma_f32_16x16x32_bf16(kf[kt][ks], qf[ti][ks], sc[kt], 0, 0, 0); }
                __builtin_amdgcn_s_setprio(0);
                if (MODE == 0) { sc[0] = sc[0] - S[ti].m; sc[1] = sc[1] - S[ti].m; sm_update(S[ti], sc, vf, lane); }
                else {
                    const int tq = tq0 + 16 * ti, kb0 = st * 128 + sub * 32, qt0 = q0w + 16 * ti;
                    float pv[8];
                    if (kb0 + 31 < qt0) {
                        const float a = __builtin_amdgcn_exp2f(lf2 * (float)(tq - kb0));
#pragma unroll
                        for (int e = 0; e < 8; ++e) pv[e] = sc[e >> 2][e & 3] * cf[e] * a;
                    } else if (kb0 > qt0 + 15) {
                        const float a = __builtin_amdgcn_exp2f(lb2 * (float)(kb0 - tq));
#pragma unroll
                        for (int e = 0; e < 8; ++e) pv[e] = sc[e >> 2][e & 3] * cb[e] * a;
                    } else {
#pragma unroll
                    for (int kt = 0; kt < 2; ++kt)
#pragma unroll
                        for (int r = 0; r < 4; ++r) { const int d = tq - (kb0 + 8 * lq + 4 * kt + r); const float fd = (float)d;
                            const float wf = d >= 0 ? exp2f(lf2 * fd) : 0.f, wb = d <= 0 ? exp2f(-lb2 * fd) : 0.f;
                            pv[kt * 4 + r] = sc[kt][r] * (wf + wb); }
                    }
                    u32x4 pu; pu.x = pk2(pv[0], pv[1]); pu.y = pk2(pv[2], pv[3]); pu.z = pk2(pv[4], pv[5]); pu.w = pk2(pv[6], pv[7]);
                    const bf16x8 pf = __builtin_bit_cast(bf16x8, pu);
                    __builtin_amdgcn_s_setprio(1);
#pragma unroll
                    for (int dt = 0; dt < 4; ++dt) S[ti].o[dt] = __builtin_amdgcn_mfma_f32_16x16x32_bf16(vf[dt], pf, S[ti].o[dt], 0, 0, 0);
                    __builtin_amdgcn_s_setprio(0);
                }
            }
        }
        if (st + 1 < ns) lstore((st + 1) & 1, krb, vrb);
        __syncthreads();
        krb = kra; vrb = vra;
    }
}

template <bool DRY = false>
DEV void at_finish_softmax_(AtState& S, bf16* gate_io, int lane, unsigned char* g_dry = nullptr) {
    const int lq = lane >> 4;
    float lsum = S.l; lsum += shx(lsum, 16, lane); lsum += shx(lsum, 32, lane);
    const float inv = 1.0f / lsum;
#pragma unroll
    for (int dt = 0; dt < 4; ++dt) { bf16* gp = gate_io + 16 * dt + 4 * lq; const u32x2 g = *(const u32x2*)gp;
        const float r0 = S.o[dt].x * inv * bf2f(g.x & 0xffffu), r1 = S.o[dt].y * inv * bf2f(g.x >> 16), r2 = S.o[dt].z * inv * bf2f(g.y & 0xffffu), r3 = S.o[dt].w * inv * bf2f(g.y >> 16);
        u32x2 w; w.x = pk2(r0, r1); w.y = pk2(r2, r3); if (DRY) *(volatile u32x2*)(g_dry + (lane & 63) * 8) = w; else *(u32x2*)gp = w; }
}
#define at_finish_softmax(S_, g_, l_) at_finish_softmax_<DRY>(S_, g_, l_, F.lds + 143360)

constexpr int N_AT_UNITS = 3 * DB * 16 + 3 * NB * 4;
template <bool DRY = false>
DEV void at_unit(Frame& F, int l, int u, unsigned* qctr = nullptr, unsigned* nx = nullptr) {
    const int lane = F.lane, li = lane & 15, lq = lane >> 4, w = F.wave;
    int kind;
    if (u < DB * 16) kind = 0; else if (u < 2 * DB * 16) { kind = 1; u -= DB * 16; } else if (u < 3 * DB * 16) { kind = 2; u -= 2 * DB * 16; }
    else { u -= 3 * DB * 16; kind = 3 + u / (NB * 4); u %= NB * 4; }
    const bool ctx = kind >= 3;
    const int b = ctx ? u / 4 : u / 16, h = ctx ? u % 4 : (u % 16) / 4, qb = ctx ? 0 : u % 4;
    const int L = ctx ? SEQ : DSEQ, tseq = ctx ? b * SEQ : TC + b * DSEQ;
    const int q0 = qb * 256 + w * 32;
    AtSrc A, B; B.k = nullptr; B.vt = nullptr; B.kstr = 64; B.vld = 64; B.nst = 0;
    AtState S[2];
#pragma unroll
    for (int ti = 0; ti < 2; ++ti) {
#pragma unroll
        for (int dt = 0; dt < 4; ++dt) S[ti].o[dt] = (f32x4){0.f, 0.f, 0.f, 0.f};
        S[ti].m = -1024.0f; S[ti].l = 0.f; }
    bf16x8 qf[2][2];
    auto load_q = [&](const bf16* qbase, int rowstride, int coloff) {
#pragma unroll
        for (int ti = 0; ti < 2; ++ti) { const bf16* q = qbase + (size_t)(tseq + q0 + 16 * ti + li) * rowstride + coloff + h * 64;
            qf[ti][0] = *(const bf16x8*)(q + 8 * lq); qf[ti][1] = *(const bf16x8*)(q + 32 + 8 * lq); } };
    if (kind == 0 || kind == 3) {
        const int kvh = h >> 1;
        load_q((const bf16*)(F.ws + WS_QA), 256, 0);
        A.k = (const bf16*)(F.ws + WS_KA) + (ctx ? (size_t)0 : (size_t)TC * 128) + ((size_t)b * 2 + kvh) * L * 64; A.vt = (const bf16*)(F.ws + WS_VAT) + (ctx ? (size_t)0 : (size_t)TC * 128) + ((size_t)b * 2 + kvh) * 64 * L;
        A.kstr = 64; A.vld = L; A.nst = L / 128;
        if (!ctx) { B.k = (const bf16*)(F.ws + WS_KAC) + (((size_t)l * DB + b) * 2 + kvh) * PAST * 64; B.vt = (const bf16*)(F.ws + WS_VACT) + (((size_t)l * DB + b) * 2 + kvh) * 64 * PAST; B.kstr = 64; B.vld = PAST; B.nst = PAST / 128; }
        at_stream<0>(F, qf, A, B, S, 0, 0.f, 0.f);
        if (nx && F.tid == 0) *nx = atomicAdd(qctr, 1u);
#pragma unroll
        for (int ti = 0; ti < 2; ++ti) at_finish_softmax(S[ti], (bf16*)(F.ws + WS_BR) + (size_t)(tseq + q0 + 16 * ti + li) * 1024 + h * 64, lane);
    } else if (kind == 4) {
        load_q((const bf16*)(F.ws + WS_NQ), 256, 0);
        A.k = (const bf16*)(F.ws + WS_NK) + ((size_t)b * 4 + h) * SEQ * 64; A.vt = (const bf16*)(F.ws + WS_NVT) + ((size_t)b * 4 + h) * 64 * SEQ; A.kstr = 64; A.vld = SEQ; A.nst = SEQ / 128;
        at_stream<0>(F, qf, A, B, S, 0, 0.f, 0.f);
        if (nx && F.tid == 0) *nx = atomicAdd(qctr, 1u);
#pragma unroll
        for (int ti = 0; ti < 2; ++ti) at_finish_softmax(S[ti], (bf16*)(F.ws + WS_BR) + (size_t)(tseq + q0 + 16 * ti + li) * 1024 + 768 + h * 64, lane);
    } else if (kind == 2) {
        load_q((const bf16*)(F.ws + WS_NQ), 256, 0);
        const int r = q0 >> 6;
        const int rs = r - 4 < 0 ? 0 : (r - 4 > 8 ? 8 : r - 4);
        float* bias = (float*)(F.lds + 2 * AT_BUF);
        { const float* bsrc = F.P->in[21] + ((size_t)l * 4 + h) * 15 * 31; if (F.tid < 465) bias[F.tid] = bsrc[F.tid] * 1.4426950408889634f; }
        __syncthreads();
#pragma unroll
        for (int ti = 0; ti < 2; ++ti) {
            const int jb = ((q0 & 63) >> 4) + ti; const int bs = jb * 16 - 8 < 0 ? 0 : (jb * 16 - 8 > 32 ? 32 : jb * 16 - 8);
            const int tok0 = rs * 64 + bs;
            const bf16* kA = (const bf16*)(F.ws + WS_NK) + (size_t)TC * 256 + (((size_t)b * 4 + h) * DSEQ + tok0) * 64;
            const bf16* vA = (const bf16*)(F.ws + WS_NVT) + (size_t)TC * 256 + ((size_t)b * 4 + h) * 64 * DSEQ + tok0;
            const int qc = jb * 16 + li, cs = qc - 8 < 0 ? 0 : (qc - 8 > 48 ? 48 : qc - 8);
            auto load_blk = [&](int blk, bf16x8 (&kf)[2][2], bf16x8 (&vf)[4]) {
                const bf16* kb = kA + (size_t)blk * 4096; const bf16* vb = vA + (size_t)blk * 64;
#pragma unroll
                for (int kt = 0; kt < 2; ++kt)
#pragma unroll
                    for (int ks = 0; ks < 2; ++ks) kf[kt][ks] = *(const bf16x8*)(kb + (size_t)(8 * (li >> 2) + 4 * kt + (li & 3)) * 64 + 32 * ks + 8 * lq);
#pragma unroll
                for (int dt = 0; dt < 4; ++dt) vf[dt] = *(const bf16x8*)(vb + (size_t)(16 * dt + li) * DSEQ + 8 * lq); };
            bf16x8 kc[2][2], vc[4];
            load_blk(0, kc, vc);
            for (int blk = 0; blk < 8; ++blk) {
                bf16x8 kn[2][2], vn[4];
                load_blk(blk < 7 ? blk + 1 : 7, kn, vn);
                f32x4 sc[2];
#pragma unroll
                for (int kt = 0; kt < 2; ++kt) { sc[kt] = (f32x4){0.f, 0.f, 0.f, 0.f};
#pragma unroll
                    for (int ks = 0; ks < 2; ++ks) sc[kt] = __builtin_amdgcn_mfma_f32_16x16x32_bf16(kc[kt][ks], qf[ti][ks], sc[kt], 0, 0, 0); }
                const int dr = rs + blk - r + 7;
#pragma unroll
                for (int kt = 0; kt < 2; ++kt)
#pragma unroll
                    for (int rr = 0; rr < 4; ++rr) { const int kc_ = bs + 8 * lq + 4 * kt + rr; int dc = kc_ - qc + 15; dc = dc < 0 ? 0 : (dc > 30 ? 30 : dc);
                        float bv = bias[dr * 31 + dc]; OPAQUE(bv);
                        const bool ok = kc_ >= cs && kc_ < cs + 16;
                        sc[kt][rr] = ok ? sc[kt][rr] + bv : -1e30f; }
                sc[0] = sc[0] - S[ti].m; sc[1] = sc[1] - S[ti].m; sm_update(S[ti], sc, vc, lane);
#pragma unroll
                for (int kt = 0; kt < 2; ++kt)
#pragma unroll
                    for (int ks = 0; ks < 2; ++ks) kc[kt][ks] = kn[kt][ks];
#pragma unroll
                for (int dt = 0; dt < 4; ++dt) vc[dt] = vn[dt];
            }
        }
        __syncthreads();
        A.k = (const bf16*)(F.ws + WS_NKC) + (((size_t)l * DB + b) * 4 + h) * PAST * 64; A.vt = (const bf16*)(F.ws + WS_NVCT) + (((size_t)l * DB + b) * 4 + h) * 64 * PAST; A.kstr = 64; A.vld = PAST; A.nst = PAST / 128;
        at_stream<0>(F, qf, A, B, S, 0, 0.f, 0.f);
        if (nx && F.tid == 0) *nx = atomicAdd(qctr, 1u);
#pragma unroll
        for (int ti = 0; ti < 2; ++ti) at_finish_softmax(S[ti], (bf16*)(F.ws + WS_BR) + (size_t)(tseq + q0 + 16 * ti + li) * 1024 + 768 + h * 64, lane);
    } else {
        const bf16* RQ = (const bf16*)(F.ws + WS_RQKV);
        load_q(RQ, 512, 0);
        const float lf2 = ret_lg2(0, h), lb2 = ret_lg2(1, h);
        if (!ctx) {
#pragma unroll
            for (int dir = 0; dir < 2; ++dir) {
                const bf16* s0t = (const bf16*)(F.ws + WS_S0T) + ((((size_t)(1 * DEPTH + l) * DB + b) * 2 + dir) * 4 + h) * 4096;
#pragma unroll
                for (int dt = 0; dt < 4; ++dt) { const bf16x8 s0f = *(const bf16x8*)(s0t + (size_t)(16 * dt + li) * 64 + 8 * lq), s1f = *(const bf16x8*)(s0t + (size_t)(16 * dt + li) * 64 + 32 + 8 * lq);
#pragma unroll
                    for (int ti = 0; ti < 2; ++ti) { const int tq = q0 + 16 * ti + li; const float sc = dir == 0 ? exp2f(lf2 * (float)(tq + 1)) : exp2f(lb2 * (float)(L - tq));
                        f32x4 a = {0.f, 0.f, 0.f, 0.f};
                        a = __builtin_amdgcn_mfma_f32_16x16x32_bf16(s0f, qf[ti][0], a, 0, 0, 0); a = __builtin_amdgcn_mfma_f32_16x16x32_bf16(s1f, qf[ti][1], a, 0, 0, 0);
                        S[ti].o[dt] = S[ti].o[dt] + a * sc; } }
            }
        }
        A.k = RQ + (size_t)tseq * 512 + 256 + h * 64; A.kstr = 512; A.vt = (const bf16*)(F.ws + WS_RVT) + (ctx ? (size_t)0 : (size_t)TC * 256) + ((size_t)b * 4 + h) * 64 * L; A.vld = L; A.nst = L / 128;
        at_stream<1>(F, qf, A, B, S, q0 + li, lf2, lb2);
        if (nx && F.tid == 0) *nx = atomicAdd(qctr, 1u);
        const float* gn = F.P->in[20] + l * 64;
#pragma unroll
        for (int ti = 0; ti < 2; ++ti) {
            float ss = 0.f;
#pragma unroll
            for (int dt = 0; dt < 4; ++dt) ss += (S[ti].o[dt].x * S[ti].o[dt].x + S[ti].o[dt].y * S[ti].o[dt].y) + (S[ti].o[dt].z * S[ti].o[dt].z + S[ti].o[dt].w * S[ti].o[dt].w);
            ss += shx(ss, 16, lane); ss += shx(ss, 32, lane);
            const float rstd = 1.0f / sqrtf(ss * (1.0f / 64.0f) + EPS);
            bf16* zrow = (bf16*)(F.ws + WS_BR) + (size_t)(tseq + q0 + 16 * ti + li) * 1024 + 512 + h * 64;
#pragma unroll
            for (int dt = 0; dt < 4; ++dt) { bf16* gp = zrow + 16 * dt + 4 * lq; const u32x2 g = *(const u32x2*)gp; const f32x4 gg = *(const f32x4*)(gn + 16 * dt + 4 * lq);
                u32x2 wv; wv.x = pk2(S[ti].o[dt].x * rstd * gg.x * bf2f(g.x & 0xffffu), S[ti].o[dt].y * rstd * gg.y * bf2f(g.x >> 16)); wv.y = pk2(S[ti].o[dt].z * rstd * gg.z * bf2f(g.y & 0xffffu), S[ti].o[dt].w * rstd * gg.w * bf2f(g.y >> 16));
                if (DRY) *(volatile u32x2*)(F.lds + 143360 + lane * 8) = wv; else *(u32x2*)gp = wv; }
        }
    }
}

DEV void ret_state_group(Frame& F, int l, int grp) {
    int wv_ = F.wave;
#ifndef EMU
    asm volatile("" : "+s"(wv_));
#endif
    const int task = grp * 8 + wv_, lane = F.lane, li = lane & 15, lq = lane >> 4;
    const int b = task / 8, h = (task % 8) / 2, dir = task & 1;
    bf16* Kl = (bf16*)F.lds + (size_t)wv_ * (32 * 72);
    const bf16* kbase = (const bf16*)(F.ws + WS_RQKV) + (size_t)(b * SEQ) * 512 + 256 + h * 64;
    const bf16* vbase = (const bf16*)(F.ws + WS_RVT) + ((size_t)b * 4 + h) * 64 * SEQ;
    const float lg2 = ret_lg2(dir, h);
    f32x4 acc[4][4];
#pragma unroll
    for (int a = 0; a < 4; ++a)
#pragma unroll
        for (int c = 0; c < 4; ++c) acc[a][c] = (f32x4){0.f, 0.f, 0.f, 0.f};
    for (int ks = 0; ks < SEQ / 32; ++ks) {
        { const int rr = lane >> 1, hh = (lane & 1) * 32; const bf16* src = kbase + (size_t)(32 * ks + rr) * 512 + hh;
#pragma unroll
          for (int c = 0; c < 4; ++c) *(u32x4*)(Kl + rr * 72 + hh + 8 * c) = *(const u32x4*)(src + 8 * c); }
        WAVE_SYNC();
        float wt[8];
#pragma unroll
        for (int e = 0; e < 8; ++e) { const int t = 32 * ks + 8 * lq + e; wt[e] = exp2f(lg2 * (float)(dir == 0 ? SEQ - 1 - t : t)); }
        bf16x8 bfr[4];
#pragma unroll
        for (int kt = 0; kt < 4; ++kt) { float x[8];
#pragma unroll
            for (int e = 0; e < 8; ++e) x[e] = bf2f(Kl[(8 * lq + e) * 72 + 16 * kt + li]) * wt[e];
            u32x4 pu; pu.x = pk2(x[0], x[1]); pu.y = pk2(x[2], x[3]); pu.z = pk2(x[4], x[5]); pu.w = pk2(x[6], x[7]); bfr[kt] = __builtin_bit_cast(bf16x8, pu); }
#pragma unroll
        for (int vt = 0; vt < 4; ++vt) { const bf16x8 af = *(const bf16x8*)(vbase + (size_t)(16 * vt + li) * SEQ + 32 * ks + 8 * lq);
#pragma unroll
            for (int kt = 0; kt < 4; ++kt) acc[vt][kt] = __builtin_amdgcn_mfma_f32_16x16x32_bf16(af, bfr[kt], acc[vt][kt], 0, 0, 0); }
        WAVE_SYNC();
    }
    float* dst = F.out + O_SR + ((((size_t)b * DEPTH + l) * 2 + dir) * 4 + h) * 4096;
#pragma unroll
    for (int vt = 0; vt < 4; ++vt)
#pragma unroll
        for (int kt = 0; kt < 4; ++kt) *(f32x4*)(dst + (16 * kt + li) * 64 + 16 * vt + 4 * lq) = acc[vt][kt];
}

#ifdef EMU
DEV unsigned pk_u8_(float x, int byte, unsigned old) { float c = x < 0.f ? 0.f : (x > 255.f ? 255.f : x); const unsigned v = (unsigned)__builtin_lrintf(c); return (old & ~(0xffu << (8 * byte))) | (v << (8 * byte)); }
#else
#define pk_u8_(x, byte, old) __builtin_amdgcn_cvt_pk_u8_f32((x), (byte), (old))
#endif
struct EpiP6 {
    static constexpr bool PERM = true;
    unsigned char* G8; bf16* Pt; bf16* Mg; LAS unsigned char* xl;
    static constexpr int LSLOT = 10;
    DEV void operator()(const f32x4 (&acc)[2][2][4][2], const pg8::Unit& u, int wr, int wc, int fr, int fq) const {
        OPAQUE(fr); OPAQUE(fq);
        const bool gate = (u.kind & 1) == 0, first = u.kind == 1, lastb = u.kind == 7;
        const int tid = (wr * 4 + wc) * 64 + fq * 16 + fr;
        LAS u32x2* gl = (LAS u32x2*)(xl + tid * 8);
        unsigned char* gg8 = G8 + (size_t)(u.pm * 4 + u.pn) * 65536 + tid * 8;
        const size_t pbase = ((size_t)(u.pm * 4 + u.pn) * 16 * 512 + (size_t)tid) * 8;
        if (gate) {
#define SG255(x) (255.f * sigmoid_f(x))
#pragma unroll
            for (int it = 0; it < 8; ++it) {
#pragma unroll
                for (int bj = 0; bj < 2; ++bj) { const f32x4 v0 = acc[it >> 2][bj][it & 3][0], v1 = acc[it >> 2][bj][it & 3][1]; u32x2 w; w.x = 0u; w.y = 0u;
                    w.x = pk_u8_(SG255(v0.x), 0, w.x); w.x = pk_u8_(SG255(v0.y), 1, w.x); w.x = pk_u8_(SG255(v0.z), 2, w.x); w.x = pk_u8_(SG255(v0.w), 3, w.x);
                    w.y = pk_u8_(SG255(v1.x), 0, w.y); w.y = pk_u8_(SG255(v1.y), 1, w.y); w.y = pk_u8_(SG255(v1.z), 2, w.y); w.y = pk_u8_(SG255(v1.w), 3, w.y);
                    if (it * 2 + bj >= LSLOT) gl[(it * 2 + bj - LSLOT) * 512] = w; else *(u32x2*)(gg8 + (it * 2 + bj) * 4096) = w; }
                if (it & 1) CFENCE(); }
#undef SG255
            return; }
        if (first) merge<true, false>(acc, u, pbase, gg8, gl, wr, wc, fr, fq); else if (lastb) merge<false, true>(acc, u, pbase, gg8, gl, wr, wc, fr, fq); else merge<false, false>(acc, u, pbase, gg8, gl, wr, wc, fr, fq);
    }
    template <bool FIRST, bool LAST>
    DEV void merge(const f32x4 (&acc)[2][2][4][2], const pg8::Unit& u, size_t pbase, const unsigned char* gg8, LAS u32x2* gl, int wr, int wc, int fr, int fq) const {
        u32x2 g[3][2]; u32x4 o[3][2];
#define P6_LOAD(it_) do { _Pragma("unroll") for (int bj = 0; bj < 2; ++bj) { const int s_ = (7 - (it_)) * 2 + bj;     \
        if (s_ >= LSLOT) g[(it_) % 3][bj] = gl[(s_ - LSLOT) * 512]; else g[(it_) % 3][bj] = *(const u32x2*)(gg8 + s_ * 4096); \
        if (FIRST) o[(it_) % 3][bj] = (u32x4){0u, 0u, 0u, 0u}; else o[(it_) % 3][bj] = *(const u32x4*)(Pt + pbase + (size_t)s_ * 4096); } } while (0)
        P6_LOAD(0); P6_LOAD(1);
#pragma unroll
        for (int it = 0; it < 8; ++it) {
            if (it + 2 < 8) P6_LOAD(it + 2);
            CFENCE();
            if (FIRST) { if (it == 0) PG8_WAIT_V(0); else if (it == 1) PG8_WAIT_V(2); else if (it < 6) PG8_WAIT_V(4); else if (it == 6) PG8_WAIT_V(2); else PG8_WAIT_V(0); }
            else { if (it == 0) PG8_WAIT_V(4); else if (it == 1) PG8_WAIT_V(6); else if (it < 6) PG8_WAIT_V(8); else if (it == 6) PG8_WAIT_V(4); else PG8_WAIT_V(0); }
            const int jt = 7 - it;
            const size_t off = (size_t)(u.pm * 256 + wr * 64 + fr + (jt >> 2) * 128 + (jt & 3) * 16) * D + u.pn * 256 + wc * 32 + 8 * fq;
            constexpr float fs = LAST ? (1.0f / 255.0f) : 1.0f;
#pragma unroll
            for (int bj = 0; bj < 2; ++bj) { const f32x4 v0 = acc[jt >> 2][bj][jt & 3][0], v1 = acc[jt >> 2][bj][jt & 3][1]; const u32x2 gg = g[it % 3][bj]; const u32x4 oo = o[it % 3][bj]; u32x4 w;
                const float g0 = (float)(gg.x & 0xffu), g1 = (float)((gg.x >> 8) & 0xffu), g2 = (float)((gg.x >> 16) & 0xffu), g3 = (float)(gg.x >> 24);
                const float g4 = (float)(gg.y & 0xffu), g5 = (float)((gg.y >> 8) & 0xffu), g6 = (float)((gg.y >> 16) & 0xffu), g7 = (float)(gg.y >> 24);
                w.x = pk2((bf2f(oo.x & 0xffffu) + g0 * v0.x) * fs, (bf2f(oo.x >> 16) + g1 * v0.y) * fs);
                w.y = pk2((bf2f(oo.y & 0xffffu) + g2 * v0.z) * fs, (bf2f(oo.y >> 16) + g3 * v0.w) * fs);
                w.z = pk2((bf2f(oo.z & 0xffffu) + g4 * v1.x) * fs, (bf2f(oo.z >> 16) + g5 * v1.y) * fs);
                w.w = pk2((bf2f(oo.w & 0xffffu) + g6 * v1.z) * fs, (bf2f(oo.w >> 16) + g7 * v1.w) * fs);
                if (LAST) *(u32x4*)(Mg + off + bj * 128) = w; else *(u32x4*)(Pt + pbase + (size_t)(jt * 2 + bj) * 4096) = w; }
            CFENCE(); }
#undef P6_LOAD
    }
};
struct EpiOut {
    static constexpr bool PERM = false;
    const float* x0; const float* x1; float* H; const float* modt; int l;
    DEV void operator()(const f32x4 (&acc)[2][2][4][2], const pg8::Unit& u, int wr, int wc, int fr, int fq) const {
        OPAQUE(fr); OPAQUE(fq);
        const int t0 = u.pm * 256; const float* gm = modt + (size_t)tok_cond(t0) * 3072 + 2048;
        const int col0 = u.pn * 256 + wc * 32 + 4 * fq;
        f32x4 gv[2][2];
#pragma unroll
        for (int bj = 0; bj < 2; ++bj)
#pragma unroll
            for (int n = 0; n < 2; ++n) gv[bj][n] = *(const f32x4*)(gm + col0 + bj * 128 + n * 16);
        const int tb = t0 + wr * 64 + fr;
        const float* sbase = (l == 0) ? (tb < TC ? x0 + (size_t)tb * D : x1 + (size_t)(tb - TC) * D) : H + (size_t)tb * D;
        f32x4 rs[3][2][2];
#define EO_LOAD(it_) do { const float* sp_ = sbase + (size_t)(((it_) >> 2) * 128 + ((it_) & 3) * 16) * D + col0; _Pragma("unroll") for (int bj = 0; bj < 2; ++bj) _Pragma("unroll") for (int n = 0; n < 2; ++n) \
        rs[(it_) % 3][bj][n] = *(const f32x4*)(sp_ + bj * 128 + n * 16); } while (0)
        EO_LOAD(0); EO_LOAD(1);
#pragma unroll
        for (int it = 0; it < 8; ++it) {
            if (it + 2 < 8) EO_LOAD(it + 2);
            CFENCE();
            if (it < 6) PG8_WAIT_V(8); else if (it == 6) PG8_WAIT_V(4); else PG8_WAIT_V(0);
            float* dst = H + (size_t)(tb + (it >> 2) * 128 + (it & 3) * 16) * D + col0;
#pragma unroll
            for (int bj = 0; bj < 2; ++bj)
#pragma unroll
                for (int n = 0; n < 2; ++n) *(f32x4*)(dst + bj * 128 + n * 16) = rs[it % 3][bj][n] + gv[bj][n] * acc[it >> 2][bj][it & 3][n];
            CFENCE(); }
#undef EO_LOAD
    }
};

DEV void pf_final(Frame& F) {
    const float* fg = F.P->in[24];
    const int gw = F.bx * 8 + F.wave, NGW = F.G * 8;
    if (F.G * 64 == T && (F.G & 7) == 0) {
        for (int i = 0; i < 2; ++i) {
            const int t0 = norm_row0(F, i);
            f32x4 v[4][4]; float s[4];
#pragma unroll
            for (int r = 0; r < 4; ++r)
#pragma unroll
                for (int j = 0; j < 4; ++j) v[r][j] = *(const f32x4*)(F.out + (size_t)(t0 + r) * D + 4 * F.lane + 256 * j);
#pragma unroll
            for (int r = 0; r < 4; ++r) { float a = 0.f;
#pragma unroll
                for (int j = 0; j < 4; ++j) a += (v[r][j].x * v[r][j].x + v[r][j].y * v[r][j].y) + (v[r][j].z * v[r][j].z + v[r][j].w * v[r][j].w);
                s[r] = 1.0f / sqrtf(wave_sum(a, F.lane) * (1.0f / D) + EPS); }
#pragma unroll
            for (int j = 0; j < 4; ++j) { const int c = 4 * F.lane + 256 * j; const f32x4 g = *(const f32x4*)(fg + c);
#pragma unroll
                for (int r = 0; r < 4; ++r) NT_ST((f32x4*)(F.out + (size_t)(t0 + r) * D + c), v[r][j] * s[r] * g); }
        }
        return;
    }
    for (int t = gw; t < T; t += NGW) {
        float* row = F.out + (size_t)t * D;
        f32x4 v[4]; float s = 0.f;
#pragma unroll
        for (int j = 0; j < 4; ++j) { v[j] = *(const f32x4*)(row + 4 * F.lane + 256 * j); s += (v[j].x * v[j].x + v[j].y * v[j].y) + (v[j].z * v[j].z + v[j].w * v[j].w); }
        const float rstd = 1.0f / sqrtf(wave_sum(s, F.lane) * (1.0f / D) + EPS);
#pragma unroll
        for (int j = 0; j < 4; ++j) { const int c = 4 * F.lane + 256 * j; *(f32x4*)(row + c) = v[j] * rstd * *(const f32x4*)(fg + c); }
    }
}

#ifdef EMU
#define DECL_LDS unsigned char* lds = emu::smem(); unsigned char* lds_las = lds;
#else
#define DECL_LDS extern __shared__ __attribute__((aligned(16))) unsigned char lds_raw[]; unsigned char* lds = lds_raw; LAS unsigned char* lds_las = (LAS unsigned char*)lds_raw;
#endif

#ifndef PH_LIMIT
#define PH_LIMIT 1000
#endif
#ifndef PH_MASK
#define PH_MASK 0xFFFF
#endif
#define PH_ON(k) ((PH_MASK >> (k)) & 1)

__global__ void __launch_bounds__(512, 2) fwd_kernel(Params prm) {
    DECL_LDS
    Frame F; F.lds = lds; F.ldsl = lds_las; F.ws = (GAS unsigned char*)prm.ws; F.out = (GAS float*)prm.out;
#ifdef EMU
    F.P = &prm;
#else
    F.P = (PP)__builtin_amdgcn_kernarg_segment_ptr();
#endif
    F.tid = threadIdx.x; F.lane = F.tid & 63; F.wave = __builtin_amdgcn_readfirstlane(F.tid >> 6); F.G = gridDim.x; F.bx = blockIdx.x;
    volatile LAS unsigned* misc = (volatile LAS unsigned*)(lds_las + LDS_MISC);
    if (F.tid < 64) misc[F.tid] = 0u;
    __syncthreads();
    XcdBarrier bar = xcd_barrier_post((unsigned*)(F.ws + WS_CTL), misc + 8); bar.wave = F.wave;
    int phase = 0;
#define GRID_BAR() do { xcd_barrier(bar); if (REP_BAR) xcd_barrier(bar); if (++phase >= PH_LIMIT) return; } while (0)
    LAS unsigned char* glds = lds_las;
#ifdef EMU
#define REFRESH() do { F.tid = threadIdx.x; F.lane = F.tid & 63; } while (0)
#else
#define REFRESH() do { F.lane = FRESH_LANE(); F.tid = F.wave * 64 + F.lane; PP kp_ = (PP)__builtin_amdgcn_kernarg_segment_ptr(); asm volatile("" : "+s"(kp_)); F.P = kp_; \
    GAS unsigned char* w_ = F.ws; asm volatile("" : "+s"(w_)); F.ws = w_; GAS float* o_ = F.out; asm volatile("" : "+s"(o_)); F.out = o_; } while (0)
#endif

    REFRESH(); if (PH_ON(0)) p0_prologue(F);
#if REP_P0
    REFRESH(); p0_prologue(F);
#endif
    GRID_BAR();
    for (int l = 0; l < DEPTH; ++l) {
        REFRESH(); if (PH_ON(1)) { if (l > 0) convert_weights(F, l);
        p1_norm(F, l); if (REP_P1) p1_norm(F, l); }
        GRID_BAR();
        for (int rep = 0; rep <= REP_P2; ++rep) { REFRESH(); if (PH_ON(2)) { pg8::Gemm g{(const bf16*)(F.ws + WS_HN), (const bf16*)(F.ws + WS_WIN), T, NIN, D}; pg8::StaticOrder S; S.init(T, NIN, F.G, F.bx);
          EpiIn E{F.ws, F.out, F.P->in[18] + l * 64, F.P->in[19] + l * 64, F.P->in[15] + l * 8, F.P->in[16] + l * 8, l};
          pg8::gemm_phase<EpiIn, pg8::StaticOrder, true, true>(glds, g, S, E, F.wave); } }
        GRID_BAR();
        REFRESH(); if (PH_ON(3)) { if (F.wave >= 4) __builtin_amdgcn_s_setprio(1);
            GdnPre pre, nxt; int k = F.bx; if (k < N_GDN_TASKS) { gdn_dma(F, l, k); gdn_prefetch<false>(F, l, k, pre); }
            for (; k < N_GDN_TASKS; k += F.G) { { int t_ = F.lane; OPAQUE(t_); F.lane = t_; F.tid = F.wave * 64 + t_; }
                gdn_a_task(F, l, k, pre, k + F.G < N_GDN_TASKS ? k + F.G : k, nxt); pre = nxt; }
            PG8_WAIT_V(0); __builtin_amdgcn_s_setprio(0); }
        GRID_BAR();
        REFRESH();
        if (PH_ON(4)) { unsigned* qctr = (unsigned*)(F.ws + WS_CTL) + 4096 + 64 * l; unsigned nx_ = 0u; bool have = false;
          for (;;) {
            __syncthreads();
            if (F.tid == 0) misc[16] = have ? nx_ : atomicAdd(qctr, 1u);
            __syncthreads();
            int u = __builtin_amdgcn_readfirstlane((int)misc[16]);
            have = false;
            { int t_ = F.lane; OPAQUE(t_); F.lane = t_; F.tid = F.wave * 64 + t_; }
            constexpr int NB_S = DB * 4, NA_S = 3 * DB * 16, NB_C = NB * 4, NA_C = 3 * NB * 4;
            if (u < NB_S) { gdn_b_wave(F, l, u * 8 + F.wave); continue; }
            u -= NB_S;
            if (u < NA_S) { at_unit(F, l, u, qctr, &nx_); have = true; continue; }
            u -= NA_S;
            if (u < NB) { ret_state_group(F, l, u); continue; }
            u -= NB;
            if (u < NB_C) { gdn_b_wave(F, l, (NB_S + u) * 8 + F.wave); continue; }
            u -= NB_C;
            if (u < NA_C) { at_unit(F, l, NA_S + u, qctr, &nx_); have = true; continue; }
            break;
          } }
        GRID_BAR();
        REFRESH(); if (PH_ON(6)) { if (F.wave >= 4) __builtin_amdgcn_s_setprio(1);
            GdnPre pre, nxt; int k = F.bx; if (k < N_GDN_TASKS) { gdn_dma(F, l, k); gdn_prefetch<true>(F, l, k, pre); }
            for (; k < N_GDN_TASKS; k += F.G) { { int t_ = F.lane; OPAQUE(t_); F.lane = t_; F.tid = F.wave * 64 + t_; }
                gdn_c_task(F, l, k, pre, k + F.G < N_GDN_TASKS ? k + F.G : k, nxt); pre = nxt; }
            PG8_WAIT_V(0); __builtin_amdgcn_s_setprio(0); }
        GRID_BAR();
        REFRESH(); if (PH_ON(7)) {
            pg8::Gemm g{nullptr, nullptr, T, D, D};
            pg8::P6Order S{(const char*)(F.ws + WS_HN), (const char*)(F.ws + WS_WIN) + (size_t)NIN * D * 2, (const char*)(F.ws + WS_BR), (const char*)(F.ws + WS_WBR), (T / 256) * 4, F.G, F.bx};
            EpiP6 E{F.ws + WS_GATE, (bf16*)(F.ws + WS_MB), (bf16*)(F.ws + WS_MERGED), lds_las + 131072};
            pg8::gemm_phase<EpiP6, pg8::P6Order, true, true>(glds, g, S, E, F.wave); }
        GRID_BAR();
        REFRESH(); if (PH_ON(8)) { pg8::Gemm g{(const bf16*)(F.ws + WS_MERGED), (const bf16*)(F.ws + WS_WOUT), T, D, D}; pg8::StaticOrder S; S.init(T, D, F.G, F.bx);
          EpiOut E{F.P->in[0], F.P->in[1], F.out, (const float*)(F.ws + WS_MODT) + (size_t)l * NCOND * 3072, l};
          pg8::gemm_phase<EpiOut, pg8::StaticOrder, true, true>(glds, g, S, E, F.wave);
          if (REP_P7 && l == 0) pg8::gemm_phase<EpiOut, pg8::StaticOrder, true, true>(glds, g, S, E, F.wave); }
        GRID_BAR();
    }
    REFRESH(); if (PH_ON(9)) pf_final(F);
}

extern "C" void kernel_launch(void* const* d_in, const int* in_sizes, int n_in, void* d_out, int out_size, void* d_ws, size_t ws_size, hipStream_t stream) {
    static int grid = 0;
    if (grid == 0) {
        if (n_in != 25 || (size_t)out_size != O_END || ws_size < WS_END2) { fprintf(stderr, "kernel_launch: unexpected shapes (n_in %d out %d ws %zu)\n", n_in, out_size, ws_size); grid = -1; return; }
        int dev = 0, cus = 0;
        if (hipGetDevice(&dev) != hipSuccess || hipDeviceGetAttribute(&cus, hipDeviceAttributeMultiprocessorCount, dev) != hipSuccess) { grid = -1; return; }
        if (hipFuncSetAttribute((const void*)fwd_kernel, hipFuncAttributeMaxDynamicSharedMemorySize, LDS_BYTES) != hipSuccess) { fprintf(stderr, "kernel_launch: hipFuncSetAttribute failed\n"); grid = -1; return; }
        (void)hipGetLastError();
        grid = cus;
    }
    if (grid < 0) return;
    (void)hipMemsetAsync((char*)d_ws + WS_CTL, 0, CTL_BYTES, stream);
    Params p{};
    for (int i = 0; i < 25; ++i) p.in[i] = (const float*)d_in[i];
    p.out = (float*)d_out; p.ws = (unsigned char*)d_ws;
    hipLaunchKernelGGL(fwd_kernel, dim3(grid), dim3(512), LDS_BYTES, stream, p);
}

#ifdef EMU
size_t emu_out_size() { return O_END; }
size_t emu_ws_size() { return (size_t)256 * 1024 * 1024; }
size_t emu_ws_used() { return WS_END2; }
#endif
```

```cpp
#include <hip/hip_runtime.h>
#include <cstdio>
#include <cstdint>

#define REP_BAR 0
#define REP_P0 0
#define REP_P7 0
#define REP_P1 0
#define REP_GDNA 0
#define REP_P2 0
#define REP_P6 0
#define REP_P4 0
#define REP_GDNC 0
#define REP_ATTN 0
#define REP_GEMM 0
#ifndef CFG_NB
#define CFG_NB 32
#endif
#ifndef CFG_DB
#define CFG_DB 8
#endif

#ifdef EMU
#define LAS
#define GAS
#define ASMV(x)
#else
#define LAS __attribute__((address_space(3)))
#if defined(__HIP_DEVICE_COMPILE__)
#define GAS __attribute__((address_space(1)))
#else
#define GAS
#endif
#define ASMV(x) asm volatile(x ::: "memory")
#endif
#define DEV __device__ __forceinline__
#ifdef EMU
#define CFENCE()
#else
#define CFENCE() asm volatile("" ::: "memory")
#endif
#ifdef EMU
#define OPAQUE(x)
#else
#define OPAQUE(x) asm volatile("" : "+v"(x))
#endif
#ifdef EMU
#define FRESH_LANE() ((int)(threadIdx.x & 63))
#else
DEV int fresh_lane_() { unsigned z = 0; asm volatile("" : "+v"(z)); return (int)__builtin_amdgcn_mbcnt_hi(~0u, __builtin_amdgcn_mbcnt_lo(~0u, z)); }
#define FRESH_LANE() fresh_lane_()
#endif
#ifdef EMU
#define WAVE_SYNC() emu::wave_sync()
#else
#define WAVE_SYNC() __builtin_amdgcn_wave_barrier()
#endif

typedef unsigned short bf16;
typedef short bf16x8 __attribute__((ext_vector_type(8)));
typedef float f32x4 __attribute__((ext_vector_type(4)));
typedef float f32x2 __attribute__((ext_vector_type(2)));
typedef unsigned u32x4 __attribute__((ext_vector_type(4)));
typedef unsigned u32x2 __attribute__((ext_vector_type(2)));

constexpr int D = 1024, DEPTH = 2, HD = 64, NB = CFG_NB, SEQ = 256, DB = CFG_DB, DSEQ = 1024, PAST = 512;
constexpr int TC = NB * SEQ, TS = DB * DSEQ, T = TC + TS, NCOND = 1 + DB, NSEQ = NB + DB;
constexpr int INW = 7952, NPERM = 8192, NIN = 4096;
constexpr float EPS = 1e-6f;
static_assert(T % 256 == 0 && TC % 256 == 0, "token tiles");

constexpr size_t O_Y = 0;
constexpr size_t O_AK = (size_t)T * D;
constexpr size_t O_AV = O_AK + (size_t)NB * DEPTH * SEQ * 128;
constexpr size_t O_NK = O_AV + (size_t)NB * DEPTH * SEQ * 128;
constexpr size_t O_NV = O_NK + (size_t)NB * DEPTH * SEQ * 256;
constexpr size_t O_SG = O_NV + (size_t)NB * DEPTH * SEQ * 256;
constexpr size_t O_SR = O_SG + (size_t)NB * DEPTH * 2 * 4 * 4096;
constexpr size_t O_END = O_SR + (size_t)NB * DEPTH * 2 * 4 * 4096;

constexpr size_t al256(size_t x) { return (x + 255) & ~(size_t)255; }
constexpr size_t WS_CTL = 0, CTL_BYTES = 65536;
constexpr size_t WS_MODT = WS_CTL + CTL_BYTES;
constexpr size_t WS_ROPE = al256(WS_MODT + (size_t)DEPTH * NCOND * 3072 * 4);
constexpr size_t WS_WIN = al256(WS_ROPE + 2 * 64 * 16 * 4);
constexpr size_t WS_WBR = WS_WIN + (size_t)NPERM * D * 2;
constexpr size_t WS_WOUT = WS_WBR + (size_t)4 * D * 256 * 2;
constexpr size_t WS_KAC = WS_WOUT + (size_t)D * D * 2;
constexpr size_t WS_VACT = WS_KAC + (size_t)DEPTH * DB * 2 * PAST * 64 * 2;
constexpr size_t WS_NKC = WS_VACT + (size_t)DEPTH * DB * 2 * PAST * 64 * 2;
constexpr size_t WS_NVCT = WS_NKC + (size_t)DEPTH * DB * 4 * PAST * 64 * 2;
constexpr size_t WS_HN = WS_NVCT + (size_t)DEPTH * DB * 4 * PAST * 64 * 2;
constexpr size_t WS_QA = WS_HN + (size_t)T * D * 2;
constexpr size_t WS_GQKV = WS_QA + (size_t)T * 256 * 2;
constexpr size_t WS_RQKV = WS_GQKV + (size_t)T * 768 * 2;
constexpr size_t WS_NQ = WS_RQKV + (size_t)T * 512 * 2;
constexpr size_t WS_KA = WS_NQ + (size_t)T * 256 * 2;
constexpr size_t WS_VAT = WS_KA + (size_t)T * 128 * 2;
constexpr size_t WS_NK = WS_VAT + (size_t)T * 128 * 2;
constexpr size_t WS_NVT = WS_NK + (size_t)T * 256 * 2;
constexpr size_t WS_AZ = WS_NVT + (size_t)T * 256 * 2;
constexpr size_t WS_BR = WS_AZ;
constexpr size_t WS_GAB = WS_AZ + (size_t)T * 1024 * 2;
constexpr size_t WS_MB = WS_GAB + (size_t)T * 16 * 4;
constexpr size_t WS_BS = WS_MB + (size_t)(T / 64) * 8 * 4096 * 4;
constexpr size_t WS_O = WS_BS;
constexpr size_t WS_RVT = WS_BS + (size_t)(T / 64) * 8 * 4096 * 4;
constexpr size_t WS_S0T = WS_RVT + (size_t)T * 256 * 2;
constexpr size_t WS_END = WS_S0T + (size_t)2 * DEPTH * DB * 8 * 4096 * 2;
constexpr size_t WS_MERGED = WS_QA, WS_GATE = WS_RQKV;
constexpr size_t TF_SLOT = 6144, TF_NA = ((size_t)NIN * D * 2) / TF_SLOT, TF_N = (size_t)(T / 64) * 4 * 2;
constexpr size_t WS_TFB = WS_END, WS_END2 = WS_TFB + (TF_N > TF_NA ? (TF_N - TF_NA) * TF_SLOT : 0);
static_assert(WS_END2 <= (size_t)256 * 1024 * 1024, "d_ws map exceeds 256 MiB");
static_assert(WS_GATE + (size_t)T * D * 2 <= WS_NK && WS_MERGED + (size_t)T * D * 2 <= WS_RQKV, "overlays");

constexpr int LDS_BYTES = 163840;
constexpr int LDS_MISC = 162816;

struct Params { const float* in[25]; float* out; unsigned char* ws; };
#ifdef EMU
typedef const Params* PP;
#else
typedef const __attribute__((address_space(4))) Params* PP;
#endif

DEV unsigned f2bf(float f) { unsigned u = __builtin_bit_cast(unsigned, f); return (u + 0x7fffu + ((u >> 16) & 1u)) >> 16; }
DEV float bf2f(unsigned h) { return __builtin_bit_cast(float, h << 16); }
DEV unsigned pk2(float lo, float hi) {
#ifdef EMU
    return f2bf(lo) | (f2bf(hi) << 16);
#else
    typedef __bf16 bfx2_ __attribute__((ext_vector_type(2))); typedef float flx2_ __attribute__((ext_vector_type(2)));
    const flx2_ v_ = {lo, hi}; return __builtin_bit_cast(unsigned, __builtin_convertvector(v_, bfx2_));
#endif
}
#ifdef EMU
#define NT_ST(p, v) (*(p) = (v))
#define NT_LD(p) (*(p))
#else
#define NT_ST(p, v) __builtin_nontemporal_store((v), (p))
#define NT_LD(p) __builtin_nontemporal_load(p)
#endif
DEV float sigmoid_f(float x) { return __builtin_amdgcn_rcpf(1.f + __builtin_amdgcn_exp2f(-1.4426950408889634f * x)); }
DEV float silu_f(float x) { return x * sigmoid_f(x); }
DEV float softplus_f(float x) { return fmaxf(x, 0.f) + __logf(1.0f + __expf(-fabsf(x))); }
#ifdef EMU
DEV float shx(float v, int mask, int lane) { return __shfl_xor(v, mask); }
DEV float shf(float v, int src) { return __shfl(v, src); }
#else
DEV float shx(float v, int mask, int lane) { return __builtin_bit_cast(float, __builtin_amdgcn_ds_bpermute((lane ^ mask) << 2, __builtin_bit_cast(int, v))); }
DEV float shf(float v, int src) { return __builtin_bit_cast(float, __builtin_amdgcn_ds_bpermute(src << 2, __builtin_bit_cast(int, v))); }
#endif
DEV float wave_sum(float v, int lane) {
#pragma unroll
    for (int o = 1; o < 64; o <<= 1) v += shx(v, o, lane);
    return v;
}

#ifdef EMU
struct XcdBarrier { unsigned* bar; int wave; };
DEV XcdBarrier xcd_barrier_post(unsigned* bar, volatile unsigned* st) { XcdBarrier b; b.bar = bar; return b; }
DEV void xcd_barrier(const XcdBarrier& b) {
    __syncthreads();
    if (threadIdx.x == 0) { const unsigned G = gridDim.x; const unsigned old = __atomic_fetch_add(&b.bar[0], 1u, __ATOMIC_SEQ_CST); const unsigned gen = old / G;
        while (__atomic_load_n(&b.bar[0], __ATOMIC_SEQ_CST) < (gen + 1u) * G) emu::yield(); }
    __syncthreads();
}
#else
#define XB_TMO      128
#define XB_XCNT(j)  (256  + 64 * (j))
#define XB_XSUB(j)  (1280 + 64 * (j))
#define XB_XGEN(j)  (2304 + 64 * (j))
#define XB_TOP      3328
#define XB_TOPGEN   3392
#define XCD_BAR_WORDS 3456
#define XB_SPIN_CAP (1u << 18)
__device__ __forceinline__ unsigned xb_ld(unsigned* p)              { return __hip_atomic_load(p, __ATOMIC_RELAXED, __HIP_MEMORY_SCOPE_AGENT); }
__device__ __forceinline__ unsigned xb_add(unsigned* p, unsigned v) { return __hip_atomic_fetch_add(p, v, __ATOMIC_RELAXED, __HIP_MEMORY_SCOPE_AGENT); }
__device__ __forceinline__ unsigned xb_xcc_id() { return (unsigned)__builtin_amdgcn_s_getreg((3 << 11) | 20) & 0xFu; }
#define XB_SPIN(cond, bar) do { unsigned _sp = 0; while (cond) { __builtin_amdgcn_s_sleep(1); \
    if ((++_sp & 255u) == 0u) { if (xb_ld(&(bar)[XB_TMO])) break; if (_sp > XB_SPIN_CAP) { atomicAdd(&(bar)[XB_TMO], 1u); break; } } } } while (0)
struct XcdBarrier { unsigned* bar; unsigned x; volatile LAS unsigned* st; int wave; };
__device__ __forceinline__ XcdBarrier xcd_barrier_post(unsigned* bar, volatile LAS unsigned* st) {
    XcdBarrier b; b.bar = bar; b.x = xb_xcc_id(); b.st = st;
    if (threadIdx.x == 0) (void)xb_add(&bar[XB_XCNT(b.x)], 1u);
    return b;
}
__device__ __forceinline__ void xcd_barrier_complete(unsigned* bar, unsigned x, unsigned& nloc, unsigned& nx) {
    const unsigned G = gridDim.x * gridDim.y * gridDim.z;
    unsigned sum, cnt, mine, sp = 0u;
    for (;;) {
        sum = 0u; cnt = 0u; mine = 0u;
#pragma unroll
        for (unsigned j = 0; j < 16; ++j) { const unsigned c = xb_ld(&bar[XB_XCNT(j)]); sum += c; cnt += (c > 0u) ? 1u : 0u; mine = (j == x) ? c : mine; }
        if (sum == G) break;
        __builtin_amdgcn_s_sleep(1);
        if ((++sp & 255u) == 0u) { if (xb_ld(&bar[XB_TMO])) break; if (sp > XB_SPIN_CAP) { atomicAdd(&bar[XB_TMO], 1u); break; } }
    }
    nloc = mine > 0u ? mine : 1u; nx = cnt > 0u ? cnt : 1u;
}
__device__ __forceinline__ void xcd_barrier(const XcdBarrier& b) {
    asm volatile("s_waitcnt vmcnt(0)" ::: "memory");
    __syncthreads();
    const int tb_ = b.wave * 64 + FRESH_LANE();
    if (tb_ == 0) {
        unsigned* bar = b.bar; asm volatile("" : "+s"(bar));
        unsigned bx_ = xb_xcc_id(); asm volatile("" : "+s"(bx_));
        __builtin_amdgcn_s_waitcnt(0);
        unsigned nloc = b.st[0], nx = b.st[1];
        if (nloc == 0u) { xcd_barrier_complete(bar, bx_, nloc, nx); b.st[0] = nloc; b.st[1] = nx; }
        const unsigned old = xb_add(&bar[XB_XSUB(bx_)], 1u);
        const unsigned gen = old / nloc;
        if (old + 1u == (gen + 1u) * nloc) {
            __builtin_amdgcn_fence(__ATOMIC_RELEASE, "agent");
            asm volatile("s_waitcnt vmcnt(0)" ::: "memory");
            const unsigned og = xb_add(&bar[XB_TOP], 1u);
            const unsigned tg = og / nx;
            if (og + 1u == (tg + 1u) * nx) xb_add(&bar[XB_TOPGEN], 1u);
            else XB_SPIN(xb_ld(&bar[XB_TOPGEN]) == tg, bar);
            __builtin_amdgcn_fence(__ATOMIC_ACQUIRE, "agent");
            xb_add(&bar[XB_XGEN(bx_)], 1u);
            asm volatile("s_waitcnt vmcnt(0)" ::: "memory");
        } else {
            XB_SPIN(xb_ld(&bar[XB_XGEN(bx_)]) == gen, bar);
            __builtin_amdgcn_fence(__ATOMIC_ACQUIRE, "agent");
            asm volatile("s_waitcnt vmcnt(0)" ::: "memory");
        }
    }
    __syncthreads();
}
#endif

namespace pg8 {
#define PG8_LAS LAS
constexpr int BM = 256, BK = 64, HALF = 128, HTB = HALF * BK * 2, STAGE_BYTES = 8 * HTB, NXCD = 8, WGM = 8;
__host__ __device__ __forceinline__ int lds_byte(int r, int c) { const int st = (r >> 4) * 2 + (c >> 5), rr = r & 15, cc = c & 31, ob = rr * 64 + cc * 2; return st * 1024 + (ob ^ (((ob >> 9) & 1) << 5)); }
__host__ __device__ __forceinline__ void stage_rc(int b, int& R, int& C) { const int st = b / 1024, sb = b % 1024, swz = sb ^ (((sb >> 9) & 1) << 5); R = (st >> 1) * 16 + swz / 64; C = (st & 1) * 32 + (swz % 64) / 2; }
__host__ __device__ __forceinline__ int perm32(int rho) { const int n = rho >> 4, i = rho & 15; return 8 * (i >> 2) + 4 * n + (i & 3); }
struct Unit { int pm, pn; const char* a; const char* b; int nt, kind; };
struct Gemm { const bf16* A; const bf16* Bt; int M, N, K; };
struct StaticOrder {
    int nM, nN, nwg, G, c;
    __host__ __device__ void init(int M, int N, int G_, int c_) { nM = M / BM; nN = N / BM; nwg = nM * nN; G = G_; c = c_; }
    __host__ __device__ bool next(int i, Unit& u, const Gemm& g) const {
        const long L = (long)i * G + c; if (L >= nwg) return false;
        int wgid = (int)L; { const int q = nwg / NXCD, r = nwg % NXCD, xcd = wgid % NXCD, off = wgid / NXCD; wgid = (xcd < r ? xcd * (q + 1) : r * (q + 1) + (xcd - r) * q) + off; }
        const int nig = WGM * nN, gid = wgid / nig, fm = gid * WGM, gsz = (nM - fm) < WGM ? (nM - fm) : WGM;
        u.pm = fm + ((wgid % nig) % gsz); u.pn = (wgid % nig) / gsz;
        u.a = (const char*)g.A + (size_t)u.pm * 256 * g.K * 2; u.b = (const char*)g.Bt + (size_t)u.pn * 256 * g.K * 2; u.nt = g.K / 64; u.kind = 0; return true;
    }
    __device__ __forceinline__ void a_ready(const Unit&) const {}
    __device__ __forceinline__ void done(const Unit&) const {}
};
struct P6Order {
    const char* hn; const char* wmg; const char* br; const char* wbr; int ntiles, G, c;
    __device__ __forceinline__ bool next(int i, Unit& u, const Gemm&) const {
        int tile = c + (i >> 3) * G; if (tile >= ntiles) return false;
        if (G == 256 && ntiles == 256) { const int xcd = c & 7, idx = c >> 3; tile = (xcd * 8 + (idx >> 2)) * 4 + (idx & 3); }
        const int sub = i & 7, n = sub >> 1; u.pm = tile >> 2; u.pn = tile & 3; u.kind = sub;
        if ((sub & 1) == 0) { u.a = hn + (size_t)u.pm * 256 * 2048; u.b = wmg + ((size_t)n * 1024 + u.pn * 256) * 2048; u.nt = 16; }
        else { u.a = br + (size_t)u.pm * 256 * 2048 + n * 512; u.b = wbr + (size_t)u.pn * 256 * 2048 + n * 512; u.nt = 4; }
        return true;
    }
    __device__ __forceinline__ void a_ready(const Unit&) const {}
    __device__ __forceinline__ void done(const Unit&) const {}
};
#ifdef EMU
#define PG8_WAIT_V(n)
#define PG8_WAIT_L(n)
#else
#define PG8_WAIT_V(n) asm volatile("s_waitcnt vmcnt(" #n ")" ::: "memory")
#define PG8_WAIT_L(n) asm volatile("s_waitcnt lgkmcnt(" #n ")" ::: "memory")
#endif
template <class Epi, class Sched, bool ALIGN_EPI = false, bool SP2 = false>
__device__ __forceinline__ void gemm_phase(PG8_LAS unsigned char* lds, const Gemm g, const Sched& S, const Epi& E, const int wid) {
    const int lane = FRESH_LANE(), tid = wid * 64 + lane, wr = wid >> 2, wc = wid & 3, fr = lane & 15, fq = lane >> 4;
    const int K = g.K;
    unsigned voffA[2], voffB[2];
#pragma unroll
    for (int i = 0; i < 2; ++i) { int R, C; stage_rc(tid * 16 + i * 8192, R, C); const int Rb = Epi::PERM ? ((R & ~31) + perm32(R & 31)) : R;
        voffA[i] = (unsigned)(R * K + C) * 2u; voffB[i] = (unsigned)(Rb * K + C) * 2u; }
    const size_t kstep = (size_t)(BK * 2);
    const size_t hstep = (size_t)HALF * K * 2;
    const unsigned ldsw = (unsigned)wid * 1024u;
    const int aoff = lds_byte(wr * 64 + fr, fq * 8), boff = lds_byte(wc * 32 + fr, fq * 8);
#define PG8_SA(b, h) (((b) * 2 + (h)) * HTB)
#define PG8_SB(b, h) ((4 + (b) * 2 + (h)) * HTB)
#define PG8_STAGE(bufoff, gbase, voff) do { _Pragma("unroll") for (int _i = 0; _i < 2; ++_i) \
        __builtin_amdgcn_global_load_lds((const unsigned*)((const char*)(gbase) + (voff)[_i]), (PG8_LAS unsigned*)(lds + (bufoff) + ldsw + _i * 8192), 16, 0, 0); } while (0)
#define PG8_LDA(dst, b, h) do { _Pragma("unroll") for (int m = 0; m < 4; ++m) _Pragma("unroll") for (int k = 0; k < 2; ++k) dst[m][k] = *(const PG8_LAS bf16x8*)(lds + PG8_SA(b, h) + aoff + m * 2048 + k * 1024); } while (0)
#define PG8_LDB(dst, b, h) do { _Pragma("unroll") for (int n = 0; n < 2; ++n) _Pragma("unroll") for (int k = 0; k < 2; ++k) dst[n][k] = *(const PG8_LAS bf16x8*)(lds + PG8_SB(b, h) + boff + n * 2048 + k * 1024); } while (0)
#define PG8_MMA(ai, bj, At, Bt) do { __builtin_amdgcn_s_setprio(1); _Pragma("unroll") for (int m = 0; m < 4; ++m) _Pragma("unroll") for (int n = 0; n < 2; ++n) _Pragma("unroll") for (int k = 0; k < 2; ++k) \
        acc[ai][bj][m][n] = __builtin_amdgcn_mfma_f32_16x16x32_bf16(Bt[n][k], At[m][k], acc[ai][bj][m][n], 0, 0, 0); __builtin_amdgcn_s_setprio(0); } while (0)
#define PG8_BAR __builtin_amdgcn_s_barrier()
#define PG8_SCHED __builtin_amdgcn_sched_barrier(0)
    Unit cur, nxt; int ui = 0;
    if (!S.next(0, cur, g)) return;
    f32x4 acc[2][2][4][2];
#pragma unroll
    for (int a = 0; a < 2; ++a)
#pragma unroll
        for (int b = 0; b < 2; ++b)
#pragma unroll
            for (int m = 0; m < 4; ++m)
#pragma unroll
                for (int n = 0; n < 2; ++n) acc[a][b][m][n] = (f32x4){0.f, 0.f, 0.f, 0.f};
    bf16x8 At[4][2], B0[2][2], B1[2][2];
    const char* cA = cur.a; const char* cB = cur.b;
    S.a_ready(cur);
    if constexpr (SP2) {
        PG8_STAGE(PG8_SB(0, 0), cB, voffB); PG8_STAGE(PG8_SB(0, 1), cB + hstep, voffB); PG8_STAGE(PG8_SA(0, 0), cA, voffA); PG8_STAGE(PG8_SA(0, 1), cA + hstep, voffA);
        if (wr == 1) PG8_BAR;
        PG8_WAIT_V(2); PG8_BAR;
        PG8_STAGE(PG8_SB(1, 0), cB + kstep, voffB); PG8_STAGE(PG8_SA(1, 0), cA + kstep, voffA); PG8_STAGE(PG8_SB(1, 1), cB + hstep + kstep, voffB);
        PG8_WAIT_V(6); PG8_BAR;
    } else {
        PG8_STAGE(PG8_SB(0, 0), cB, voffB); PG8_STAGE(PG8_SA(0, 0), cA, voffA); PG8_STAGE(PG8_SB(0, 1), cB + hstep, voffB); PG8_STAGE(PG8_SA(0, 1), cA + hstep, voffA);
        if (wr == 1) PG8_BAR;
        PG8_WAIT_V(4); PG8_BAR;
        PG8_STAGE(PG8_SB(1, 0), cB + kstep, voffB); PG8_STAGE(PG8_SA(1, 0), cA + kstep, voffA); PG8_STAGE(PG8_SB(1, 1), cB + hstep + kstep, voffB);
        PG8_WAIT_V(6); PG8_BAR;
    }
    for (;;) {
        const bool has_next = S.next(ui + 1, nxt, g);
        const char* nA = has_next ? nxt.a : cA; const char* nB = has_next ? nxt.b : cB;
        const int nt = cur.nt;
        for (int t = 0; t < nt; t += 2) {
            const bool last = (t == nt - 2);
            const char* a1 = cA + (size_t)(t + 1) * kstep;
            const char* a2 = last ? nA : cA + (size_t)(t + 2) * kstep; const char* b2 = last ? nB : cB + (size_t)(t + 2) * kstep;
            const char* a3 = a2 + kstep; const char* b3 = b2 + kstep;
            if (last && has_next) S.a_ready(nxt);
            if constexpr (SP2) {
            PG8_LDB(B0, 0, 0); PG8_LDB(B1, 0, 1); PG8_SCHED; PG8_LDA(At, 0, 0); PG8_STAGE(PG8_SA(1, 1), a1 + hstep, voffA);
            PG8_WAIT_V(8); PG8_WAIT_L(0); PG8_BAR; PG8_MMA(0, 0, At, B0); PG8_MMA(0, 1, At, B1); PG8_BAR; PG8_SCHED;
            PG8_LDA(At, 0, 1); PG8_STAGE(PG8_SB(0, 0), b2, voffB); PG8_STAGE(PG8_SB(0, 1), b2 + hstep, voffB); PG8_STAGE(PG8_SA(0, 0), a2, voffA);
            PG8_WAIT_V(8); PG8_WAIT_L(0); PG8_BAR; PG8_MMA(1, 0, At, B0); PG8_MMA(1, 1, At, B1); PG8_BAR; PG8_SCHED;
            PG8_LDB(B0, 1, 0); PG8_LDB(B1, 1, 1); PG8_SCHED; PG8_LDA(At, 1, 0); PG8_STAGE(PG8_SA(0, 1), a2 + hstep, voffA);
            PG8_WAIT_V(8); PG8_WAIT_L(0); PG8_BAR; PG8_MMA(0, 0, At, B0); PG8_MMA(0, 1, At, B1); PG8_BAR; PG8_SCHED;
            PG8_LDA(At, 1, 1); PG8_STAGE(PG8_SB(1, 0), b3, voffB); PG8_STAGE(PG8_SB(1, 1), b3 + hstep, voffB); PG8_STAGE(PG8_SA(1, 0), a3, voffA);
            PG8_WAIT_V(8); PG8_WAIT_L(0); PG8_BAR; PG8_MMA(1, 0, At, B0); PG8_MMA(1, 1, At, B1); PG8_BAR; PG8_SCHED;
            } else {
            PG8_LDB(B0, 0, 0); PG8_SCHED; PG8_LDA(At, 0, 0); PG8_STAGE(PG8_SA(1, 1), a1 + hstep, voffA);
            PG8_WAIT_L(8); PG8_BAR; PG8_WAIT_L(0); PG8_MMA(0, 0, At, B0); PG8_BAR; PG8_SCHED;
            PG8_LDB(B1, 0, 1); PG8_STAGE(PG8_SB(0, 0), b2, voffB);
            PG8_BAR; PG8_WAIT_L(0); PG8_MMA(0, 1, At, B1); PG8_BAR;
            PG8_LDA(At, 0, 1); PG8_STAGE(PG8_SA(0, 0), a2, voffA);
            PG8_BAR; PG8_WAIT_L(0); PG8_MMA(1, 0, At, B0); PG8_BAR; PG8_SCHED;
            PG8_STAGE(PG8_SB(0, 1), b2 + hstep, voffB);
            PG8_WAIT_V(6); PG8_BAR; PG8_MMA(1, 1, At, B1); PG8_BAR;
            PG8_LDB(B0, 1, 0); PG8_SCHED; PG8_LDA(At, 1, 0); PG8_STAGE(PG8_SA(0, 1), a2 + hstep, voffA);
            PG8_WAIT_L(8); PG8_BAR; PG8_WAIT_L(0); PG8_MMA(0, 0, At, B0); PG8_BAR; PG8_SCHED;
            PG8_LDB(B1, 1, 1); PG8_STAGE(PG8_SB(1, 0), b3, voffB);
            PG8_BAR; PG8_WAIT_L(0); PG8_MMA(0, 1, At, B1); PG8_BAR;
            PG8_LDA(At, 1, 1); PG8_STAGE(PG8_SA(1, 0), a3, voffA);
            PG8_BAR; PG8_WAIT_L(0); PG8_MMA(1, 0, At, B0); PG8_BAR; PG8_SCHED;
            PG8_STAGE(PG8_SB(1, 1), b3 + hstep, voffB);
            PG8_WAIT_V(6); PG8_BAR; PG8_MMA(1, 1, At, B1); PG8_BAR;
            }
        }
        if constexpr (ALIGN_EPI) { if (wr == 0) PG8_BAR; }
        E(acc, cur, wr, wc, fr, fq);
        PG8_WAIT_V(0);
        if (!has_next) break;
#pragma unroll
        for (int a = 0; a < 2; ++a)
#pragma unroll
            for (int b = 0; b < 2; ++b)
#pragma unroll
                for (int m = 0; m < 4; ++m)
#pragma unroll
                    for (int n = 0; n < 2; ++n) acc[a][b][m][n] = (f32x4){0.f, 0.f, 0.f, 0.f};
        cur = nxt; cA = nA; cB = nB; ++ui;
        if constexpr (ALIGN_EPI) { if (wr == 1) PG8_BAR; }
    }
    PG8_WAIT_V(0);
    if constexpr (!ALIGN_EPI) { if (wr == 0) PG8_BAR; }
    PG8_BAR;
#undef PG8_SA
#undef PG8_SB
#undef PG8_STAGE
#undef PG8_LDA
#undef PG8_LDB
#undef PG8_MMA
#undef PG8_BAR
#undef PG8_SCHED
}
}

struct Frame {
    unsigned char* lds; LAS unsigned char* ldsl; PP P; GAS unsigned char* ws; GAS float* out;
    int tid, lane, wave, G, bx;
};
DEV int tok_cond(int t) { return t < TC ? 0 : 1 + (t - TC) / DSEQ; }

DEV int hperm(int p) { const int bj = p >> 7, wc = (p >> 5) & 3, c5 = p & 31; return wc * 64 + 32 * bj + 16 * ((c5 >> 2) & 1) + 4 * (c5 >> 3) + (c5 & 3); }
DEV int win_src_col(int r) {
    if (r < 512) return (r & ~255) + hperm(r & 255);
    if (r < 1536) return r;
    if (r < 3840) return r + 16;
    if (r < 3856) return 1536 + (r - 3840);
    if (r < 4096) return -1;
    return r - 240;
}
DEV void transpose_item(const float* W, int ldw, int srccol, bf16* WT, int ldt, int drow0, int k0, float* scr, int lane) {
#pragma unroll 8
    for (int i = 0; i < 32; ++i) { const int kk = 2 * i + (lane >> 5); scr[kk * 33 + (lane & 31)] = srccol >= 0 ? NT_LD(W + (size_t)(k0 + kk) * ldw + srccol) : 0.f; }
    WAVE_SYNC();
    const int c = lane & 7;
#pragma unroll
    for (int j = 0; j < 4; ++j) { const int n = (lane >> 3) + 8 * j; const float* s = scr + (8 * c) * 33 + n;
        u32x4 o; o.x = pk2(s[0 * 33], s[1 * 33]); o.y = pk2(s[2 * 33], s[3 * 33]); o.z = pk2(s[4 * 33], s[5 * 33]); o.w = pk2(s[6 * 33], s[7 * 33]);
        *(u32x4*)(WT + (size_t)(drow0 + n) * ldt + k0 + 8 * c) = o; }
    WAVE_SYNC();
}
DEV void transpose_item64(const float* W, int ldw, int srccol0, bf16* WT, int ldt, int drow0, int k0, int dcol0, float* scr, int lane) {
    const int c4 = (lane & 15) * 4, r4 = lane >> 4;
#pragma unroll 8
    for (int i = 0; i < 16; ++i) { const int kk = 4 * i + r4; const f32x4 v = NT_LD((const f32x4*)(W + (size_t)(k0 + kk) * ldw + srccol0 + c4));
        float* d = scr + kk * 65 + c4; d[0] = v.x; d[1] = v.y; d[2] = v.z; d[3] = v.w; }
    WAVE_SYNC();
    const int c = lane & 7;
#pragma unroll
    for (int j = 0; j < 8; ++j) { const int n = (lane >> 3) + 8 * j; const float* sp = scr + (8 * c) * 65 + n;
        u32x4 o; o.x = pk2(sp[0 * 65], sp[1 * 65]); o.y = pk2(sp[2 * 65], sp[3 * 65]); o.z = pk2(sp[4 * 65], sp[5 * 65]); o.w = pk2(sp[6 * 65], sp[7 * 65]);
        *(u32x4*)(WT + (size_t)(drow0 + n) * ldt + dcol0 + 8 * c) = o; }
    WAVE_SYNC();
}
constexpr int CW_IN = 16 * (NPERM / 64), CW_BR = 4 * 4 * (D / 64), CW_OUT = 16 * (D / 64), CW_ITEMS = CW_IN + CW_BR + CW_OUT;
DEV void convert_item(Frame& F, int l, int it, float* scr) {
    const float* w_in = F.P->in[13] + (size_t)l * D * INW;
    const float* w_br = F.P->in[22] + (size_t)l * 4 * 256 * D;
    const float* w_out = F.P->in[23] + (size_t)l * D * D;
    bf16* WIN = (bf16*)(F.ws + WS_WIN); bf16* WBR = (bf16*)(F.ws + WS_WBR); bf16* WOUT = (bf16*)(F.ws + WS_WOUT);
    int r = it;
    if (r < CW_IN) { const int kb = r / (NPERM / 64), nb = r % (NPERM / 64), r0 = nb * 64;
        if (r0 < 512 || (r0 >= 3840 && r0 < 4096)) {
            transpose_item(w_in, INW, win_src_col(r0 + (F.lane & 31)), WIN, D, r0, kb * 64, scr, F.lane);
            transpose_item(w_in, INW, win_src_col(r0 + 32 + (F.lane & 31)), WIN, D, r0 + 32, kb * 64, scr, F.lane);
        } else transpose_item64(w_in, INW, win_src_col(r0), WIN, D, r0, kb * 64, kb * 64, scr, F.lane);
        return; }
    r -= CW_IN;
    if (r < CW_BR) { const int n = r / (4 * (D / 64)), q = r % (4 * (D / 64)), kb = q / (D / 64), nb = q % (D / 64);
        transpose_item64(w_br + (size_t)n * 256 * D, D, nb * 64, WBR, D, nb * 64, kb * 64, n * 256 + kb * 64, scr, F.lane); return; }
    r -= CW_BR;
    { const int kb = r / (D / 64), nb = r % (D / 64); transpose_item64(w_out, D, nb * 64, WOUT, D, nb * 64, kb * 64, kb * 64, scr, F.lane); }
}
DEV void convert_weights(Frame& F, int l) {
    float* scr = (float*)(F.lds + F.wave * 16640);
    const int gw = F.bx * 8 + F.wave, NGW = F.G * 8;
    for (int it = gw; it < CW_ITEMS; it += NGW) convert_item(F, l, it, scr);
}
constexpr int CT_AV = DEPTH * DB * 2 * (PAST / 64), CT_NV = DEPTH * DB * 4 * (PAST / 64), CT_S0 = 2 * DEPTH * DB * 8, CT_ITEMS = CT_AV + CT_NV + CT_S0;
DEV void cache_item(Frame& F, int it, float* scr) {
    int r = it;
    if (r < CT_AV) { const int sb = r % (PAST / 64); int q = r / (PAST / 64); const int h = q % 2; q /= 2; const int b = q % DB; const int l = q / DB;
        transpose_item64(F.P->in[3] + (((size_t)b * DEPTH + l) * PAST) * 128 + h * 64, 128, 0, (bf16*)(F.ws + WS_VACT) + (((size_t)l * DB + b) * 2 + h) * 64 * PAST, PAST, 0, sb * 64, sb * 64, scr, F.lane); return; }
    r -= CT_AV;
    if (r < CT_NV) { const int sb = r % (PAST / 64); int q = r / (PAST / 64); const int h = q % 4; q /= 4; const int b = q % DB; const int l = q / DB;
        transpose_item64(F.P->in[5] + (((size_t)b * DEPTH + l) * PAST) * 256 + h * 64, 256, 0, (bf16*)(F.ws + WS_NVCT) + (((size_t)l * DB + b) * 4 + h) * 64 * PAST, PAST, 0, sb * 64, sb * 64, scr, F.lane); return; }
    r -= CT_NV;
    { const int hd = r % 8; int q = r / 8; const int b = q % DB; q /= DB; const int l = q % DEPTH; const int type = q / DEPTH;
      const float* src = (type == 0 ? F.P->in[6] : F.P->in[7]) + (((size_t)b * DEPTH + l) * 8 + hd) * 4096;
      transpose_item64(src, 64, 0, (bf16*)(F.ws + WS_S0T) + (size_t)r * 4096, 64, 0, 0, 0, scr, F.lane); }
}
DEV void mod_item(Frame& F, int it, float* red, const float* scond) {
    float* MODT = (float*)(F.ws + WS_MODT);
    const int l = it / 48, c0 = (it % 48) * 64;
    const float* wa = F.P->in[10] + (size_t)l * D * 3072 + c0 + F.lane;
    float acc[NCOND];
#pragma unroll
    for (int j = 0; j < NCOND; ++j) acc[j] = 0.f;
    for (int k0 = F.wave * 128; k0 < F.wave * 128 + 128; k0 += 32) {
        float wv[32];
#pragma unroll
        for (int i = 0; i < 32; ++i) wv[i] = NT_LD(wa + (size_t)(k0 + i) * 3072);
#pragma unroll
        for (int i = 0; i < 32; ++i)
#pragma unroll
            for (int j = 0; j < NCOND; ++j) acc[j] += scond[j * D + k0 + i] * wv[i];
    }
#pragma unroll
    for (int j = 0; j < NCOND; ++j) red[(F.wave * NCOND + j) * 64 + F.lane] = acc[j];
    __syncthreads();
    for (int e = F.tid; e < NCOND * 64; e += 512) { const int j = e >> 6, ln = e & 63; float sm = F.P->in[11][(size_t)l * 3072 + c0 + ln];
        for (int w = 0; w < 8; ++w) sm += red[(w * NCOND + j) * 64 + ln];
        MODT[((size_t)l * NCOND + j) * 3072 + c0 + ln] = sm; }
    __syncthreads();
}
DEV void p0_prologue(Frame& F) {
    float* red = (float*)F.lds;
    float* scond = (float*)F.lds + 8 * NCOND * 64;
    float* scr = (float*)(F.lds + F.wave * 16640);
    volatile LAS unsigned* misc = (volatile LAS unsigned*)(F.ldsl + LDS_MISC);
    constexpr int U_MOD = DEPTH * 48, U_CW = (CW_ITEMS + 7) / 8, U_CT = (CT_ITEMS + 7) / 8;
    bool have_scond = false;
    for (;;) {
        __syncthreads();
        if (F.tid == 0) misc[16] = atomicAdd((unsigned*)(F.ws + WS_CTL) + 4096 + 64 * 2, 1u);
        __syncthreads();
        int u = __builtin_amdgcn_readfirstlane((int)misc[16]);
        if (u < U_MOD) {
            if (!have_scond) { for (int e = F.tid; e < NCOND * D; e += 512) { const int j = e / D, k = e % D; scond[e] = silu_f(j == 0 ? F.P->in[9][k] : F.P->in[8][(size_t)(j - 1) * D + k]); }
                __syncthreads(); have_scond = true; }
            mod_item(F, u, red, scond); continue; }
        u -= U_MOD; have_scond = false;
        if (u < U_CW) { const int it = u * 8 + F.wave; if (it < CW_ITEMS) convert_item(F, 0, it, scr); continue; }
        u -= U_CW;
        if (u < U_CT) { const int it = u * 8 + F.wave; if (it < CT_ITEMS) cache_item(F, it, scr); continue; }
        break;
    }
    if (F.bx == F.G - 1) {
        float* RC = (float*)(F.ws + WS_ROPE); float* RS = RC + 1024;
        for (int e = F.tid; e < 1024; e += 512) { const int pos = e >> 4, i = e & 15; const float inv = powf(10000.0f, -(float)i / 16.0f); const float ang = (float)pos * inv; RC[e] = cosf(ang); RS[e] = sinf(ang); }
    }
    const size_t gt = (size_t)F.bx * 512 + F.tid, NT = (size_t)F.G * 512;
    { bf16* KAC = (bf16*)(F.ws + WS_KAC); constexpr size_t n4 = (size_t)DEPTH * DB * 2 * PAST * 16;
#pragma unroll 4
      for (size_t e = gt; e < n4; e += NT) { const int d = (int)(e & 15) * 4; size_t q = e >> 4; const int sq = q % PAST; q /= PAST; const int h = q % 2; q /= 2; const int b = q % DB; const int l = q / DB;
          const f32x4 v = NT_LD((const f32x4*)(F.P->in[2] + ((((size_t)b * DEPTH + l) * PAST + sq) * 2 + h) * 64 + d)); u32x2 w; w.x = pk2(v.x, v.y); w.y = pk2(v.z, v.w); *(u32x2*)(KAC + e * 4) = w; } }
    { bf16* NKC = (bf16*)(F.ws + WS_NKC); constexpr size_t n4 = (size_t)DEPTH * DB * 4 * PAST * 16;
#pragma unroll 4
      for (size_t e = gt; e < n4; e += NT) { const int d = (int)(e & 15) * 4; size_t q = e >> 4; const int sq = q % PAST; q /= PAST; const int h = q % 4; q /= 4; const int b = q % DB; const int l = q / DB;
          const f32x4 v = NT_LD((const f32x4*)(F.P->in[4] + ((((size_t)b * DEPTH + l) * PAST + sq) * 4 + h) * 64 + d)); u32x2 w; w.x = pk2(v.x, v.y); w.y = pk2(v.z, v.w); *(u32x2*)(NKC + e * 4) = w; } }
}

DEV int norm_row0(const Frame& F, int i) { return (F.G * 64 == T && (F.G & 7) == 0) ? (F.bx & 7) * (T / 8) + ((F.bx >> 3) * 8 + F.wave) * 8 + 4 * i : -1; }
DEV void p1_norm(Frame& F, int l) {
    const float* MODT = (const float*)(F.ws + WS_MODT) + (size_t)l * NCOND * 3072;
    const float* ng = F.P->in[12] + (size_t)l * D;
    bf16* HN = (bf16*)(F.ws + WS_HN);
    const int gw = F.bx * 8 + F.wave, NGW = F.G * 8;
    if (F.G * 64 == T && (F.G & 7) == 0) {
        {
            const int t0 = norm_row0(F, 0);
            f32x4 v[8][4]; float s[8];
#pragma unroll
            for (int r = 0; r < 8; ++r) { const int t = t0 + r;
                const float* xrow = (l == 0) ? (t < TC ? F.P->in[0] + (size_t)t * D : F.P->in[1] + (size_t)(t - TC) * D) : F.out + (size_t)t * D;
#pragma unroll
                for (int j = 0; j < 4; ++j) v[r][j] = *(const f32x4*)(xrow + 4 * F.lane + 256 * j); }
#pragma unroll
            for (int r = 0; r < 8; ++r) { float a = 0.f;
#pragma unroll
                for (int j = 0; j < 4; ++j) a += (v[r][j].x * v[r][j].x + v[r][j].y * v[r][j].y) + (v[r][j].z * v[r][j].z + v[r][j].w * v[r][j].w);
                s[r] = 1.0f / sqrtf(wave_sum(a, F.lane) * (1.0f / D) + EPS); }
            const float* md = MODT + (size_t)tok_cond(t0) * 3072;
#pragma unroll
            for (int j = 0; j < 4; ++j) { const int c = 4 * F.lane + 256 * j;
                const f32x4 g = *(const f32x4*)(ng + c), sh = *(const f32x4*)(md + c), sc = *(const f32x4*)(md + 1024 + c); const f32x4 gs = g * (sc + 1.0f);
#pragma unroll
                for (int r = 0; r < 8; ++r) { const f32x4 o = v[r][j] * s[r] * gs + sh;
                    u32x2 w; w.x = pk2(o.x, o.y); w.y = pk2(o.z, o.w); *(u32x2*)(HN + (size_t)(t0 + r) * D + c) = w; } }
        }
        return;
    }
    for (int t = gw; t < T; t += NGW) {
        const float* xrow = (l == 0) ? (t < TC ? F.P->in[0] + (size_t)t * D : F.P->in[1] + (size_t)(t - TC) * D) : F.out + (size_t)t * D;
        const float* md = MODT + (size_t)tok_cond(t) * 3072;
        f32x4 v[4]; float s = 0.f;
#pragma unroll
        for (int j = 0; j < 4; ++j) { v[j] = *(const f32x4*)(xrow + 4 * F.lane + 256 * j); s += (v[j].x * v[j].x + v[j].y * v[j].y) + (v[j].z * v[j].z + v[j].w * v[j].w); }
        const float rstd = 1.0f / sqrtf(wave_sum(s, F.lane) * (1.0f / D) + EPS);
#pragma unroll
        for (int j = 0; j < 4; ++j) { const int c = 4 * F.lane + 256 * j;
            const f32x4 g = *(const f32x4*)(ng + c), sh = *(const f32x4*)(md + c), sc = *(const f32x4*)(md + 1024 + c);
            const f32x4 o = v[j] * rstd * g * (sc + 1.0f) + sh;
            u32x2 w; w.x = pk2(o.x, o.y); w.y = pk2(o.z, o.w); *(u32x2*)(HN + (size_t)t * D + c) = w; }
    }
}

struct EpiIn {
    static constexpr bool PERM = true;
    unsigned char* ws; float* out; const float* qn; const float* kn; const float* alog_; const float* dtb_; int l;
    DEV void operator()(const f32x4 (&acc)[2][2][4][2], const pg8::Unit& u, int wr, int wc, int fr, int fq) const {
        OPAQUE(fr); OPAQUE(fq);
        const int t0 = u.pm * 256; const bool ctx = t0 < TC;
        const int b = ctx ? t0 / SEQ : (t0 - TC) / DSEQ, sb = ctx ? t0 % SEQ : (t0 - TC) % DSEQ, L = ctx ? SEQ : DSEQ;
        const int rl0 = wr * 64 + fr;
        const int pn = u.pn;
        auto plain = [&](bf16* base, int ld, int coloff, int act, float scale) {
#pragma unroll
            for (int ai = 0; ai < 2; ++ai)
#pragma unroll
                for (int m = 0; m < 4; ++m) { const int t = t0 + rl0 + ai * 128 + m * 16; bf16* rowp = base + (size_t)t * ld + coloff + wc * 32 + 8 * fq;
#pragma unroll
                    for (int bj = 0; bj < 2; ++bj) { f32x4 v0 = acc[ai][bj][m][0], v1 = acc[ai][bj][m][1];
                        if (act == 1) { v0.x = silu_f(v0.x); v0.y = silu_f(v0.y); v0.z = silu_f(v0.z); v0.w = silu_f(v0.w); v1.x = silu_f(v1.x); v1.y = silu_f(v1.y); v1.z = silu_f(v1.z); v1.w = silu_f(v1.w); }
                        v0 = v0 * scale; v1 = v1 * scale;
                        u32x4 w; w.x = pk2(v0.x, v0.y); w.y = pk2(v0.z, v0.w); w.z = pk2(v1.x, v1.y); w.w = pk2(v1.z, v1.w);
                        *(u32x4*)(rowp + bj * 128) = w; } CFENCE(); }
        };
        if (pn == 0 || pn == 1) {
            const bool isq = (pn == 0), isv = (pn == 1 && wc >= 2);
            const float* gn = isq ? qn : kn;
            f32x4 gnv[2][2];
#pragma unroll
            for (int bj = 0; bj < 2; ++bj)
#pragma unroll
                for (int n = 0; n < 2; ++n) gnv[bj][n] = *(const f32x4*)(gn + 32 * bj + 16 * n + 4 * fq);
            const float* RC = (const float*)(ws + WS_ROPE); const float* RS = RC + 1024;
#pragma unroll
            for (int ai = 0; ai < 2; ++ai)
#pragma unroll
                for (int m = 0; m < 4; ++m) {
                    const int rl = rl0 + ai * 128 + m * 16, t = t0 + rl, s = sb + rl;
                    f32x4 x[2][2];
#pragma unroll
                    for (int bj = 0; bj < 2; ++bj)
#pragma unroll
                        for (int n = 0; n < 2; ++n) x[bj][n] = acc[ai][bj][m][n];
                    if (!isv) {
                        float ss = 0.f;
#pragma unroll
                        for (int bj = 0; bj < 2; ++bj)
#pragma unroll
                            for (int n = 0; n < 2; ++n) ss += (x[bj][n].x * x[bj][n].x + x[bj][n].y * x[bj][n].y) + (x[bj][n].z * x[bj][n].z + x[bj][n].w * x[bj][n].w);
                        ss += shx(ss, 16, fr + 16 * fq); ss += shx(ss, 32, fr + 16 * fq);
                        const float rstd = 1.0f / sqrtf(ss * (1.0f / 64.0f) + EPS);
#pragma unroll
                        for (int bj = 0; bj < 2; ++bj)
#pragma unroll
                            for (int n = 0; n < 2; ++n) x[bj][n] = x[bj][n] * rstd * gnv[bj][n];
                    }
                    if (pn == 1 && ctx) {
                        float* dst = out + (wc < 2 ? O_AK : O_AV) + (((size_t)b * DEPTH + l) * SEQ + s) * 128 + (wc & 1) * 64;
#pragma unroll
                        for (int bj = 0; bj < 2; ++bj)
#pragma unroll
                            for (int n = 0; n < 2; ++n) NT_ST((f32x4*)(dst + 32 * bj + 16 * n + 4 * fq), x[bj][n]);
                    }
                    if (!isv && !ctx) {
#pragma unroll
                        for (int bj = 0; bj < 2; ++bj) { const int pos = bj == 0 ? (s >> 6) : (s & 63);
                            const f32x4 cs = *(const f32x4*)(RC + pos * 16 + 4 * fq), sn = *(const f32x4*)(RS + pos * 16 + 4 * fq);
                            const f32x4 x1 = x[bj][0], x2 = x[bj][1];
                            x[bj][0] = x1 * cs - x2 * sn; x[bj][1] = x2 * cs + x1 * sn; }
                    }
                    if (isq) {
                        bf16* dst = (bf16*)(ws + WS_QA) + (size_t)t * 256 + wc * 64;
#pragma unroll
                        for (int bj = 0; bj < 2; ++bj)
#pragma unroll
                            for (int n = 0; n < 2; ++n) { const f32x4 v = x[bj][n] * (0.125f * 1.4426950408889634f); u32x2 w; w.x = pk2(v.x, v.y); w.y = pk2(v.z, v.w); *(u32x2*)(dst + 32 * bj + 16 * n + 4 * fq) = w; }
                    } else if (!isv) {
                        bf16* dst = (bf16*)(ws + WS_KA) + (ctx ? (size_t)0 : (size_t)TC * 128) + (((size_t)b * 2 + wc) * L + s) * 64;
#pragma unroll
                        for (int bj = 0; bj < 2; ++bj)
#pragma unroll
                            for (int n = 0; n < 2; ++n) { const f32x4 v = x[bj][n]; u32x2 w; w.x = pk2(v.x, v.y); w.y = pk2(v.z, v.w); *(u32x2*)(dst + 32 * bj + 16 * n + 4 * fq) = w; }
                    } else {
                        bf16* dst = (bf16*)(ws + WS_VAT) + (ctx ? (size_t)0 : (size_t)TC * 128) + ((size_t)b * 2 + (wc - 2)) * 64 * L + s;
#pragma unroll
                        for (int bj = 0; bj < 2; ++bj)
#pragma unroll
                            for (int n = 0; n < 2; ++n) { const int d0 = 32 * bj + 16 * n + 4 * fq;
                                dst[(size_t)(d0 + 0) * L] = (bf16)f2bf(x[bj][n].x); dst[(size_t)(d0 + 1) * L] = (bf16)f2bf(x[bj][n].y);
                                dst[(size_t)(d0 + 2) * L] = (bf16)f2bf(x[bj][n].z); dst[(size_t)(d0 + 3) * L] = (bf16)f2bf(x[bj][n].w); }
                    }
                    CFENCE();
                }
        } else if (pn == 2) plain((bf16*)(ws + WS_BR), 1024, 0, 1, 1.f);
        else if (pn >= 3 && pn <= 5) plain((bf16*)(ws + WS_GQKV), 768, (pn - 3) * 256, 0, 1.f);
        else if (pn == 6) plain((bf16*)(ws + WS_BR), 1024, 256, 1, 1.f);
        else if (pn == 7 || pn == 8) plain((bf16*)(ws + WS_RQKV), 512, (pn - 7) * 256, 0, pn == 7 ? 0.125f : 1.f);
        else if (pn == 10) plain((bf16*)(ws + WS_BR), 1024, 512, 1, 1.f);
        else if (pn == 11) plain((bf16*)(ws + WS_NQ), 256, 0, 0, 0.125f * 1.4426950408889634f);
        else if (pn == 12 || pn == 13 || pn == 9) {
            const bool isk = pn == 12; const bool isr = pn == 9;
#pragma unroll
            for (int ai = 0; ai < 2; ++ai)
#pragma unroll
                for (int m = 0; m < 4; ++m) { const int rl = rl0 + ai * 128 + m * 16, s = sb + rl;
#pragma unroll
                    for (int bj = 0; bj < 2; ++bj) { const int head = 2 * bj + (wc >> 1), d0 = 32 * (wc & 1) + 8 * fq;
                        const f32x4 v0 = acc[ai][bj][m][0], v1 = acc[ai][bj][m][1];
                        if (ctx && !isr) { float* dst = out + (isk ? O_NK : O_NV) + (((size_t)b * DEPTH + l) * SEQ + s) * 256 + head * 64 + d0; NT_ST((f32x4*)dst, v0); NT_ST((f32x4*)(dst + 4), v1); }
                        if (isk) { bf16* dst = (bf16*)(ws + WS_NK) + (ctx ? (size_t)0 : (size_t)TC * 256) + (((size_t)b * 4 + head) * L + s) * 64 + d0;
                            u32x4 w; w.x = pk2(v0.x, v0.y); w.y = pk2(v0.z, v0.w); w.z = pk2(v1.x, v1.y); w.w = pk2(v1.z, v1.w); *(u32x4*)dst = w; }
                        else { bf16* dst = (bf16*)(ws + (isr ? WS_RVT : WS_NVT)) + (ctx ? (size_t)0 : (size_t)TC * 256) + (((size_t)b * 4 + head) * 64 + d0) * L + s;
                            dst[0] = (bf16)f2bf(v0.x); dst[(size_t)L] = (bf16)f2bf(v0.y); dst[(size_t)2 * L] = (bf16)f2bf(v0.z); dst[(size_t)3 * L] = (bf16)f2bf(v0.w);
                            dst[(size_t)4 * L] = (bf16)f2bf(v1.x); dst[(size_t)5 * L] = (bf16)f2bf(v1.y); dst[(size_t)6 * L] = (bf16)f2bf(v1.z); dst[(size_t)7 * L] = (bf16)f2bf(v1.w); } } CFENCE(); }
        } else if (pn == 14) plain((bf16*)(ws + WS_BR), 1024, 768, 1, 1.f);
        else {
            if (wc == 0 && fq < 2) {
                const float* alog = alog_; const float* dtb = dtb_;
                float* GAB = (float*)(ws + WS_GAB);
#pragma unroll
                for (int ai = 0; ai < 2; ++ai)
#pragma unroll
                    for (int m = 0; m < 4; ++m) { const int t = t0 + rl0 + ai * 128 + m * 16;
#pragma unroll
                        for (int n = 0; n < 2; ++n) { const int c = 8 * fq + 4 * n; const f32x4 v = acc[ai][0][m][n]; f32x4 o;
                            if (c < 8) { o.x = sigmoid_f(v.x); o.y = sigmoid_f(v.y); o.z = sigmoid_f(v.z); o.w = sigmoid_f(v.w); }
                            else { const int dir = (c >> 2) - 2;
                                o.x = -__expf(alog[dir * 4 + 0]) * softplus_f(v.x + dtb[dir * 4 + 0]); o.y = -__expf(alog[dir * 4 + 1]) * softplus_f(v.y + dtb[dir * 4 + 1]);
                                o.z = -__expf(alog[dir * 4 + 2]) * softplus_f(v.z + dtb[dir * 4 + 2]); o.w = -__expf(alog[dir * 4 + 3]) * softplus_f(v.w + dtb[dir * 4 + 3]); }
                            *(f32x4*)(GAB + (size_t)t * 16 + c) = o; } CFENCE(); }
            }
        }
    }
};

DEV f32x4 mfma4(float a, float b, f32x4 c) { return __builtin_amdgcn_mfma_f32_16x16x4f32(a, b, c, 0, 0, 0); }
constexpr int GP = 72;
constexpr int TS_ = 68;
constexpr int G_TM = 0, G_KR = 17408, G_QR = G_KR + 9216, G_KT = G_QR + 9216, G_VT = G_KT + 9216, G_ST = G_VT + 9216, G_VEC = G_ST + 9216, G_HALF = G_VEC + 1536;
static_assert(2 * G_HALF <= 143360, "GDN LDS map");
DEV unsigned char* g_tm(unsigned char* lds, int half) { return lds + half * 17408; }
DEV unsigned char* g_half(unsigned char* lds, int half) { return lds + 2 * 17408 + half * (G_HALF - 17408); }
#define GOFF(x) ((x) - 17408)

DEV f32x4 bmma(bf16x8 a, bf16x8 b, f32x4 c) { return __builtin_amdgcn_mfma_f32_16x16x32_bf16(a, b, c, 0, 0, 0); }
DEV bf16x8 pack8(f32x4 lo, f32x4 hi) { u32x4 u; u.x = pk2(lo.x, lo.y); u.y = pk2(lo.z, lo.w); u.z = pk2(hi.x, hi.y); u.w = pk2(hi.z, hi.w); return __builtin_bit_cast(bf16x8, u); }
DEV bf16x8 ld8(const bf16* p) { return *(const bf16x8*)p; }
DEV bf16x8 ld44(const bf16* p0, const bf16* p1) { const u32x2 a = *(const u32x2*)p0, b = *(const u32x2*)p1; u32x4 u; u.x = a.x; u.y = a.y; u.z = b.x; u.w = b.y; return __builtin_bit_cast(bf16x8, u); }

constexpr int G_PB = 130048;
constexpr size_t WS_ZERO = WS_CTL + 32768;
constexpr int G_TB = G_PB + 26112;
DEV void gdn_dma(Frame& F, int l, int task) {
    const int chunk = task >> 2, head = task & 3, tid = F.tid;
    const int t0 = chunk * 64; const bool ctx = t0 < TC;
    const int L = ctx ? SEQ : DSEQ, s0 = ctx ? t0 % SEQ : (t0 - TC) % DSEQ, tseq = t0 - s0;
    const bf16* SRC = (const bf16*)(F.ws + WS_GQKV); const bf16* ZR = (const bf16*)(F.ws + WS_ZERO);
#pragma unroll
    for (int k = 0; k < 4; ++k) { const int e = tid + 512 * k; const int rr = e / 24, c8 = e % 24; const int sp = s0 - 2 + rr;
        const bf16* src = (sp >= 0 && sp < L) ? SRC + (size_t)(tseq + sp) * 768 + (c8 >> 3) * 256 + head * 64 + (c8 & 7) * 8 : ZR;
        if (e < 68 * 24) __builtin_amdgcn_global_load_lds((const unsigned*)src, (LAS unsigned*)(F.ldsl + G_PB + (F.wave * 64 + 512 * k) * 16), 16, 0, 0); }
#pragma unroll
    for (int rr = 0; rr < 2; ++rr) { const int r = F.wave * 2 + rr;
        if (r < 15) { const float* src = F.P->in[14] + (size_t)l * 5 * 768 + (r % 5) * 768 + (r / 5) * 256 + head * 64 + F.lane;
            __builtin_amdgcn_global_load_lds((const unsigned*)src, (LAS unsigned*)(F.ldsl + G_TB + r * 256), 4, 0, 0); } }
}
DEV void gdn_dma_wait() { PG8_WAIT_V(0); __syncthreads(); }
struct GdnPre { float ga[2]; };
template <bool NEEDQ>
DEV void gdn_prefetch(Frame& F, int l, int task, GdnPre& P) {
    const int chunk = task >> 2, head = task & 3, lane = F.lane, half = F.wave >> 2, wq = F.wave & 3;
    const int t0 = chunk * 64; const bool ctx = t0 < TC;
    const int s0 = ctx ? t0 % SEQ : (t0 - TC) % DSEQ, tseq = t0 - s0;
    P.ga[0] = 0.f; P.ga[1] = 0.f;
    if (wq == 3) { const int s = s0 + (half ? 63 - lane : lane); const float* ga = (const float*)(F.ws + WS_GAB) + (size_t)(tseq + s) * 16; P.ga[0] = ga[8 + half * 4 + head]; P.ga[1] = ga[half * 4 + head]; }
}
DEV bf16x8* gdn_tf(const Frame& F, int task, int half) { const size_t slot = (size_t)task * 2 + half; return (bf16x8*)(F.ws + (slot < TF_NA ? WS_WIN + slot * TF_SLOT : WS_TFB + (slot - TF_NA) * TF_SLOT)); }
template <bool NEEDQ, bool SKIPT = false>
DEV void gdn_front(Frame& F, int l, int chunk, int head, const GdnPre& P, int ntask, GdnPre& N) {
    const int tid = F.tid, lane = F.lane, li = lane & 15, lq = lane >> 4, half = F.wave >> 2, wq = F.wave & 3, dir = half;
    unsigned char* lds = F.lds;
    const int t0 = chunk * 64; const bool ctx = t0 < TC;
    const int L = ctx ? SEQ : DSEQ, s0 = ctx ? t0 % SEQ : (t0 - TC) % DSEQ, tseq = t0 - s0;
    const bf16* raw = (const bf16*)(lds + G_PB);
    float* Tm = (float*)g_tm(lds, half);
    unsigned char* hb = g_half(lds, half);
    bf16* kr = (bf16*)(hb + GOFF(G_KR)); bf16* qr = (bf16*)(hb + GOFF(G_QR)); bf16* kT = (bf16*)(hb + GOFF(G_KT)); bf16* vT = (bf16*)(hb + GOFF(G_VT));
    float* vec = (float*)(hb + GOFF(G_VEC)); float* gs = vec; float* bs = vec + 64; float* rnk = vec + 128; float* rnq = vec + 192; float* sc1 = vec + 256; float* scd = vec + 320;
    {
        LAS bf16* H0 = (LAS bf16*)(F.ldsl + 2 * 17408); LAS bf16* H1 = (LAS bf16*)(F.ldsl + 2 * 17408 + (G_HALF - 17408));
        const int pb = 32 * half + 8 * wq;
#pragma unroll
        for (int t = NEEDQ ? 0 : 1; t < 3; ++t) {
            const bf16* rc = raw + t * 64 + lane;
            float w5[5];
#pragma unroll
            for (int j = 0; j < 5; ++j) w5[j] = ((const float*)(lds + G_TB))[(t * 5 + j) * 64 + lane];
            const int orow = (t == 0 ? GOFF(G_QR) : GOFF(G_KR)) / 2, otr = (t == 1 ? GOFF(G_KT) : GOFF(G_VT)) / 2;
            float x0 = bf2f(rc[(pb + 0) * 192]), x1 = bf2f(rc[(pb + 1) * 192]), x2 = bf2f(rc[(pb + 2) * 192]), x3 = bf2f(rc[(pb + 3) * 192]);
            float yv[8];
#pragma unroll
            for (int e = 0; e < 8; ++e) { const int p = pb + e; const float x4 = bf2f(rc[(p + 4) * 192]);
                const float y = x0 * w5[0] + x1 * w5[1] + x2 * w5[2] + x3 * w5[3] + x4 * w5[4];
                x0 = x1; x1 = x2; x2 = x3; x3 = x4;
                yv[e] = silu_f(y);
                if (t < 2) { const bf16 yb = (bf16)f2bf(yv[e]); H0[orow + p * GP + lane] = yb; H1[orow + (63 - p) * GP + lane] = yb; } }
            if (t > 0) {
                u32x4 f, r; f.x = pk2(yv[0], yv[1]); f.y = pk2(yv[2], yv[3]); f.z = pk2(yv[4], yv[5]); f.w = pk2(yv[6], yv[7]);
                r.x = pk2(yv[7], yv[6]); r.y = pk2(yv[5], yv[4]); r.z = pk2(yv[3], yv[2]); r.w = pk2(yv[1], yv[0]);
                *(LAS u32x4*)(H0 + otr + lane * GP + pb) = f;
                *(LAS u32x4*)(H1 + otr + lane * GP + (56 - pb)) = r; }
        }
    }
    if (wq == 3) {
        float g = P.ga[0];
#pragma unroll
        for (int o = 1; o < 64; o <<= 1) { const float v = shf(g, lane >= o ? lane - o : lane); if (lane >= o) g += v; }
        gs[lane] = g; bs[lane] = P.ga[1];
    }
    __syncthreads();
    gdn_dma(F, l, ntask); gdn_prefetch<NEEDQ>(F, l, ntask, N);
    if (wq == 0 || (NEEDQ && wq == 1)) {
        const bf16* row = (wq == 0 ? kr : qr) + lane * GP; float ss = 0.f;
#pragma unroll
        for (int c = 0; c < 8; ++c) { const u32x4 v = *(const u32x4*)(row + 8 * c);
            const float a0 = bf2f(v.x & 0xffffu), a1 = bf2f(v.x >> 16), a2 = bf2f(v.y & 0xffffu), a3 = bf2f(v.y >> 16), a4 = bf2f(v.z & 0xffffu), a5 = bf2f(v.z >> 16), a6 = bf2f(v.w & 0xffffu), a7 = bf2f(v.w >> 16);
            ss += (a0 * a0 + a1 * a1) + (a2 * a2 + a3 * a3) + (a4 * a4 + a5 * a5) + (a6 * a6 + a7 * a7); }
        const float rn = 1.0f / sqrtf(ss + EPS);
        if (wq == 0) { rnk[lane] = rn; sc1[lane] = bs[lane] * __expf(gs[lane]) * rn; scd[lane] = rn * __expf(gs[63] - gs[lane]); }
        else rnq[lane] = rn * 0.125f;
    }
    __syncthreads();
    if constexpr (SKIPT) return;
    {
        auto a_tile = [&](int ti, int tj) {
            f32x4 c = {0.f, 0.f, 0.f, 0.f};
#pragma unroll
            for (int ks = 0; ks < 2; ++ks) c = bmma(ld8(kr + (16 * ti + li) * GP + 32 * ks + 8 * lq), ld8(kr + (16 * tj + li) * GP + 32 * ks + 8 * lq), c);
            const int j = 16 * tj + li; const float gj = gs[j], rj = rnk[j];
            const f32x4 gi4 = *(const f32x4*)(gs + 16 * ti + 4 * lq), bi4 = *(const f32x4*)(bs + 16 * ti + 4 * lq), ri4 = *(const f32x4*)(rnk + 16 * ti + 4 * lq);
#pragma unroll
            for (int r = 0; r < 4; ++r) { const int i = 16 * ti + 4 * lq + r; Tm[i * TS_ + j] = (i > j) ? c[r] * bi4[r] * ri4[r] * rj * __expf(gi4[r] - gj) : 0.f; }
        };
        auto z_tile = [&](int ti, int tj) {
#pragma unroll
            for (int r = 0; r < 4; ++r) Tm[(16 * ti + 4 * lq + r) * TS_ + 16 * tj + li] = 0.f; };
        if (wq == 0) { a_tile(0, 0); a_tile(3, 3); a_tile(3, 0); z_tile(0, 1); }
        else if (wq == 1) { a_tile(1, 1); a_tile(1, 0); a_tile(3, 1); z_tile(0, 2); }
        else if (wq == 2) { a_tile(2, 2); a_tile(2, 0); a_tile(3, 2); z_tile(0, 3); }
        else { a_tile(2, 1); z_tile(1, 2); z_tile(1, 3); z_tile(2, 3); }
    }
    __syncthreads();
    if (wq == half) {
        {   int cc = li; OPAQUE(cc);
            float* Ab = Tm + (16 * lq) * TS_ + 16 * lq;
            float x[16];
#pragma unroll
            for (int r = 0; r < 16; ++r) {
                float a0 = (r == cc) ? 1.f : 0.f, a1 = 0.f;
#pragma unroll
                for (int j4 = 0; j4 < (r + 3) / 4; ++j4) { const f32x4 a = *(const f32x4*)(Ab + r * TS_ + 4 * j4);
                    if (4 * j4 + 0 < r) a0 -= a.x * x[4 * j4 + 0];
                    if (4 * j4 + 1 < r) a1 -= a.y * x[4 * j4 + 1];
                    if (4 * j4 + 2 < r) a0 -= a.z * x[4 * j4 + 2];
                    if (4 * j4 + 3 < r) a1 -= a.w * x[4 * j4 + 3]; }
                x[r] = a0 + a1;
            }
            WAVE_SYNC();
#pragma unroll
            for (int r = 0; r < 16; ++r) Ab[r * TS_ + li] = x[r];
        }
        WAVE_SYNC();
#pragma unroll
        for (int i = 1; i < 4; ++i) {
            f32x4 Xr[3];
#pragma unroll
            for (int j = 0; j < 3; ++j) { if (j < i) {
                f32x4 M = {0.f, 0.f, 0.f, 0.f};
#pragma unroll
                for (int k = 0; k < 3; ++k) { if (k >= j && k < i) {
#pragma unroll
                    for (int ks = 0; ks < 4; ++ks) M = mfma4(Tm[(16 * i + li) * TS_ + 16 * k + 4 * ks + lq], Tm[(16 * k + 4 * ks + lq) * TS_ + 16 * j + li], M); } }
                f32x4 X = {0.f, 0.f, 0.f, 0.f};
#pragma unroll
                for (int r = 0; r < 4; ++r) X = mfma4(Tm[(16 * i + li) * TS_ + 16 * i + 4 * lq + r], M[r], X);
                Xr[j] = X; } }
            WAVE_SYNC();
#pragma unroll
            for (int j = 0; j < 3; ++j) { if (j < i) {
#pragma unroll
                for (int r = 0; r < 4; ++r) Tm[(16 * i + 4 * lq + r) * TS_ + 16 * j + li] = -Xr[j][r]; } }
            WAVE_SYNC();
        }
    }
    __syncthreads();
}

DEV void gdn_a_task(Frame& F, int l, int task, const GdnPre& pre, int ntask, GdnPre& nxt) {
    const int chunk = task >> 2, head = task & 3;
    gdn_dma_wait();
    gdn_front<false>(F, l, chunk, head, pre, ntask, nxt);
    if ((F.wave & 3) == 3) {
        const int li_ = F.lane & 15, lq_ = F.lane >> 4; const float* Tm_ = (const float*)g_tm(F.lds, F.wave >> 2); bf16x8* TF = gdn_tf(F, task, F.wave >> 2);
#pragma unroll
        for (int tc = 0; tc < 4; ++tc) { const float* tp = Tm_ + (16 * tc + li_) * TS_ + 4 * lq_; const int j0 = tc < 2 ? tc : 2 * tc - 2;
            TF[j0 * 64 + F.lane] = pack8(*(const f32x4*)tp, *(const f32x4*)(tp + 16));
            if (tc >= 2) TF[(j0 + 1) * 64 + F.lane] = pack8(*(const f32x4*)(tp + 32), *(const f32x4*)(tp + 48)); }
    }
    const int lane = F.lane, li = lane & 15, lq = lane >> 4, half = F.wave >> 2, tj = F.wave & 3, dir = half;
    const float* Tm = (const float*)g_tm(F.lds, half);
    unsigned char* hb = g_half(F.lds, half);
    const bf16* kT = (const bf16*)(hb + GOFF(G_KT)); const bf16* vT = (const bf16*)(hb + GOFF(G_VT));
    const float* vec = (const float*)(hb + GOFF(G_VEC)); const float* gs = vec; const float* bs = vec + 64; const float* sc1 = vec + 256; const float* scd = vec + 320;
    f32x4 w[4], u[4];
#pragma unroll
    for (int tc = 0; tc < 4; ++tc) { w[tc] = (f32x4){0.f, 0.f, 0.f, 0.f}; u[tc] = w[tc];
#pragma unroll
        for (int ks = 0; ks < 2; ++ks) { if (32 * ks <= 16 * tc + 15) {
            const float* tp = Tm + (16 * tc + li) * TS_ + 32 * ks + 8 * lq;
            const f32x4 t0 = *(const f32x4*)tp, t1 = *(const f32x4*)(tp + 4);
            const f32x4 s0 = *(const f32x4*)(sc1 + 32 * ks + 8 * lq), s1 = *(const f32x4*)(sc1 + 32 * ks + 8 * lq + 4);
            const f32x4 b0 = *(const f32x4*)(bs + 32 * ks + 8 * lq), b1 = *(const f32x4*)(bs + 32 * ks + 8 * lq + 4);
            w[tc] = bmma(pack8(t0 * s0, t1 * s1), ld8(kT + (16 * tj + li) * GP + 32 * ks + 8 * lq), w[tc]);
            u[tc] = bmma(pack8(t0 * b0, t1 * b1), ld8(vT + (16 * tj + li) * GP + 32 * ks + 8 * lq), u[tc]); } }
         }
#pragma unroll
    for (int tc = 0; tc < 4; ++tc) { const f32x4 sd = *(const f32x4*)(scd + 16 * tc + 4 * lq); w[tc] = w[tc] * sd; u[tc] = u[tc] * sd; }
    const bf16x8 wb0 = pack8(w[0], w[1]), wb1 = pack8(w[2], w[3]), ub0 = pack8(u[0], u[1]), ub1 = pack8(u[2], u[3]);
    const float egl = __expf(gs[63]);
    const size_t cell = ((size_t)chunk * 4 + head) * 2 + dir;
    float* Mb = (float*)(F.ws + WS_MB) + cell * 4096; float* Bb = (float*)(F.ws + WS_BS) + cell * 4096;
#pragma unroll
    for (int tk = 0; tk < 4; ++tk) {
        const bf16* kp = kT + (16 * tk + li) * GP + 4 * lq;
        const bf16x8 a0 = ld44(kp, kp + 16), a1 = ld44(kp + 32, kp + 48);
        f32x4 m = {0.f, 0.f, 0.f, 0.f}, bm = m;
        m = bmma(a0, wb0, m); m = bmma(a1, wb1, m); bm = bmma(a0, ub0, bm); bm = bmma(a1, ub1, bm);
#pragma unroll
        for (int r = 0; r < 4; ++r) { const int dk = 16 * tk + 4 * lq + r, dk2 = 16 * tj + li; Mb[dk * 64 + dk2] = (dk == dk2 ? egl : 0.f) - m[r]; }
        *(f32x4*)(Bb + ((tj * 4 + tk) * 64 + lane) * 4) = bm;

    }
    __syncthreads();
}
constexpr int N_GDN_TASKS = (T / 64) * 4;

DEV void gdn_b_wave(Frame& F, int l, int task) {
    const int lane = F.lane, li = lane & 15, lq = lane >> 4;
    const int tj = task & 3; int q = task >> 2; const int dir = q & 1; q >>= 1; const int head = q & 3; q >>= 2;
    const int seq = q < DB ? NB + q : q - DB;
    const bool ctx = seq < NB; const int L = ctx ? SEQ : DSEQ, nch = L / 64, tseq = ctx ? seq * SEQ : TC + (seq - NB) * DSEQ;
    f32x4 S[4];
    if (ctx) {
#pragma unroll
        for (int ti = 0; ti < 4; ++ti) S[ti] = (f32x4){0.f, 0.f, 0.f, 0.f};
    } else {
        const float* s0 = F.P->in[6] + ((((size_t)(seq - NB) * DEPTH + l) * 2 + dir) * 4 + head) * 4096;
#pragma unroll
        for (int ti = 0; ti < 4; ++ti)
#pragma unroll
            for (int r = 0; r < 4; ++r) S[ti][r] = NT_LD(s0 + (16 * ti + 4 * lq + r) * 64 + 16 * tj + li);
    }
    f32x4 mf[4][4], bm[4];
    auto cell_of = [&](int n) { const int c = dir ? nch - 1 - n : n; return ((size_t)(tseq / 64 + c) * 4 + head) * 2 + dir; };
    auto load_step = [&](int n, f32x4 (&m)[4][4], f32x4 (&b)[4]) { const size_t cell = cell_of(n);
        const float* Mb = (const float*)(F.ws + WS_MB) + cell * 4096; const float* Bb = (const float*)(F.ws + WS_BS) + cell * 4096;
#pragma unroll
        for (int ti = 0; ti < 4; ++ti) { b[ti] = *(const f32x4*)(Bb + ((tj * 4 + ti) * 64 + lane) * 4);
#pragma unroll
            for (int kb = 0; kb < 4; ++kb) m[ti][kb] = *(const f32x4*)(Mb + (16 * ti + li) * 64 + 16 * kb + 4 * lq); } };
    load_step(0, mf, bm);
    for (int n = 0; n < nch; ++n) {
        f32x4 mfn[4][4], bmn[4];
        if (n + 1 < nch) load_step(n + 1, mfn, bmn);
        float* Bb = (float*)(F.ws + WS_BS) + cell_of(n) * 4096;
        f32x4 nS[4];
#pragma unroll
        for (int ti = 0; ti < 4; ++ti) { nS[ti] = bm[ti]; *(f32x4*)(Bb + ((tj * 4 + ti) * 64 + lane) * 4) = S[ti]; }
#pragma unroll
        for (int kb = 0; kb < 4; ++kb)
#pragma unroll
            for (int r = 0; r < 4; ++r)
#pragma unroll
                for (int ti = 0; ti < 4; ++ti) nS[ti] = mfma4(mf[ti][kb][r], S[kb][r], nS[ti]);
#pragma unroll
        for (int ti = 0; ti < 4; ++ti) { S[ti] = nS[ti]; bm[ti] = bmn[ti];
#pragma unroll
            for (int kb = 0; kb < 4; ++kb) mf[ti][kb] = mfn[ti][kb]; }
    }
    if (ctx) { float* dst = F.out + O_SG + ((((size_t)seq * DEPTH + l) * 2 + dir) * 4 + head) * 4096;
#pragma unroll
        for (int ti = 0; ti < 4; ++ti)
#pragma unroll
            for (int r = 0; r < 4; ++r) NT_ST(dst + (16 * ti + 4 * lq + r) * 64 + 16 * tj + li, S[ti][r]); }
}
constexpr int N_GDNB_TASKS = NSEQ * 32;

template <bool DRY = false>
DEV void gdn_c_task(Frame& F, int l, int task, const GdnPre& pre, int ntask, GdnPre& nxt) {
    const int chunk = task >> 2, head = task & 3;
    const int tid = F.tid, lane = F.lane, li = lane & 15, lq = lane >> 4, half = F.wave >> 2, tj = F.wave & 3, dir = half;
    unsigned char* hb = g_half(F.lds, half);
    gdn_dma_wait();
    f32x4 sn[4]; u32x2 zc0, zc1;
    { const size_t cell = ((size_t)chunk * 4 + head) * 2 + half; const float* Sb = (const float*)(F.ws + WS_BS) + cell * 4096; const int ht = tid & 255;
#pragma unroll
      for (int e = 0; e < 4; ++e) sn[e] = *(const f32x4*)(Sb + (size_t)(ht + 256 * e) * 4);
      const bf16* zb = (const bf16*)(F.ws + WS_BR) + (size_t)(chunk * 64 + 8 * F.wave + (lane >> 4)) * 1024 + 256 + head * 64 + 4 * (lane & 15);
      zc0 = *(const u32x2*)zb; zc1 = *(const u32x2*)(zb + 4 * 1024); }
    const f32x4 gg = *(const f32x4*)(F.P->in[17] + l * 64 + 4 * li);
    bf16x8 tf[6];
    { const bf16x8* TF = gdn_tf(F, task, half);
#pragma unroll
      for (int j = 0; j < 6; ++j) tf[j] = TF[j * 64 + lane]; }
    gdn_front<true, true>(F, l, chunk, head, pre, ntask, nxt);
    {
        bf16* sT = (bf16*)(hb + GOFF(G_ST));
        const int ht = tid & 255;
#pragma unroll
        for (int e = 0; e < 4; ++e) { const int idx = ht + 256 * e;
            const f32x4 v = sn[e]; const int ln = idx & 63, ti2 = (idx >> 6) & 3, tj2 = idx >> 8;
            const int dv = 16 * tj2 + (ln & 15), dk = 16 * ti2 + 4 * (ln >> 4);
            u32x2 w; w.x = pk2(v.x, v.y); w.y = pk2(v.z, v.w); *(u32x2*)(sT + dv * GP + dk) = w; }
    }
    __syncthreads();
    float* Tm = (float*)g_tm(F.lds, half);
    const bf16* kr = (const bf16*)(hb + GOFF(G_KR)); const bf16* qr = (const bf16*)(hb + GOFF(G_QR)); const bf16* vT = (const bf16*)(hb + GOFF(G_VT)); const bf16* sT = (const bf16*)(hb + GOFF(G_ST));
    const float* vec = (const float*)(hb + GOFF(G_VEC)); const float* gs = vec; const float* bs = vec + 64; const float* rnk = vec + 128; const float* rnq = vec + 192;
    f32x4 X[4];
#pragma unroll
    for (int tc = 0; tc < 4; ++tc) { f32x4 a = {0.f, 0.f, 0.f, 0.f};
#pragma unroll
        for (int ks = 0; ks < 2; ++ks) a = bmma(ld8(kr + (16 * tc + li) * GP + 32 * ks + 8 * lq), ld8(sT + (16 * tj + li) * GP + 32 * ks + 8 * lq), a);
        const u32x2 vv = *(const u32x2*)(vT + (16 * tj + li) * GP + 16 * tc + 4 * lq);
        const f32x4 vf = {bf2f(vv.x & 0xffffu), bf2f(vv.x >> 16), bf2f(vv.y & 0xffffu), bf2f(vv.y >> 16)};
        const f32x4 g4 = *(const f32x4*)(gs + 16 * tc + 4 * lq), b4 = *(const f32x4*)(bs + 16 * tc + 4 * lq), r4 = *(const f32x4*)(rnk + 16 * tc + 4 * lq);
#pragma unroll
        for (int r = 0; r < 4; ++r) X[tc][r] = b4[r] * (vf[r] - __expf(g4[r]) * r4[r] * a[r]); }

    f32x4 vn[4];
    { const bf16x8 xb0 = pack8(X[0], X[1]), xb1 = pack8(X[2], X[3]);
#pragma unroll
      for (int tc = 0; tc < 4; ++tc) { const int j0 = tc < 2 ? tc : 2 * tc - 2; f32x4 a = {0.f, 0.f, 0.f, 0.f};
          a = bmma(tf[j0], xb0, a);
          if (tc >= 2) a = bmma(tf[j0 + 1], xb1, a);
          vn[tc] = a; } }
    const bf16x8 vb0 = pack8(vn[0], vn[1]), vb1 = pack8(vn[2], vn[3]);

    f32x4 o[4];
#pragma unroll
    for (int ti = 0; ti < 4; ++ti) { f32x4 a = {0.f, 0.f, 0.f, 0.f};
#pragma unroll
        for (int ks = 0; ks < 2; ++ks) a = bmma(ld8(qr + (16 * ti + li) * GP + 32 * ks + 8 * lq), ld8(sT + (16 * tj + li) * GP + 32 * ks + 8 * lq), a);
        const f32x4 g4 = *(const f32x4*)(gs + 16 * ti + 4 * lq), q4 = *(const f32x4*)(rnq + 16 * ti + 4 * lq);
#pragma unroll
        for (int r = 0; r < 4; ++r) a[r] *= q4[r] * __expf(g4[r]);
        o[ti] = a; }
    {
        bf16* QKL = (bf16*)g_tm(F.lds, half);
        auto qk_tile = [&](int ti, int tc) {
            f32x4 a = {0.f, 0.f, 0.f, 0.f};
#pragma unroll
            for (int ks = 0; ks < 2; ++ks) a = bmma(ld8(kr + (16 * tc + li) * GP + 32 * ks + 8 * lq), ld8(qr + (16 * ti + li) * GP + 32 * ks + 8 * lq), a);
            const int i = 16 * ti + li; const float gi = gs[i], rqi = rnq[i];
            const f32x4 gc = *(const f32x4*)(gs + 16 * tc + 4 * lq), rc = *(const f32x4*)(rnk + 16 * tc + 4 * lq);
#pragma unroll
            for (int r = 0; r < 4; ++r) { const int c = 16 * tc + 4 * lq + r; a[r] = (i >= c) ? a[r] * rc[r] * rqi * __expf(gi - gc[r]) : 0.f; }
            u32x2 w; w.x = pk2(a.x, a.y); w.y = pk2(a.z, a.w); *(u32x2*)(QKL + i * GP + 16 * tc + 4 * lq) = w; };
        if (tj == 0) { qk_tile(3, 0); qk_tile(3, 3); qk_tile(0, 0); }
        else if (tj == 1) { qk_tile(3, 1); qk_tile(1, 1); qk_tile(1, 0); }
        else if (tj == 2) { qk_tile(3, 2); qk_tile(2, 2); }
        else { qk_tile(2, 0); qk_tile(2, 1); }
        __syncthreads();
#pragma unroll
        for (int ti = 0; ti < 4; ++ti) { const bf16* rp = QKL + (16 * ti + li) * GP + 4 * lq;
            const u32x2 q0 = *(const u32x2*)rp, q1 = ti >= 1 ? *(const u32x2*)(rp + 16) : (u32x2){0u, 0u};
            u32x4 f0; f0.x = q0.x; f0.y = q0.y; f0.z = q1.x; f0.w = q1.y;
            o[ti] = bmma(__builtin_bit_cast(bf16x8, f0), vb0, o[ti]);
            if (ti >= 2) { const u32x2 q2 = *(const u32x2*)(rp + 32), q3 = ti >= 3 ? *(const u32x2*)(rp + 48) : (u32x2){0u, 0u};
                u32x4 f1; f1.x = q2.x; f1.y = q2.y; f1.z = q3.x; f1.w = q3.y;
                o[ti] = bmma(__builtin_bit_cast(bf16x8, f1), vb1, o[ti]); } }
    }
    __syncthreads();
#pragma unroll
    for (int ti = 0; ti < 4; ++ti)
#pragma unroll
        for (int r = 0; r < 4; ++r) { const int i = 16 * ti + 4 * lq + r; Tm[(dir ? 63 - i : i) * TS_ + 16 * tj + li] = o[ti][r]; }
    __syncthreads();
    {
        const float* O0 = (const float*)g_tm(F.lds, 0); const float* O1 = (const float*)g_tm(F.lds, 1);
#pragma unroll
        for (int it = 0; it < 2; ++it) { const int pos = 8 * F.wave + 4 * it + lq;
            const f32x4 a = *(const f32x4*)(O0 + pos * TS_ + 4 * li) + *(const f32x4*)(O1 + pos * TS_ + 4 * li);
            float ss = (a.x * a.x + a.y * a.y) + (a.z * a.z + a.w * a.w);
            ss += shx(ss, 1, lane); ss += shx(ss, 2, lane); ss += shx(ss, 4, lane); ss += shx(ss, 8, lane);
            const float rstd = 1.0f / sqrtf(ss * (1.0f / 64.0f) + EPS);
            bf16* z = (bf16*)(F.ws + WS_BR) + (size_t)(chunk * 64 + pos) * 1024 + 256 + head * 64 + 4 * li; const u32x2 zz = it == 0 ? zc0 : zc1;
            u32x2 wv; wv.x = pk2(a.x * rstd * gg.x * bf2f(zz.x & 0xffffu), a.y * rstd * gg.y * bf2f(zz.x >> 16)); wv.y = pk2(a.z * rstd * gg.z * bf2f(zz.y & 0xffffu), a.w * rstd * gg.w * bf2f(zz.y >> 16));
            if (DRY) *(volatile u32x2*)(F.lds + 143360 + lane * 8) = wv; else *(u32x2*)z = wv; }
    }
    __syncthreads();
}

constexpr int AT_BUF = 36864;
constexpr int AT_VP = 136;
struct AtSrc { const bf16* k; const bf16* vt; int kstr, vld, nst; };
struct AtState { f32x4 o[4]; float m, l; };

DEV float ret_lg2(int dir, int head) { const float uu = exp2f(-((dir ? 5.5f : 5.0f) + (float)head)); const float ln = -uu * (1.f + uu * (0.5f + uu * (1.f / 3.f + uu * (0.25f + uu * (0.2f + uu * (1.f / 6.f)))))); return ln * 1.4426950408889634f; }

DEV void sm_update(AtState& S, f32x4 (&st)[2], const bf16x8 (&vf)[4], int lane) {
    float mb = fmaxf(fmaxf(fmaxf(st[0].x, st[0].y), fmaxf(st[0].z, st[0].w)), fmaxf(fmaxf(st[1].x, st[1].y), fmaxf(st[1].z, st[1].w)));
    if (__any(mb > 8.0f)) {
        mb = fmaxf(mb, shx(mb, 16, lane)); mb = fmaxf(mb, shx(mb, 32, lane));
        const float dm = fmaxf(mb, 0.f), alpha = __builtin_amdgcn_exp2f(-dm);
        S.m += dm; S.l *= alpha;
#pragma unroll
        for (int dt = 0; dt < 4; ++dt) S.o[dt] = S.o[dt] * alpha;
#pragma unroll
        for (int kt = 0; kt < 2; ++kt) st[kt] = st[kt] - dm;
    }
    float ps = 0.f; float pv[8];
#pragma unroll
    for (int kt = 0; kt < 2; ++kt)
#pragma unroll
        for (int r = 0; r < 4; ++r) { const float p = __builtin_amdgcn_exp2f(st[kt][r]); pv[kt * 4 + r] = p; ps += p; }
    S.l += ps;
    u32x4 pu; pu.x = pk2(pv[0], pv[1]); pu.y = pk2(pv[2], pv[3]); pu.z = pk2(pv[4], pv[5]); pu.w = pk2(pv[6], pv[7]);
    const bf16x8 pf = __builtin_bit_cast(bf16x8, pu);
    __builtin_amdgcn_s_setprio(1);
#pragma unroll
    for (int dt = 0; dt < 4; ++dt) S.o[dt] = __builtin_amdgcn_mfma_f32_16x16x32_bf16(vf[dt], pf, S.o[dt], 0, 0, 0);
    __builtin_amdgcn_s_setprio(0);
}

template <int MODE>
DEV void at_stream(Frame& F, const bf16x8 (&qf)[2][2], const AtSrc& A, const AtSrc& B, AtState (&S)[2], int tq0, float lf2, float lb2) {
    const int tid = F.tid, lane = F.lane, li = lane & 15, lq = lane >> 4;
    const int ns = A.nst + B.nst;
    const int srow = tid >> 3, sch = (tid & 7) * 8;
    const int vrow = tid >> 4, vch = (tid & 15) * 8;
    struct StageRegs { u32x4 k0, k1, v0, v1; };
    StageRegs kra, krb; u32x4 vra, vrb;
    auto gload = [&](int st, StageRegs& R, u32x4&) { const bool a = st < A.nst; const bf16* kp = a ? A.k : B.k; const bf16* vp = a ? A.vt : B.vt; const int ks = a ? A.kstr : B.kstr, vl = a ? A.vld : B.vld, s2 = a ? st : st - A.nst;
        R.k0 = *(const u32x4*)(kp + (size_t)(s2 * 128 + srow) * ks + sch); R.k1 = *(const u32x4*)(kp + (size_t)(s2 * 128 + 64 + srow) * ks + sch);
        R.v0 = *(const u32x4*)(vp + (size_t)vrow * vl + s2 * 128 + vch); R.v1 = *(const u32x4*)(vp + (size_t)(vrow + 32) * vl + s2 * 128 + vch); };
    auto lstore = [&](int buf, const StageRegs& R, const u32x4&) { unsigned char* b = F.lds + buf * AT_BUF;
        *(u32x4*)(b + (srow * 72 + sch) * 2) = R.k0; *(u32x4*)(b + ((srow + 64) * 72 + sch) * 2) = R.k1;
        *(u32x4*)(b + 18432 + (vrow * AT_VP + vch) * 2) = R.v0; *(u32x4*)(b + 18432 + ((vrow + 32) * AT_VP + vch) * 2) = R.v1; };
    float cf[8], cb[8]; int q0w = 0;
    if (MODE == 1) {
#pragma unroll
        for (int e = 0; e < 8; ++e) { const float j = (float)(8 * lq + e); cf[e] = __builtin_amdgcn_exp2f(-lf2 * j); cb[e] = __builtin_amdgcn_exp2f(lb2 * j); }
        q0w = __builtin_amdgcn_readfirstlane(tq0 - li);
    }
    gload(0, kra, vra); if (ns > 1) gload(1, krb, vrb);
    lstore(0, kra, vra);
    __syncthreads();
    for (int st = 0; st < ns; ++st) {
        if (st + 2 < ns) gload(st + 2, kra, vra);
        const bf16* kl = (const bf16*)(F.lds + (st & 1) * AT_BUF); const bf16* vl = kl + 9216;
#pragma unroll 1
        for (int sub = 0; sub < 4; ++sub) {
            bf16x8 kf[2][2];
#pragma unroll
            for (int kt = 0; kt < 2; ++kt)
#pragma unroll
                for (int ks = 0; ks < 2; ++ks) kf[kt][ks] = *(const bf16x8*)(kl + (32 * sub + 8 * (li >> 2) + 4 * kt + (li & 3)) * 72 + 32 * ks + 8 * lq);
            bf16x8 vf[4];
#pragma unroll
            for (int dt = 0; dt < 4; ++dt) vf[dt] = *(const bf16x8*)(vl + (16 * dt + li) * AT_VP + 32 * sub + 8 * lq);
#pragma unroll
            for (int ti = 0; ti < 2; ++ti) {
                f32x4 sc[2];
                __builtin_amdgcn_s_setprio(1);
#pragma unroll
                for (int kt = 0; kt < 2; ++kt) { sc[kt] = (f32x4){0.f, 0.f, 0.f, 0.f};
#pragma unroll
                    for (int ks = 0; ks < 2; ++ks) sc[kt] = __builtin_amdgcn_mfma_f32_16x16x32_bf16(kf[kt][ks], qf[ti][ks], sc[kt], 0, 0, 0); }
                __builtin_amdgcn_s_setprio(0);
                if (MODE == 0) { sc[0] = sc[0] - S[ti].m; sc[1] = sc[1] - S[ti].m; sm_update(S[ti], sc, vf, lane); }
                else {
                    const int tq = tq0 + 16 * ti, kb0 = st * 128 + sub * 32, qt0 = q0w + 16 * ti;
                    float pv[8];
                    if (kb0 + 31 < qt0) {
                        const float a = __builtin_amdgcn_exp2f(lf2 * (float)(tq - kb0));
#pragma unroll
                        for (int e = 0; e < 8; ++e) pv[e] = sc[e >> 2][e & 3] * cf[e] * a;
                    } else if (kb0 > qt0 + 15) {
                        const float a = __builtin_amdgcn_exp2f(lb2 * (float)(kb0 - tq));
#pragma unroll
                        for (int e = 0; e < 8; ++e) pv[e] = sc[e >> 2][e & 3] * cb[e] * a;
                    } else {
#pragma unroll
                    for (int kt = 0; kt < 2; ++kt)
#pragma unroll
                        for (int r = 0; r < 4; ++r) { const int d = tq - (kb0 + 8 * lq + 4 * kt + r); const float fd = (float)d;
                            const float wf = d >= 0 ? exp2f(lf2 * fd) : 0.f, wb = d <= 0 ? exp2f(-lb2 * fd) : 0.f;
                            pv[kt * 4 + r] = sc[kt][r] * (wf + wb); }
                    }
                    u32x4 pu; pu.x = pk2(pv[0], pv[1]); pu.y = pk2(pv[2], pv[3]); pu.z = pk2(pv[4], pv[5]); pu.w = pk2(pv[6], pv[7]);
                    const bf16x8 pf = __builtin_bit_cast(bf16x8, pu);
                    __builtin_amdgcn_s_setprio(1);
#pragma unroll
                    for (int dt = 0; dt < 4; ++dt) S[ti].o[dt] = __builtin_amdgcn_mfma_f32_16x16x32_bf16(vf[dt], pf, S[ti].o[dt], 0, 0, 0);
                    __builtin_amdgcn_s_setprio(0);
                }
            }
        }
        if (st + 1 < ns) lstore((st + 1) & 1, krb, vrb);
        __syncthreads();
        krb = kra; vrb = vra;
    }
}

template <bool DRY = false>
DEV void at_finish_softmax_(AtState& S, bf16* gate_io, int lane, unsigned char* g_dry = nullptr) {
    const int lq = lane >> 4;
    float lsum = S.l; lsum += shx(lsum, 16, lane); lsum += shx(lsum, 32, lane);
    const float inv = 1.0f / lsum;
#pragma unroll
    for (int dt = 0; dt < 4; ++dt) { bf16* gp = gate_io + 16 * dt + 4 * lq; const u32x2 g = *(const u32x2*)gp;
        const float r0 = S.o[dt].x * inv * bf2f(g.x & 0xffffu), r1 = S.o[dt].y * inv * bf2f(g.x >> 16), r2 = S.o[dt].z * inv * bf2f(g.y & 0xffffu), r3 = S.o[dt].w * inv * bf2f(g.y >> 16);
        u32x2 w; w.x = pk2(r0, r1); w.y = pk2(r2, r3); if (DRY) *(volatile u32x2*)(g_dry + (lane & 63) * 8) = w; else *(u32x2*)gp = w; }
}
#define at_finish_softmax(S_, g_, l_) at_finish_softmax_<DRY>(S_, g_, l_, F.lds + 143360)

constexpr int N_AT_UNITS = 3 * DB * 16 + 3 * NB * 4;
template <bool DRY = false>
DEV void at_unit(Frame& F, int l, int u, unsigned* qctr = nullptr, unsigned* nx = nullptr) {
    const int lane = F.lane, li = lane & 15, lq = lane >> 4, w = F.wave;
    int kind;
    if (u < DB * 16) kind = 0; else if (u < 2 * DB * 16) { kind = 1; u -= DB * 16; } else if (u < 3 * DB * 16) { kind = 2; u -= 2 * DB * 16; }
    else { u -= 3 * DB * 16; kind = 3 + u / (NB * 4); u %= NB * 4; }
    const bool ctx = kind >= 3;
    const int b = ctx ? u / 4 : u / 16, h = ctx ? u % 4 : (u % 16) / 4, qb = ctx ? 0 : u % 4;
    const int L = ctx ? SEQ : DSEQ, tseq = ctx ? b * SEQ : TC + b * DSEQ;
    const int q0 = qb * 256 + w * 32;
    AtSrc A, B; B.k = nullptr; B.vt = nullptr; B.kstr = 64; B.vld = 64; B.nst = 0;
    AtState S[2];
#pragma unroll
    for (int ti = 0; ti < 2; ++ti) {
#pragma unroll
        for (int dt = 0; dt < 4; ++dt) S[ti].o[dt] = (f32x4){0.f, 0.f, 0.f, 0.f};
        S[ti].m = -1024.0f; S[ti].l = 0.f; }
    bf16x8 qf[2][2];
    auto load_q = [&](const bf16* qbase, int rowstride, int coloff) {
#pragma unroll
        for (int ti = 0; ti < 2; ++ti) { const bf16* q = qbase + (size_t)(tseq + q0 + 16 * ti + li) * rowstride + coloff + h * 64;
            qf[ti][0] = *(const bf16x8*)(q + 8 * lq); qf[ti][1] = *(const bf16x8*)(q + 32 + 8 * lq); } };
    if (kind == 0 || kind == 3) {
        const int kvh = h >> 1;
        load_q((const bf16*)(F.ws + WS_QA), 256, 0);
        A.k = (const bf16*)(F.ws + WS_KA) + (ctx ? (size_t)0 : (size_t)TC * 128) + ((size_t)b * 2 + kvh) * L * 64; A.vt = (const bf16*)(F.ws + WS_VAT) + (ctx ? (size_t)0 : (size_t)TC * 128) + ((size_t)b * 2 + kvh) * 64 * L;
        A.kstr = 64; A.vld = L; A.nst = L / 128;
        if (!ctx) { B.k = (const bf16*)(F.ws + WS_KAC) + (((size_t)l * DB + b) * 2 + kvh) * PAST * 64; B.vt = (const bf16*)(F.ws + WS_VACT) + (((size_t)l * DB + b) * 2 + kvh) * 64 * PAST; B.kstr = 64; B.vld = PAST; B.nst = PAST / 128; }
        at_stream<0>(F, qf, A, B, S, 0, 0.f, 0.f);
        if (nx && F.tid == 0) *nx = atomicAdd(qctr, 1u);
#pragma unroll
        for (int ti = 0; ti < 2; ++ti) at_finish_softmax(S[ti], (bf16*)(F.ws + WS_BR) + (size_t)(tseq + q0 + 16 * ti + li) * 1024 + h * 64, lane);
    } else if (kind == 4) {
        load_q((const bf16*)(F.ws + WS_NQ), 256, 0);
        A.k = (const bf16*)(F.ws + WS_NK) + ((size_t)b * 4 + h) * SEQ * 64; A.vt = (const bf16*)(F.ws + WS_NVT) + ((size_t)b * 4 + h) * 64 * SEQ; A.kstr = 64; A.vld = SEQ; A.nst = SEQ / 128;
        at_stream<0>(F, qf, A, B, S, 0, 0.f, 0.f);
        if (nx && F.tid == 0) *nx = atomicAdd(qctr, 1u);
#pragma unroll
        for (int ti = 0; ti < 2; ++ti) at_finish_softmax(S[ti], (bf16*)(F.ws + WS_BR) + (size_t)(tseq + q0 + 16 * ti + li) * 1024 + 768 + h * 64, lane);
    } else if (kind == 2) {
        load_q((const bf16*)(F.ws + WS_NQ), 256, 0);
        const int r = q0 >> 6;
        const int rs = r - 4 < 0 ? 0 : (r - 4 > 8 ? 8 : r - 4);
        float* bias = (float*)(F.lds + 2 * AT_BUF);
        { const float* bsrc = F.P->in[21] + ((size_t)l * 4 + h) * 15 * 31; if (F.tid < 465) bias[F.tid] = bsrc[F.tid] * 1.4426950408889634f; }
        __syncthreads();
#pragma unroll
        for (int ti = 0; ti < 2; ++ti) {
            const int jb = ((q0 & 63) >> 4) + ti; const int bs = jb * 16 - 8 < 0 ? 0 : (jb * 16 - 8 > 32 ? 32 : jb * 16 - 8);
            const int tok0 = rs * 64 + bs;
            const bf16* kA = (const bf16*)(F.ws + WS_NK) + (size_t)TC * 256 + (((size_t)b * 4 + h) * DSEQ + tok0) * 64;
            const bf16* vA = (const bf16*)(F.ws + WS_NVT) + (size_t)TC * 256 + ((size_t)b * 4 + h) * 64 * DSEQ + tok0;
            const int qc = jb * 16 + li, cs = qc - 8 < 0 ? 0 : (qc - 8 > 48 ? 48 : qc - 8);
            auto load_blk = [&](int blk, bf16x8 (&kf)[2][2], bf16x8 (&vf)[4]) {
                const bf16* kb = kA + (size_t)blk * 4096; const bf16* vb = vA + (size_t)blk * 64;
#pragma unroll
                for (int kt = 0; kt < 2; ++kt)
#pragma unroll
                    for (int ks = 0; ks < 2; ++ks) kf[kt][ks] = *(const bf16x8*)(kb + (size_t)(8 * (li >> 2) + 4 * kt + (li & 3)) * 64 + 32 * ks + 8 * lq);
#pragma unroll
                for (int dt = 0; dt < 4; ++dt) vf[dt] = *(const bf16x8*)(vb + (size_t)(16 * dt + li) * DSEQ + 8 * lq); };
            bf16x8 kc[2][2], vc[4];
            load_blk(0, kc, vc);
            for (int blk = 0; blk < 8; ++blk) {
                bf16x8 kn[2][2], vn[4];
                load_blk(blk < 7 ? blk + 1 : 7, kn, vn);
                f32x4 sc[2];
#pragma unroll
                for (int kt = 0; kt < 2; ++kt) { sc[kt] = (f32x4){0.f, 0.f, 0.f, 0.f};
#pragma unroll
                    for (int ks = 0; ks < 2; ++ks) sc[kt] = __builtin_amdgcn_mfma_f32_16x16x32_bf16(kc[kt][ks], qf[ti][ks], sc[kt], 0, 0, 0); }
                const int dr = rs + blk - r + 7;
#pragma unroll
                for (int kt = 0; kt < 2; ++kt)
#pragma unroll
                    for (int rr = 0; rr < 4; ++rr) { const int kc_ = bs + 8 * lq + 4 * kt + rr; int dc = kc_ - qc + 15; dc = dc < 0 ? 0 : (dc > 30 ? 30 : dc);
                        float bv = bias[dr * 31 + dc]; OPAQUE(bv);
                        const bool ok = kc_ >= cs && kc_ < cs + 16;
                        sc[kt][rr] = ok ? sc[kt][rr] + bv : -1e30f; }
                sc[0] = sc[0] - S[ti].m; sc[1] = sc[1] - S[ti].m; sm_update(S[ti], sc, vc, lane);
#pragma unroll
                for (int kt = 0; kt < 2; ++kt)
#pragma unroll
                    for (int ks = 0; ks < 2; ++ks) kc[kt][ks] = kn[kt][ks];
#pragma unroll
                for (int dt = 0; dt < 4; ++dt) vc[dt] = vn[dt];
            }
        }
        __syncthreads();
        A.k = (const bf16*)(F.ws + WS_NKC) + (((size_t)l * DB + b) * 4 + h) * PAST * 64; A.vt = (const bf16*)(F.ws + WS_NVCT) + (((size_t)l * DB + b) * 4 + h) * 64 * PAST; A.kstr = 64; A.vld = PAST; A.nst = PAST / 128;
        at_stream<0>(F, qf, A, B, S, 0, 0.f, 0.f);
        if (nx && F.tid == 0) *nx = atomicAdd(qctr, 1u);
#pragma unroll
        for (int ti = 0; ti < 2; ++ti) at_finish_softmax(S[ti], (bf16*)(F.ws + WS_BR) + (size_t)(tseq + q0 + 16 * ti + li) * 1024 + 768 + h * 64, lane);
    } else {
        const bf16* RQ = (const bf16*)(F.ws + WS_RQKV);
        load_q(RQ, 512, 0);
        const float lf2 = ret_lg2(0, h), lb2 = ret_lg2(1, h);
        if (!ctx) {
#pragma unroll
            for (int dir = 0; dir < 2; ++dir) {
                const bf16* s0t = (const bf16*)(F.ws + WS_S0T) + ((((size_t)(1 * DEPTH + l) * DB + b) * 2 + dir) * 4 + h) * 4096;
#pragma unroll
                for (int dt = 0; dt < 4; ++dt) { const bf16x8 s0f = *(const bf16x8*)(s0t + (size_t)(16 * dt + li) * 64 + 8 * lq), s1f = *(const bf16x8*)(s0t + (size_t)(16 * dt + li) * 64 + 32 + 8 * lq);
#pragma unroll
                    for (int ti = 0; ti < 2; ++ti) { const int tq = q0 + 16 * ti + li; const float sc = dir == 0 ? exp2f(lf2 * (float)(tq + 1)) : exp2f(lb2 * (float)(L - tq));
                        f32x4 a = {0.f, 0.f, 0.f, 0.f};
                        a = __builtin_amdgcn_mfma_f32_16x16x32_bf16(s0f, qf[ti][0], a, 0, 0, 0); a = __builtin_amdgcn_mfma_f32_16x16x32_bf16(s1f, qf[ti][1], a, 0, 0, 0);
                        S[ti].o[dt] = S[ti].o[dt] + a * sc; } }
            }
        }
        A.k = RQ + (size_t)tseq * 512 + 256 + h * 64; A.kstr = 512; A.vt = (const bf16*)(F.ws + WS_RVT) + (ctx ? (size_t)0 : (size_t)TC * 256) + ((size_t)b * 4 + h) * 64 * L; A.vld = L; A.nst = L / 128;
        at_stream<1>(F, qf, A, B, S, q0 + li, lf2, lb2);
        if (nx && F.tid == 0) *nx = atomicAdd(qctr, 1u);
        const float* gn = F.P->in[20] + l * 64;
#pragma unroll
        for (int ti = 0; ti < 2; ++ti) {
            float ss = 0.f;
#pragma unroll
            for (int dt = 0; dt < 4; ++dt) ss += (S[ti].o[dt].x * S[ti].o[dt].x + S[ti].o[dt].y * S[ti].o[dt].y) + (S[ti].o[dt].z * S[ti].o[dt].z + S[ti].o[dt].w * S[ti].o[dt].w);
            ss += shx(ss, 16, lane); ss += shx(ss, 32, lane);
            const float rstd = 1.0f / sqrtf(ss * (1.0f / 64.0f) + EPS);
            bf16* zrow = (bf16*)(F.ws + WS_BR) + (size_t)(tseq + q0 + 16 * ti + li) * 1024 + 512 + h * 64;
#pragma unroll
            for (int dt = 0; dt < 4; ++dt) { bf16* gp = zrow + 16 * dt + 4 * lq; const u32x2 g = *(const u32x2*)gp; const f32x4 gg = *(const f32x4*)(gn + 16 * dt + 4 * lq);
                u32x2 wv; wv.x = pk2(S[ti].o[dt].x * rstd * gg.x * bf2f(g.x & 0xffffu), S[ti].o[dt].y * rstd * gg.y * bf2f(g.x >> 16)); wv.y = pk2(S[ti].o[dt].z * rstd * gg.z * bf2f(g.y & 0xffffu), S[ti].o[dt].w * rstd * gg.w * bf2f(g.y >> 16));
                if (DRY) *(volatile u32x2*)(F.lds + 143360 + lane * 8) = wv; else *(u32x2*)gp = wv; }
        }
    }
}

DEV void ret_state_group(Frame& F, int l, int grp) {
    int wv_ = F.wave;
#ifndef EMU
    asm volatile("" : "+s"(wv_));
#endif
    const int task = grp * 8 + wv_, lane = F.lane, li = lane & 15, lq = lane >> 4;
    const int b = task / 8, h = (task % 8) / 2, dir = task & 1;
    bf16* Kl = (bf16*)F.lds + (size_t)wv_ * (32 * 72);
    const bf16* kbase = (const bf16*)(F.ws + WS_RQKV) + (size_t)(b * SEQ) * 512 + 256 + h * 64;
    const bf16* vbase = (const bf16*)(F.ws + WS_RVT) + ((size_t)b * 4 + h) * 64 * SEQ;
    const float lg2 = ret_lg2(dir, h);
    f32x4 acc[4][4];
#pragma unroll
    for (int a = 0; a < 4; ++a)
#pragma unroll
        for (int c = 0; c < 4; ++c) acc[a][c] = (f32x4){0.f, 0.f, 0.f, 0.f};
    for (int ks = 0; ks < SEQ / 32; ++ks) {
        { const int rr = lane >> 1, hh = (lane & 1) * 32; const bf16* src = kbase + (size_t)(32 * ks + rr) * 512 + hh;
#pragma unroll
          for (int c = 0; c < 4; ++c) *(u32x4*)(Kl + rr * 72 + hh + 8 * c) = *(const u32x4*)(src + 8 * c); }
        WAVE_SYNC();
        float wt[8];
#pragma unroll
        for (int e = 0; e < 8; ++e) { const int t = 32 * ks + 8 * lq + e; wt[e] = exp2f(lg2 * (float)(dir == 0 ? SEQ - 1 - t : t)); }
        bf16x8 bfr[4];
#pragma unroll
        for (int kt = 0; kt < 4; ++kt) { float x[8];
#pragma unroll
            for (int e = 0; e < 8; ++e) x[e] = bf2f(Kl[(8 * lq + e) * 72 + 16 * kt + li]) * wt[e];
            u32x4 pu; pu.x = pk2(x[0], x[1]); pu.y = pk2(x[2], x[3]); pu.z = pk2(x[4], x[5]); pu.w = pk2(x[6], x[7]); bfr[kt] = __builtin_bit_cast(bf16x8, pu); }
#pragma unroll
        for (int vt = 0; vt < 4; ++vt) { const bf16x8 af = *(const bf16x8*)(vbase + (size_t)(16 * vt + li) * SEQ + 32 * ks + 8 * lq);
#pragma unroll
            for (int kt = 0; kt < 4; ++kt) acc[vt][kt] = __builtin_amdgcn_mfma_f32_16x16x32_bf16(af, bfr[kt], acc[vt][kt], 0, 0, 0); }
        WAVE_SYNC();
    }
    float* dst = F.out + O_SR + ((((size_t)b * DEPTH + l) * 2 + dir) * 4 + h) * 4096;
#pragma unroll
    for (int vt = 0; vt < 4; ++vt)
#pragma unroll
        for (int kt = 0; kt < 4; ++kt) NT_ST((f32x4*)(dst + (16 * kt + li) * 64 + 16 * vt + 4 * lq), acc[vt][kt]);
}

#ifdef EMU
DEV unsigned pk_u8_(float x, int byte, unsigned old) { float c = x < 0.f ? 0.f : (x > 255.f ? 255.f : x); const unsigned v = (unsigned)__builtin_lrintf(c); return (old & ~(0xffu << (8 * byte))) | (v << (8 * byte)); }
#else
#define pk_u8_(x, byte, old) __builtin_amdgcn_cvt_pk_u8_f32((x), (byte), (old))
#endif
struct EpiP6 {
    static constexpr bool PERM = true;
    unsigned char* G8; bf16* Pt; bf16* Mg; LAS unsigned char* xl;
    static constexpr int LSLOT = 10;
    DEV void operator()(const f32x4 (&acc)[2][2][4][2], const pg8::Unit& u, int wr, int wc, int fr, int fq) const {
        OPAQUE(fr); OPAQUE(fq);
        const bool gate = (u.kind & 1) == 0, first = u.kind == 1, lastb = u.kind == 7;
        const int tid = (wr * 4 + wc) * 64 + fq * 16 + fr;
        LAS u32x2* gl = (LAS u32x2*)(xl + tid * 8);
        unsigned char* gg8 = G8 + (size_t)(u.pm * 4 + u.pn) * 65536 + tid * 8;
        const size_t pbase = ((size_t)(u.pm * 4 + u.pn) * 16 * 512 + (size_t)tid) * 8;
        if (gate) {
#define SG255(x) (255.f * sigmoid_f(x))
#pragma unroll
            for (int it = 0; it < 8; ++it) {
#pragma unroll
                for (int bj = 0; bj < 2; ++bj) { const f32x4 v0 = acc[it >> 2][bj][it & 3][0], v1 = acc[it >> 2][bj][it & 3][1]; u32x2 w; w.x = 0u; w.y = 0u;
                    w.x = pk_u8_(SG255(v0.x), 0, w.x); w.x = pk_u8_(SG255(v0.y), 1, w.x); w.x = pk_u8_(SG255(v0.z), 2, w.x); w.x = pk_u8_(SG255(v0.w), 3, w.x);
                    w.y = pk_u8_(SG255(v1.x), 0, w.y); w.y = pk_u8_(SG255(v1.y), 1, w.y); w.y = pk_u8_(SG255(v1.z), 2, w.y); w.y = pk_u8_(SG255(v1.w), 3, w.y);
                    if (it * 2 + bj >= LSLOT) gl[(it * 2 + bj - LSLOT) * 512] = w; else *(u32x2*)(gg8 + (it * 2 + bj) * 4096) = w; }
                if (it & 1) CFENCE(); }
#undef SG255
            return; }
        if (first) merge<true, false>(acc, u, pbase, gg8, gl, wr, wc, fr, fq); else if (lastb) merge<false, true>(acc, u, pbase, gg8, gl, wr, wc, fr, fq); else merge<false, false>(acc, u, pbase, gg8, gl, wr, wc, fr, fq);
    }
    template <bool FIRST, bool LAST>
    DEV void merge(const f32x4 (&acc)[2][2][4][2], const pg8::Unit& u, size_t pbase, const unsigned char* gg8, LAS u32x2* gl, int wr, int wc, int fr, int fq) const {
        u32x2 g[3][2]; u32x4 o[3][2];
#define P6_LOAD(it_) do { _Pragma("unroll") for (int bj = 0; bj < 2; ++bj) { const int s_ = (7 - (it_)) * 2 + bj;     \
        if (s_ >= LSLOT) g[(it_) % 3][bj] = gl[(s_ - LSLOT) * 512]; else g[(it_) % 3][bj] = *(const u32x2*)(gg8 + s_ * 4096); \
        if (FIRST) o[(it_) % 3][bj] = (u32x4){0u, 0u, 0u, 0u}; else o[(it_) % 3][bj] = *(const u32x4*)(Pt + pbase + (size_t)s_ * 4096); } } while (0)
        P6_LOAD(0); P6_LOAD(1);
#pragma unroll
        for (int it = 0; it < 8; ++it) {
            if (it + 2 < 8) P6_LOAD(it + 2);
            CFENCE();
            if (FIRST) { if (it == 0) PG8_WAIT_V(0); else if (it == 1) PG8_WAIT_V(2); else if (it < 6) PG8_WAIT_V(4); else if (it == 6) PG8_WAIT_V(2); else PG8_WAIT_V(0); }
            else { if (it == 0) PG8_WAIT_V(4); else if (it == 1) PG8_WAIT_V(6); else if (it < 6) PG8_WAIT_V(8); else if (it == 6) PG8_WAIT_V(4); else PG8_WAIT_V(0); }
            const int jt = 7 - it;
            const size_t off = (size_t)(u.pm * 256 + wr * 64 + fr + (jt >> 2) * 128 + (jt & 3) * 16) * D + u.pn * 256 + wc * 32 + 8 * fq;
            constexpr float fs = LAST ? (1.0f / 255.0f) : 1.0f;
#pragma unroll
            for (int bj = 0; bj < 2; ++bj) { const f32x4 v0 = acc[jt >> 2][bj][jt & 3][0], v1 = acc[jt >> 2][bj][jt & 3][1]; const u32x2 gg = g[it % 3][bj]; const u32x4 oo = o[it % 3][bj]; u32x4 w;
                const float g0 = (float)(gg.x & 0xffu), g1 = (float)((gg.x >> 8) & 0xffu), g2 = (float)((gg.x >> 16) & 0xffu), g3 = (float)(gg.x >> 24);
                const float g4 = (float)(gg.y & 0xffu), g5 = (float)((gg.y >> 8) & 0xffu), g6 = (float)((gg.y >> 16) & 0xffu), g7 = (float)(gg.y >> 24);
                w.x = pk2((bf2f(oo.x & 0xffffu) + g0 * v0.x) * fs, (bf2f(oo.x >> 16) + g1 * v0.y) * fs);
                w.y = pk2((bf2f(oo.y & 0xffffu) + g2 * v0.z) * fs, (bf2f(oo.y >> 16) + g3 * v0.w) * fs);
                w.z = pk2((bf2f(oo.z & 0xffffu) + g4 * v1.x) * fs, (bf2f(oo.z >> 16) + g5 * v1.y) * fs);
                w.w = pk2((bf2f(oo.w & 0xffffu) + g6 * v1.z) * fs, (bf2f(oo.w >> 16) + g7 * v1.w) * fs);
                if (LAST) *(u32x4*)(Mg + off + bj * 128) = w; else *(u32x4*)(Pt + pbase + (size_t)(jt * 2 + bj) * 4096) = w; }
            CFENCE(); }
#undef P6_LOAD
    }
};
struct EpiOut {
    static constexpr bool PERM = false;
    const float* x0; const float* x1; float* H; const float* modt; int l;
    DEV void operator()(const f32x4 (&acc)[2][2][4][2], const pg8::Unit& u, int wr, int wc, int fr, int fq) const {
        OPAQUE(fr); OPAQUE(fq);
        const int t0 = u.pm * 256; const float* gm = modt + (size_t)tok_cond(t0) * 3072 + 2048;
        const int col0 = u.pn * 256 + wc * 32 + 4 * fq;
        f32x4 gv[2][2];
#pragma unroll
        for (int bj = 0; bj < 2; ++bj)
#pragma unroll
            for (int n = 0; n < 2; ++n) gv[bj][n] = *(const f32x4*)(gm + col0 + bj * 128 + n * 16);
        const int tb = t0 + wr * 64 + fr;
        const float* sbase = (l == 0) ? (tb < TC ? x0 + (size_t)tb * D : x1 + (size_t)(tb - TC) * D) : H + (size_t)tb * D;
        f32x4 rs[3][2][2];
#define EO_LOAD(it_) do { const float* sp_ = sbase + (size_t)(((it_) >> 2) * 128 + ((it_) & 3) * 16) * D + col0; _Pragma("unroll") for (int bj = 0; bj < 2; ++bj) _Pragma("unroll") for (int n = 0; n < 2; ++n) \
        rs[(it_) % 3][bj][n] = *(const f32x4*)(sp_ + bj * 128 + n * 16); } while (0)
        EO_LOAD(0); EO_LOAD(1);
#pragma unroll
        for (int it = 0; it < 8; ++it) {
            if (it + 2 < 8) EO_LOAD(it + 2);
            CFENCE();
            if (it < 6) PG8_WAIT_V(8); else if (it == 6) PG8_WAIT_V(4); else PG8_WAIT_V(0);
            float* dst = H + (size_t)(tb + (it >> 2) * 128 + (it & 3) * 16) * D + col0;
#pragma unroll
            for (int bj = 0; bj < 2; ++bj)
#pragma unroll
                for (int n = 0; n < 2; ++n) *(f32x4*)(dst + bj * 128 + n * 16) = rs[it % 3][bj][n] + gv[bj][n] * acc[it >> 2][bj][it & 3][n];
            CFENCE(); }
#undef EO_LOAD
    }
};

DEV void pf_final(Frame& F) {
    const float* fg = F.P->in[24];
    const int gw = F.bx * 8 + F.wave, NGW = F.G * 8;
    if (F.G * 64 == T && (F.G & 7) == 0) {
        for (int i = 0; i < 2; ++i) {
            const int t0 = norm_row0(F, i);
            f32x4 v[4][4]; float s[4];
#pragma unroll
            for (int r = 0; r < 4; ++r)
#pragma unroll
                for (int j = 0; j < 4; ++j) v[r][j] = *(const f32x4*)(F.out + (size_t)(t0 + r) * D + 4 * F.lane + 256 * j);
#pragma unroll
            for (int r = 0; r < 4; ++r) { float a = 0.f;
#pragma unroll
                for (int j = 0; j < 4; ++j) a += (v[r][j].x * v[r][j].x + v[r][j].y * v[r][j].y) + (v[r][j].z * v[r][j].z + v[r][j].w * v[r][j].w);
                s[r] = 1.0f / sqrtf(wave_sum(a, F.lane) * (1.0f / D) + EPS); }
#pragma unroll
            for (int j = 0; j < 4; ++j) { const int c = 4 * F.lane + 256 * j; const f32x4 g = *(const f32x4*)(fg + c);
#pragma unroll
                for (int r = 0; r < 4; ++r) NT_ST((f32x4*)(F.out + (size_t)(t0 + r) * D + c), v[r][j] * s[r] * g); }
        }
        return;
    }
    for (int t = gw; t < T; t += NGW) {
        float* row = F.out + (size_t)t * D;
        f32x4 v[4]; float s = 0.f;
#pragma unroll
        for (int j = 0; j < 4; ++j) { v[j] = *(const f32x4*)(row + 4 * F.lane + 256 * j); s += (v[j].x * v[j].x + v[j].y * v[j].y) + (v[j].z * v[j].z + v[j].w * v[j].w); }
        const float rstd = 1.0f / sqrtf(wave_sum(s, F.lane) * (1.0f / D) + EPS);
#pragma unroll
        for (int j = 0; j < 4; ++j) { const int c = 4 * F.lane + 256 * j; *(f32x4*)(row + c) = v[j] * rstd * *(const f32x4*)(fg + c); }
    }
}

#ifdef EMU
#define DECL_LDS unsigned char* lds = emu::smem(); unsigned char* lds_las = lds;
#else
#define DECL_LDS extern __shared__ __attribute__((aligned(16))) unsigned char lds_raw[]; unsigned char* lds = lds_raw; LAS unsigned char* lds_las = (LAS unsigned char*)lds_raw;
#endif

#ifndef PH_LIMIT
#define PH_LIMIT 1000
#endif
#ifndef PH_MASK
#define PH_MASK 0xFFFF
#endif
#define PH_ON(k) ((PH_MASK >> (k)) & 1)

__global__ void __launch_bounds__(512, 2) fwd_kernel(Params prm) {
    DECL_LDS
    Frame F; F.lds = lds; F.ldsl = lds_las; F.ws = (GAS unsigned char*)prm.ws; F.out = (GAS float*)prm.out;
#ifdef EMU
    F.P = &prm;
#else
    F.P = (PP)__builtin_amdgcn_kernarg_segment_ptr();
#endif
    F.tid = threadIdx.x; F.lane = F.tid & 63; F.wave = __builtin_amdgcn_readfirstlane(F.tid >> 6); F.G = gridDim.x; F.bx = blockIdx.x;
    volatile LAS unsigned* misc = (volatile LAS unsigned*)(lds_las + LDS_MISC);
    if (F.tid < 64) misc[F.tid] = 0u;
    __syncthreads();
    XcdBarrier bar = xcd_barrier_post((unsigned*)(F.ws + WS_CTL), misc + 8); bar.wave = F.wave;
    int phase = 0;
#define GRID_BAR() do { xcd_barrier(bar); if (REP_BAR) xcd_barrier(bar); if (++phase >= PH_LIMIT) return; } while (0)
    LAS unsigned char* glds = lds_las;
#ifdef EMU
#define REFRESH() do { F.tid = threadIdx.x; F.lane = F.tid & 63; } while (0)
#else
#define REFRESH() do { F.lane = FRESH_LANE(); F.tid = F.wave * 64 + F.lane; PP kp_ = (PP)__builtin_amdgcn_kernarg_segment_ptr(); asm volatile("" : "+s"(kp_)); F.P = kp_; \
    GAS unsigned char* w_ = F.ws; asm volatile("" : "+s"(w_)); F.ws = w_; GAS float* o_ = F.out; asm volatile("" : "+s"(o_)); F.out = o_; } while (0)
#endif

    REFRESH(); if (PH_ON(0)) p0_prologue(F);
#if REP_P0
    REFRESH(); p0_prologue(F);
#endif
    GRID_BAR();
    for (int l = 0; l < DEPTH; ++l) {
        REFRESH(); if (PH_ON(1)) { if (l > 0) convert_weights(F, l);
        p1_norm(F, l); if (REP_P1) p1_norm(F, l); }
        GRID_BAR();
        for (int rep = 0; rep <= REP_P2; ++rep) { REFRESH(); if (PH_ON(2)) { pg8::Gemm g{(const bf16*)(F.ws + WS_HN), (const bf16*)(F.ws + WS_WIN), T, NIN, D}; pg8::StaticOrder S; S.init(T, NIN, F.G, F.bx);
          EpiIn E{F.ws, F.out, F.P->in[18] + l * 64, F.P->in[19] + l * 64, F.P->in[15] + l * 8, F.P->in[16] + l * 8, l};
          pg8::gemm_phase<EpiIn, pg8::StaticOrder, true, true>(glds, g, S, E, F.wave); } }
        GRID_BAR();
        REFRESH(); if (PH_ON(3)) { GdnPre pre, nxt; int k = F.bx; if (k < N_GDN_TASKS) { gdn_dma(F, l, k); gdn_prefetch<false>(F, l, k, pre); }
            for (; k < N_GDN_TASKS; k += F.G) { { int t_ = F.lane; OPAQUE(t_); F.lane = t_; F.tid = F.wave * 64 + t_; }
                gdn_a_task(F, l, k, pre, k + F.G < N_GDN_TASKS ? k + F.G : k, nxt); pre = nxt; }
            PG8_WAIT_V(0); }
        GRID_BAR();
        REFRESH();
        if (PH_ON(4)) { unsigned* qctr = (unsigned*)(F.ws + WS_CTL) + 4096 + 64 * l; unsigned nx_ = 0u; bool have = false;
          for (;;) {
            __syncthreads();
            if (F.tid == 0) misc[16] = have ? nx_ : atomicAdd(qctr, 1u);
            __syncthreads();
            int u = __builtin_amdgcn_readfirstlane((int)misc[16]);
            have = false;
            { int t_ = F.lane; OPAQUE(t_); F.lane = t_; F.tid = F.wave * 64 + t_; }
            constexpr int NB_S = DB * 4, NA_S = 3 * DB * 16, NB_C = NB * 4, NA_C = 3 * NB * 4;
            if (u < NB_S) { gdn_b_wave(F, l, u * 8 + F.wave); continue; }
            u -= NB_S;
            if (u < NA_S) { at_unit(F, l, u, qctr, &nx_); have = true; continue; }
            u -= NA_S;
            if (u < NB) { ret_state_group(F, l, u); continue; }
            u -= NB;
            if (u < NB_C) { gdn_b_wave(F, l, (NB_S + u) * 8 + F.wave); continue; }
            u -= NB_C;
            if (u < NA_C) { at_unit(F, l, NA_S + u, qctr, &nx_); have = true; continue; }
            break;
          } }
        GRID_BAR();
        REFRESH(); if (PH_ON(6)) { GdnPre pre, nxt; int k = F.bx; if (k < N_GDN_TASKS) { gdn_dma(F, l, k); gdn_prefetch<true>(F, l, k, pre); }
            for (; k < N_GDN_TASKS; k += F.G) { { int t_ = F.lane; OPAQUE(t_); F.lane = t_; F.tid = F.wave * 64 + t_; }
                gdn_c_task(F, l, k, pre, k + F.G < N_GDN_TASKS ? k + F.G : k, nxt); pre = nxt; }
            PG8_WAIT_V(0); }
        GRID_BAR();
        REFRESH(); if (PH_ON(7)) {
            pg8::Gemm g{nullptr, nullptr, T, D, D};
            pg8::P6Order S{(const char*)(F.ws + WS_HN), (const char*)(F.ws + WS_WIN) + (size_t)NIN * D * 2, (const char*)(F.ws + WS_BR), (const char*)(F.ws + WS_WBR), (T / 256) * 4, F.G, F.bx};
            EpiP6 E{F.ws + WS_GATE, (bf16*)(F.ws + WS_MB), (bf16*)(F.ws + WS_MERGED), lds_las + 131072};
            pg8::gemm_phase<EpiP6, pg8::P6Order, true, true>(glds, g, S, E, F.wave); }
        GRID_BAR();
        REFRESH(); if (PH_ON(8)) { pg8::Gemm g{(const bf16*)(F.ws + WS_MERGED), (const bf16*)(F.ws + WS_WOUT), T, D, D}; pg8::StaticOrder S; S.init(T, D, F.G, F.bx);
          EpiOut E{F.P->in[0], F.P->in[1], F.out, (const float*)(F.ws + WS_MODT) + (size_t)l * NCOND * 3072, l};
          pg8::gemm_phase<EpiOut, pg8::StaticOrder, true, true>(glds, g, S, E, F.wave);
          if (REP_P7 && l == 0) pg8::gemm_phase<EpiOut, pg8::StaticOrder, true, true>(glds, g, S, E, F.wave); }
        GRID_BAR();
    }
    REFRESH(); if (PH_ON(9)) pf_final(F);
}

extern "C" void kernel_launch(void* const* d_in, const int* in_sizes, int n_in, void* d_out, int out_size, void* d_ws, size_t ws_size, hipStream_t stream) {
    static int grid = 0;
    if (grid == 0) {
        if (n_in != 25 || (size_t)out_size != O_END || ws_size < WS_END2) { fprintf(stderr, "kernel_launch: unexpected shapes (n_in %d out %d ws %zu)\n", n_in, out_size, ws_size); grid = -1; return; }
        int dev = 0, cus = 0;
        if (hipGetDevice(&dev) != hipSuccess || hipDeviceGetAttribute(&cus, hipDeviceAttributeMultiprocessorCount, dev) != hipSuccess) { grid = -1; return; }
        if (hipFuncSetAttribute((const void*)fwd_kernel, hipFuncAttributeMaxDynamicSharedMemorySize, LDS_BYTES) != hipSuccess) { fprintf(stderr, "kernel_launch: hipFuncSetAttribute failed\n"); grid = -1; return; }
        (void)hipGetLastError();
        grid = cus;
    }
    if (grid < 0) return;
    (void)hipMemsetAsync((char*)d_ws + WS_CTL, 0, CTL_BYTES, stream);
    Params p{};
    for (int i = 0; i < 25; ++i) p.in[i] = (const float*)d_in[i];
    p.out = (float*)d_out; p.ws = (unsigned char*)d_ws;
    hipLaunchKernelGGL(fwd_kernel, dim3(grid), dim3(512), LDS_BYTES, stream, p);
}

#ifdef EMU
size_t emu_out_size() { return O_END; }
size_t emu_ws_size() { return (size_t)256 * 1024 * 1024; }
size_t emu_ws_used() { return WS_END2; }
#endif
```

```cpp
#include <hip/hip_runtime.h>
#include <cstdio>
#include <cstdint>

#define REP_BAR 0
#define REP_P0 0
#define REP_P7 0
#define REP_P1 0
#define REP_GDNA 0
#define REP_P2 0
#define REP_P6 0
#define REP_P4 0
#define REP_GDNC 0
#define REP_ATTN 0
#define REP_GEMM 0
#ifndef CFG_NB
#define CFG_NB 32
#endif
#ifndef CFG_DB
#define CFG_DB 8
#endif

#ifdef EMU
#define LAS
#define GAS
#define ASMV(x)
#else
#define LAS __attribute__((address_space(3)))
#if defined(__HIP_DEVICE_COMPILE__)
#define GAS __attribute__((address_space(1)))
#else
#define GAS
#endif
#define ASMV(x) asm volatile(x ::: "memory")
#endif
#define DEV __device__ __forceinline__
#ifdef EMU
#define CFENCE()
#else
#define CFENCE() asm volatile("" ::: "memory")
#endif
#ifdef EMU
#define OPAQUE(x)
#else
#define OPAQUE(x) asm volatile("" : "+v"(x))
#endif
#ifdef EMU
#define FRESH_LANE() ((int)(threadIdx.x & 63))
#else
DEV int fresh_lane_() { unsigned z = 0; asm volatile("" : "+v"(z)); return (int)__builtin_amdgcn_mbcnt_hi(~0u, __builtin_amdgcn_mbcnt_lo(~0u, z)); }
#define FRESH_LANE() fresh_lane_()
#endif
#ifdef EMU
#define WAVE_SYNC() emu::wave_sync()
#else
#define WAVE_SYNC() __builtin_amdgcn_wave_barrier()
#endif

typedef unsigned short bf16;
typedef short bf16x8 __attribute__((ext_vector_type(8)));
typedef float f32x4 __attribute__((ext_vector_type(4)));
typedef float f32x2 __attribute__((ext_vector_type(2)));
typedef unsigned u32x4 __attribute__((ext_vector_type(4)));
typedef unsigned u32x2 __attribute__((ext_vector_type(2)));

constexpr int D = 1024, DEPTH = 2, HD = 64, NB = CFG_NB, SEQ = 256, DB = CFG_DB, DSEQ = 1024, PAST = 512;
constexpr int TC = NB * SEQ, TS = DB * DSEQ, T = TC + TS, NCOND = 1 + DB, NSEQ = NB + DB;
constexpr int INW = 7952, NPERM = 8192, NIN = 4096;
constexpr float EPS = 1e-6f;
static_assert(T % 256 == 0 && TC % 256 == 0, "token tiles");

constexpr size_t O_Y = 0;
constexpr size_t O_AK = (size_t)T * D;
constexpr size_t O_AV = O_AK + (size_t)NB * DEPTH * SEQ * 128;
constexpr size_t O_NK = O_AV + (size_t)NB * DEPTH * SEQ * 128;
constexpr size_t O_NV = O_NK + (size_t)NB * DEPTH * SEQ * 256;
constexpr size_t O_SG = O_NV + (size_t)NB * DEPTH * SEQ * 256;
constexpr size_t O_SR = O_SG + (size_t)NB * DEPTH * 2 * 4 * 4096;
constexpr size_t O_END = O_SR + (size_t)NB * DEPTH * 2 * 4 * 4096;

constexpr size_t al256(size_t x) { return (x + 255) & ~(size_t)255; }
constexpr size_t WS_CTL = 0, CTL_BYTES = 65536;
constexpr size_t WS_MODT = WS_CTL + CTL_BYTES;
constexpr size_t WS_ROPE = al256(WS_MODT + (size_t)DEPTH * NCOND * 3072 * 4);
constexpr size_t WS_WIN = al256(WS_ROPE + 2 * 64 * 16 * 4);
constexpr size_t WS_WBR = WS_WIN + (size_t)NPERM * D * 2;
constexpr size_t WS_WOUT = WS_WBR + (size_t)4 * D * 256 * 2;
constexpr size_t WS_KAC = WS_WOUT + (size_t)D * D * 2;
constexpr size_t WS_VACT = WS_KAC + (size_t)DEPTH * DB * 2 * PAST * 64 * 2;
constexpr size_t WS_NKC = WS_VACT + (size_t)DEPTH * DB * 2 * PAST * 64 * 2;
constexpr size_t WS_NVCT = WS_NKC + (size_t)DEPTH * DB * 4 * PAST * 64 * 2;
constexpr size_t WS_HN = WS_NVCT + (size_t)DEPTH * DB * 4 * PAST * 64 * 2;
constexpr size_t WS_QA = WS_HN + (size_t)T * D * 2;
constexpr size_t WS_GQKV = WS_QA + (size_t)T * 256 * 2;
constexpr size_t WS_RQKV = WS_GQKV + (size_t)T * 768 * 2;
constexpr size_t WS_NQ = WS_RQKV + (size_t)T * 512 * 2;
constexpr size_t WS_KA = WS_NQ + (size_t)T * 256 * 2;
constexpr size_t WS_VAT = WS_KA + (size_t)T * 128 * 2;
constexpr size_t WS_NK = WS_VAT + (size_t)T * 128 * 2;
constexpr size_t WS_NVT = WS_NK + (size_t)T * 256 * 2;
constexpr size_t WS_AZ = WS_NVT + (size_t)T * 256 * 2;
constexpr size_t WS_BR = WS_AZ;
constexpr size_t WS_GAB = WS_AZ + (size_t)T * 1024 * 2;
constexpr size_t WS_MB = WS_GAB + (size_t)T * 16 * 4;
constexpr size_t WS_BS = WS_MB + (size_t)(T / 64) * 8 * 4096 * 4;
constexpr size_t WS_O = WS_BS;
constexpr size_t WS_RVT = WS_BS + (size_t)(T / 64) * 8 * 4096 * 4;
constexpr size_t WS_S0T = WS_RVT + (size_t)T * 256 * 2;
constexpr size_t WS_END = WS_S0T + (size_t)2 * DEPTH * DB * 8 * 4096 * 2;
constexpr size_t WS_MERGED = WS_QA, WS_GATE = WS_RQKV;
constexpr size_t TF_SLOT = 6144, TF_NA = ((size_t)NIN * D * 2) / TF_SLOT, TF_N = (size_t)(T / 64) * 4 * 2;
constexpr size_t WS_TFB = WS_END, WS_END2 = WS_TFB + (TF_N > TF_NA ? (TF_N - TF_NA) * TF_SLOT : 0);
static_assert(WS_END2 <= (size_t)256 * 1024 * 1024, "d_ws map exceeds 256 MiB");
static_assert(WS_GATE + (size_t)T * D * 2 <= WS_NK && WS_MERGED + (size_t)T * D * 2 <= WS_RQKV, "overlays");

constexpr int LDS_BYTES = 163840;
constexpr int LDS_MISC = 162816;

struct Params { const float* in[25]; float* out; unsigned char* ws; };
#ifdef EMU
typedef const Params* PP;
#else
typedef const __attribute__((address_space(4))) Params* PP;
#endif

DEV unsigned f2bf(float f) { unsigned u = __builtin_bit_cast(unsigned, f); return (u + 0x7fffu + ((u >> 16) & 1u)) >> 16; }
DEV float bf2f(unsigned h) { return __builtin_bit_cast(float, h << 16); }
DEV unsigned pk2(float lo, float hi) {
#ifdef EMU
    return f2bf(lo) | (f2bf(hi) << 16);
#else
    typedef __bf16 bfx2_ __attribute__((ext_vector_type(2))); typedef float flx2_ __attribute__((ext_vector_type(2)));
    const flx2_ v_ = {lo, hi}; return __builtin_bit_cast(unsigned, __builtin_convertvector(v_, bfx2_));
#endif
}
#ifdef EMU
#define NT_ST(p, v) (*(p) = (v))
#define NT_LD(p) (*(p))
#else
#define NT_ST(p, v) __builtin_nontemporal_store((v), (p))
#define NT_LD(p) __builtin_nontemporal_load(p)
#endif
DEV float sigmoid_f(float x) { return __builtin_amdgcn_rcpf(1.f + __builtin_amdgcn_exp2f(-1.4426950408889634f * x)); }
DEV float silu_f(float x) { return x * sigmoid_f(x); }
DEV float softplus_f(float x) { return fmaxf(x, 0.f) + __logf(1.0f + __expf(-fabsf(x))); }
#ifdef EMU
DEV float shx(float v, int mask, int lane) { return __shfl_xor(v, mask); }
DEV float shf(float v, int src) { return __shfl(v, src); }
#else
DEV float shx(float v, int mask, int lane) { return __builtin_bit_cast(float, __builtin_amdgcn_ds_bpermute((lane ^ mask) << 2, __builtin_bit_cast(int, v))); }
DEV float shf(float v, int src) { return __builtin_bit_cast(float, __builtin_amdgcn_ds_bpermute(src << 2, __builtin_bit_cast(int, v))); }
#endif
DEV float wave_sum(float v, int lane) {
#pragma unroll
    for (int o = 1; o < 64; o <<= 1) v += shx(v, o, lane);
    return v;
}

#ifdef EMU
struct XcdBarrier { unsigned* bar; int wave; };
DEV XcdBarrier xcd_barrier_post(unsigned* bar, volatile unsigned* st) { XcdBarrier b; b.bar = bar; return b; }
DEV void xcd_barrier(const XcdBarrier& b) {
    __syncthreads();
    if (threadIdx.x == 0) { const unsigned G = gridDim.x; const unsigned old = __atomic_fetch_add(&b.bar[0], 1u, __ATOMIC_SEQ_CST); const unsigned gen = old / G;
        while (__atomic_load_n(&b.bar[0], __ATOMIC_SEQ_CST) < (gen + 1u) * G) emu::yield(); }
    __syncthreads();
}
#else
#define XB_TMO      128
#define XB_XCNT(j)  (256  + 64 * (j))
#define XB_XSUB(j)  (1280 + 64 * (j))
#define XB_XGEN(j)  (2304 + 64 * (j))
#define XB_TOP      3328
#define XB_TOPGEN   3392
#define XCD_BAR_WORDS 3456
#define XB_SPIN_CAP (1u << 18)
__device__ __forceinline__ unsigned xb_ld(unsigned* p)              { return __hip_atomic_load(p, __ATOMIC_RELAXED, __HIP_MEMORY_SCOPE_AGENT); }
__device__ __forceinline__ unsigned xb_add(unsigned* p, unsigned v) { return __hip_atomic_fetch_add(p, v, __ATOMIC_RELAXED, __HIP_MEMORY_SCOPE_AGENT); }
__device__ __forceinline__ unsigned xb_xcc_id() { return (unsigned)__builtin_amdgcn_s_getreg((3 << 11) | 20) & 0xFu; }
#define XB_SPIN(cond, bar) do { unsigned _sp = 0; while (cond) { __builtin_amdgcn_s_sleep(1); \
    if ((++_sp & 255u) == 0u) { if (xb_ld(&(bar)[XB_TMO])) break; if (_sp > XB_SPIN_CAP) { atomicAdd(&(bar)[XB_TMO], 1u); break; } } } } while (0)
struct XcdBarrier { unsigned* bar; unsigned x; volatile LAS unsigned* st; int wave; };
__device__ __forceinline__ XcdBarrier xcd_barrier_post(unsigned* bar, volatile LAS unsigned* st) {
    XcdBarrier b; b.bar = bar; b.x = xb_xcc_id(); b.st = st;
    if (threadIdx.x == 0) (void)xb_add(&bar[XB_XCNT(b.x)], 1u);
    return b;
}
__device__ __forceinline__ void xcd_barrier_complete(unsigned* bar, unsigned x, unsigned& nloc, unsigned& nx) {
    const unsigned G = gridDim.x * gridDim.y * gridDim.z;
    unsigned sum, cnt, mine, sp = 0u;
    for (;;) {
        sum = 0u; cnt = 0u; mine = 0u;
#pragma unroll
        for (unsigned j = 0; j < 16; ++j) { const unsigned c = xb_ld(&bar[XB_XCNT(j)]); sum += c; cnt += (c > 0u) ? 1u : 0u; mine = (j == x) ? c : mine; }
        if (sum == G) break;
        __builtin_amdgcn_s_sleep(1);
        if ((++sp & 255u) == 0u) { if (xb_ld(&bar[XB_TMO])) break; if (sp > XB_SPIN_CAP) { atomicAdd(&bar[XB_TMO], 1u); break; } }
    }
    nloc = mine > 0u ? mine : 1u; nx = cnt > 0u ? cnt : 1u;
}
__device__ __forceinline__ void xcd_barrier(const XcdBarrier& b) {
    asm volatile("s_waitcnt vmcnt(0)" ::: "memory");
    __syncthreads();
    const int tb_ = b.wave * 64 + FRESH_LANE();
    if (tb_ == 0) {
        unsigned* bar = b.bar; asm volatile("" : "+s"(bar));
        unsigned bx_ = xb_xcc_id(); asm volatile("" : "+s"(bx_));
        __builtin_amdgcn_s_waitcnt(0);
        unsigned nloc = b.st[0], nx = b.st[1];
        if (nloc == 0u) { xcd_barrier_complete(bar, bx_, nloc, nx); b.st[0] = nloc; b.st[1] = nx; }
        const unsigned old = xb_add(&bar[XB_XSUB(bx_)], 1u);
        const unsigned gen = old / nloc;
        if (old + 1u == (gen + 1u) * nloc) {
            __builtin_amdgcn_fence(__ATOMIC_RELEASE, "agent");
            asm volatile("s_waitcnt vmcnt(0)" ::: "memory");
            const unsigned og = xb_add(&bar[XB_TOP], 1u);
            const unsigned tg = og / nx;
            if (og + 1u == (tg + 1u) * nx) xb_add(&bar[XB_TOPGEN], 1u);
            else XB_SPIN(xb_ld(&bar[XB_TOPGEN]) == tg, bar);
            __builtin_amdgcn_fence(__ATOMIC_ACQUIRE, "agent");
            xb_add(&bar[XB_XGEN(bx_)], 1u);
            asm volatile("s_waitcnt vmcnt(0)" ::: "memory");
        } else {
            XB_SPIN(xb_ld(&bar[XB_XGEN(bx_)]) == gen, bar);
            __builtin_amdgcn_fence(__ATOMIC_ACQUIRE, "agent");
            asm volatile("s_waitcnt vmcnt(0)" ::: "memory");
        }
    }
    __syncthreads();
}
#endif

namespace pg8 {
#define PG8_LAS LAS
constexpr int BM = 256, BK = 64, HALF = 128, HTB = HALF * BK * 2, STAGE_BYTES = 8 * HTB, NXCD = 8, WGM = 8;
__host__ __device__ __forceinline__ int lds_byte(int r, int c) { const int st = (r >> 4) * 2 + (c >> 5), rr = r & 15, cc = c & 31, ob = rr * 64 + cc * 2; return st * 1024 + (ob ^ (((ob >> 9) & 1) << 5)); }
__host__ __device__ __forceinline__ void stage_rc(int b, int& R, int& C) { const int st = b / 1024, sb = b % 1024, swz = sb ^ (((sb >> 9) & 1) << 5); R = (st >> 1) * 16 + swz / 64; C = (st & 1) * 32 + (swz % 64) / 2; }
__host__ __device__ __forceinline__ int perm32(int rho) { const int n = rho >> 4, i = rho & 15; return 8 * (i >> 2) + 4 * n + (i & 3); }
struct Unit { int pm, pn; const char* a; const char* b; int nt, kind; };
struct Gemm { const bf16* A; const bf16* Bt; int M, N, K; };
struct StaticOrder {
    int nM, nN, nwg, G, c;
    __host__ __device__ void init(int M, int N, int G_, int c_) { nM = M / BM; nN = N / BM; nwg = nM * nN; G = G_; c = c_; }
    __host__ __device__ bool next(int i, Unit& u, const Gemm& g) const {
        const long L = (long)i * G + c; if (L >= nwg) return false;
        int wgid = (int)L; { const int q = nwg / NXCD, r = nwg % NXCD, xcd = wgid % NXCD, off = wgid / NXCD; wgid = (xcd < r ? xcd * (q + 1) : r * (q + 1) + (xcd - r) * q) + off; }
        const int nig = WGM * nN, gid = wgid / nig, fm = gid * WGM, gsz = (nM - fm) < WGM ? (nM - fm) : WGM;
        u.pm = fm + ((wgid % nig) % gsz); u.pn = (wgid % nig) / gsz;
        u.a = (const char*)g.A + (size_t)u.pm * 256 * g.K * 2; u.b = (const char*)g.Bt + (size_t)u.pn * 256 * g.K * 2; u.nt = g.K / 64; u.kind = 0; return true;
    }
    __device__ __forceinline__ void a_ready(const Unit&) const {}
    __device__ __forceinline__ void done(const Unit&) const {}
};
struct P6Order {
    const char* hn; const char* wmg; const char* br; const char* wbr; int ntiles, G, c;
    __device__ __forceinline__ bool next(int i, Unit& u, const Gemm&) const {
        int tile = c + (i >> 3) * G; if (tile >= ntiles) return false;
        if (G == 256 && ntiles == 256) { const int xcd = c & 7, idx = c >> 3; tile = (xcd * 8 + (idx >> 2)) * 4 + (idx & 3); }
        const int sub = i & 7, n = sub >> 1; u.pm = tile >> 2; u.pn = tile & 3; u.kind = sub;
        if ((sub & 1) == 0) { u.a = hn + (size_t)u.pm * 256 * 2048; u.b = wmg + ((size_t)n * 1024 + u.pn * 256) * 2048; u.nt = 16; }
        else { u.a = br + (size_t)u.pm * 256 * 2048 + n * 512; u.b = wbr + (size_t)u.pn * 256 * 2048 + n * 512; u.nt = 4; }
        return true;
    }
    __device__ __forceinline__ void a_ready(const Unit&) const {}
    __device__ __forceinline__ void done(const Unit&) const {}
};
#ifdef EMU
#define PG8_WAIT_V(n)
#define PG8_WAIT_L(n)
#else
#define PG8_WAIT_V(n) asm volatile("s_waitcnt vmcnt(" #n ")" ::: "memory")
#define PG8_WAIT_L(n) asm volatile("s_waitcnt lgkmcnt(" #n ")" ::: "memory")
#endif
template <class Epi, class Sched, bool ALIGN_EPI = false, bool SP2 = false>
__device__ __forceinline__ void gemm_phase(PG8_LAS unsigned char* lds, const Gemm g, const Sched& S, const Epi& E, const int wid) {
    const int lane = FRESH_LANE(), tid = wid * 64 + lane, wr = wid >> 2, wc = wid & 3, fr = lane & 15, fq = lane >> 4;
    const int K = g.K;
    unsigned voffA[2], voffB[2];
#pragma unroll
    for (int i = 0; i < 2; ++i) { int R, C; stage_rc(tid * 16 + i * 8192, R, C); const int Rb = Epi::PERM ? ((R & ~31) + perm32(R & 31)) : R;
        voffA[i] = (unsigned)(R * K + C) * 2u; voffB[i] = (unsigned)(Rb * K + C) * 2u; }
    const size_t kstep = (size_t)(BK * 2);
    const size_t hstep = (size_t)HALF * K * 2;
    const unsigned ldsw = (unsigned)wid * 1024u;
    const int aoff = lds_byte(wr * 64 + fr, fq * 8), boff = lds_byte(wc * 32 + fr, fq * 8);
#define PG8_SA(b, h) (((b) * 2 + (h)) * HTB)
#define PG8_SB(b, h) ((4 + (b) * 2 + (h)) * HTB)
#define PG8_STAGE(bufoff, gbase, voff) do { _Pragma("unroll") for (int _i = 0; _i < 2; ++_i) \
        __builtin_amdgcn_global_load_lds((const unsigned*)((const char*)(gbase) + (voff)[_i]), (PG8_LAS unsigned*)(lds + (bufoff) + ldsw + _i * 8192), 16, 0, 0); } while (0)
#define PG8_LDA(dst, b, h) do { _Pragma("unroll") for (int m = 0; m < 4; ++m) _Pragma("unroll") for (int k = 0; k < 2; ++k) dst[m][k] = *(const PG8_LAS bf16x8*)(lds + PG8_SA(b, h) + aoff + m * 2048 + k * 1024); } while (0)
#define PG8_LDB(dst, b, h) do { _Pragma("unroll") for (int n = 0; n < 2; ++n) _Pragma("unroll") for (int k = 0; k < 2; ++k) dst[n][k] = *(const PG8_LAS bf16x8*)(lds + PG8_SB(b, h) + boff + n * 2048 + k * 1024); } while (0)
#define PG8_MMA(ai, bj, At, Bt) do { __builtin_amdgcn_s_setprio(1); _Pragma("unroll") for (int m = 0; m < 4; ++m) _Pragma("unroll") for (int n = 0; n < 2; ++n) _Pragma("unroll") for (int k = 0; k < 2; ++k) \
        acc[ai][bj][m][n] = __builtin_amdgcn_mfma_f32_16x16x32_bf16(Bt[n][k], At[m][k], acc[ai][bj][m][n], 0, 0, 0); __builtin_amdgcn_s_setprio(0); } while (0)
#define PG8_BAR __builtin_amdgcn_s_barrier()
#define PG8_SCHED __builtin_amdgcn_sched_barrier(0)
    Unit cur, nxt; int ui = 0;
    if (!S.next(0, cur, g)) return;
    f32x4 acc[2][2][4][2];
#pragma unroll
    for (int a = 0; a < 2; ++a)
#pragma unroll
        for (int b = 0; b < 2; ++b)
#pragma unroll
            for (int m = 0; m < 4; ++m)
#pragma unroll
                for (int n = 0; n < 2; ++n) acc[a][b][m][n] = (f32x4){0.f, 0.f, 0.f, 0.f};
    bf16x8 At[4][2], B0[2][2], B1[2][2];
    const char* cA = cur.a; const char* cB = cur.b;
    S.a_ready(cur);
    if constexpr (SP2) {
        PG8_STAGE(PG8_SB(0, 0), cB, voffB); PG8_STAGE(PG8_SB(0, 1), cB + hstep, voffB); PG8_STAGE(PG8_SA(0, 0), cA, voffA); PG8_STAGE(PG8_SA(0, 1), cA + hstep, voffA);
        if (wr == 1) PG8_BAR;
        PG8_WAIT_V(2); PG8_BAR;
        PG8_STAGE(PG8_SB(1, 0), cB + kstep, voffB); PG8_STAGE(PG8_SA(1, 0), cA + kstep, voffA); PG8_STAGE(PG8_SB(1, 1), cB + hstep + kstep, voffB);
        PG8_WAIT_V(6); PG8_BAR;
    } else {
        PG8_STAGE(PG8_SB(0, 0), cB, voffB); PG8_STAGE(PG8_SA(0, 0), cA, voffA); PG8_STAGE(PG8_SB(0, 1), cB + hstep, voffB); PG8_STAGE(PG8_SA(0, 1), cA + hstep, voffA);
        if (wr == 1) PG8_BAR;
        PG8_WAIT_V(4); PG8_BAR;
        PG8_STAGE(PG8_SB(1, 0), cB + kstep, voffB); PG8_STAGE(PG8_SA(1, 0), cA + kstep, voffA); PG8_STAGE(PG8_SB(1, 1), cB + hstep + kstep, voffB);
        PG8_WAIT_V(6); PG8_BAR;
    }
    for (;;) {
        const bool has_next = S.next(ui + 1, nxt, g);
        const char* nA = has_next ? nxt.a : cA; const char* nB = has_next ? nxt.b : cB;
        const int nt = cur.nt;
        for (int t = 0; t < nt; t += 2) {
            const bool last = (t == nt - 2);
            const char* a1 = cA + (size_t)(t + 1) * kstep;
            const char* a2 = last ? nA : cA + (size_t)(t + 2) * kstep; const char* b2 = last ? nB : cB + (size_t)(t + 2) * kstep;
            const char* a3 = a2 + kstep; const char* b3 = b2 + kstep;
            if (last && has_next) S.a_ready(nxt);
            if constexpr (SP2) {
            PG8_LDB(B0, 0, 0); PG8_LDB(B1, 0, 1); PG8_SCHED; PG8_LDA(At, 0, 0); PG8_STAGE(PG8_SA(1, 1), a1 + hstep, voffA);
            PG8_WAIT_V(8); PG8_WAIT_L(0); PG8_BAR; PG8_MMA(0, 0, At, B0); PG8_MMA(0, 1, At, B1); PG8_BAR; PG8_SCHED;
            PG8_LDA(At, 0, 1); PG8_STAGE(PG8_SB(0, 0), b2, voffB); PG8_STAGE(PG8_SB(0, 1), b2 + hstep, voffB); PG8_STAGE(PG8_SA(0, 0), a2, voffA);
            PG8_WAIT_V(8); PG8_WAIT_L(0); PG8_BAR; PG8_MMA(1, 0, At, B0); PG8_MMA(1, 1, At, B1); PG8_BAR; PG8_SCHED;
            PG8_LDB(B0, 1, 0); PG8_LDB(B1, 1, 1); PG8_SCHED; PG8_LDA(At, 1, 0); PG8_STAGE(PG8_SA(0, 1), a2 + hstep, voffA);
            PG8_WAIT_V(8); PG8_WAIT_L(0); PG8_BAR; PG8_MMA(0, 0, At, B0); PG8_MMA(0, 1, At, B1); PG8_BAR; PG8_SCHED;
            PG8_LDA(At, 1, 1); PG8_STAGE(PG8_SB(1, 0), b3, voffB); PG8_STAGE(PG8_SB(1, 1), b3 + hstep, voffB); PG8_STAGE(PG8_SA(1, 0), a3, voffA);
            PG8_WAIT_V(8); PG8_WAIT_L(0); PG8_BAR; PG8_MMA(1, 0, At, B0); PG8_MMA(1, 1, At, B1); PG8_BAR; PG8_SCHED;
            } else {
            PG8_LDB(B0, 0, 0); PG8_SCHED; PG8_LDA(At, 0, 0); PG8_STAGE(PG8_SA(1, 1), a1 + hstep, voffA);
            PG8_WAIT_L(8); PG8_BAR; PG8_WAIT_L(0); PG8_MMA(0, 0, At, B0); PG8_BAR; PG8_SCHED;
            PG8_LDB(B1, 0, 1); PG8_STAGE(PG8_SB(0, 0), b2, voffB);
            PG8_BAR; PG8_WAIT_L(0); PG8_MMA(0, 1, At, B1); PG8_BAR;
            PG8_LDA(At, 0, 1); PG8_STAGE(PG8_SA(0, 0), a2, voffA);
            PG8_BAR; PG8_WAIT_L(0); PG8_MMA(1, 0, At, B0); PG8_BAR; PG8_SCHED;
            PG8_STAGE(PG8_SB(0, 1), b2 + hstep, voffB);
            PG8_WAIT_V(6); PG8_BAR; PG8_MMA(1, 1, At, B1); PG8_BAR;
            PG8_LDB(B0, 1, 0); PG8_SCHED; PG8_LDA(At, 1, 0); PG8_STAGE(PG8_SA(0, 1), a2 + hstep, voffA);
            PG8_WAIT_L(8); PG8_BAR; PG8_WAIT_L(0); PG8_MMA(0, 0, At, B0); PG8_BAR; PG8_SCHED;
            PG8_LDB(B1, 1, 1); PG8_STAGE(PG8_SB(1, 0), b3, voffB);
            PG8_BAR; PG8_WAIT_L(0); PG8_MMA(0, 1, At, B1); PG8_BAR;
            PG8_LDA(At, 1, 1); PG8_STAGE(PG8_SA(1, 0), a3, voffA);
            PG8_BAR; PG8_WAIT_L(0); PG8_MMA(1, 0, At, B0); PG8_BAR; PG8_SCHED;
            PG8_STAGE(PG8_SB(1, 1), b3 + hstep, voffB);
            PG8_WAIT_V(6); PG8_BAR; PG8_MMA(1, 1, At, B1); PG8_BAR;
            }
        }
        if constexpr (ALIGN_EPI) { if (wr == 0) PG8_BAR; }
        E(acc, cur, wr, wc, fr, fq);
        PG8_WAIT_V(0);
        if (!has_next) break;
#pragma unroll
        for (int a = 0; a < 2; ++a)
#pragma unroll
            for (int b = 0; b < 2; ++b)
#pragma unroll
                for (int m = 0; m < 4; ++m)
#pragma unroll
                    for (int n = 0; n < 2; ++n) acc[a][b][m][n] = (f32x4){0.f, 0.f, 0.f, 0.f};
        cur = nxt; cA = nA; cB = nB; ++ui;
        if constexpr (ALIGN_EPI) { if (wr == 1) PG8_BAR; }
    }
    PG8_WAIT_V(0);
    if constexpr (!ALIGN_EPI) { if (wr == 0) PG8_BAR; }
    PG8_BAR;
#undef PG8_SA
#undef PG8_SB
#undef PG8_STAGE
#undef PG8_LDA
#undef PG8_LDB
#undef PG8_MMA
#undef PG8_BAR
#undef PG8_SCHED
}
}

struct Frame {
    unsigned char* lds; LAS unsigned char* ldsl; PP P; GAS unsigned char* ws; GAS float* out;
    int tid, lane, wave, G, bx;
};
DEV int tok_cond(int t) { return t < TC ? 0 : 1 + (t - TC) / DSEQ; }

DEV int hperm(int p) { const int bj = p >> 7, wc = (p >> 5) & 3, c5 = p & 31; return wc * 64 + 32 * bj + 16 * ((c5 >> 2) & 1) + 4 * (c5 >> 3) + (c5 & 3); }
DEV int win_src_col(int r) {
    if (r < 512) return (r & ~255) + hperm(r & 255);
    if (r < 1536) return r;
    if (r < 3840) return r + 16;
    if (r < 3856) return 1536 + (r - 3840);
    if (r < 4096) return -1;
    return r - 240;
}
DEV void transpose_item(const float* W, int ldw, int srccol, bf16* WT, int ldt, int drow0, int k0, float* scr, int lane) {
#pragma unroll 8
    for (int i = 0; i < 32; ++i) { const int kk = 2 * i + (lane >> 5); scr[kk * 33 + (lane & 31)] = srccol >= 0 ? NT_LD(W + (size_t)(k0 + kk) * ldw + srccol) : 0.f; }
    WAVE_SYNC();
    const int c = lane & 7;
#pragma unroll
    for (int j = 0; j < 4; ++j) { const int n = (lane >> 3) + 8 * j; const float* s = scr + (8 * c) * 33 + n;
        u32x4 o; o.x = pk2(s[0 * 33], s[1 * 33]); o.y = pk2(s[2 * 33], s[3 * 33]); o.z = pk2(s[4 * 33], s[5 * 33]); o.w = pk2(s[6 * 33], s[7 * 33]);
        *(u32x4*)(WT + (size_t)(drow0 + n) * ldt + k0 + 8 * c) = o; }
    WAVE_SYNC();
}
DEV void transpose_item64(const float* W, int ldw, int srccol0, bf16* WT, int ldt, int drow0, int k0, int dcol0, float* scr, int lane) {
    const int c4 = (lane & 15) * 4, r4 = lane >> 4;
#pragma unroll 8
    for (int i = 0; i < 16; ++i) { const int kk = 4 * i + r4; const f32x4 v = NT_LD((const f32x4*)(W + (size_t)(k0 + kk) * ldw + srccol0 + c4));
        float* d = scr + kk * 65 + c4; d[0] = v.x; d[1] = v.y; d[2] = v.z; d[3] = v.w; }
    WAVE_SYNC();
    const int c = lane & 7;
#pragma unroll
    for (int j = 0; j < 8; ++j) { const int n = (lane >> 3) + 8 * j; const float* sp = scr + (8 * c) * 65 + n;
        u32x4 o; o.x = pk2(sp[0 * 65], sp[1 * 65]); o.y = pk2(sp[2 * 65], sp[3 * 65]); o.z = pk2(sp[4 * 65], sp[5 * 65]); o.w = pk2(sp[6 * 65], sp[7 * 65]);
        *(u32x4*)(WT + (size_t)(drow0 + n) * ldt + dcol0 + 8 * c) = o; }
    WAVE_SYNC();
}
constexpr int CW_IN = 16 * (NPERM / 64), CW_BR = 4 * 4 * (D / 64), CW_OUT = 16 * (D / 64), CW_ITEMS = CW_IN + CW_BR + CW_OUT;
DEV void convert_item(Frame& F, int l, int it, float* scr) {
    const float* w_in = F.P->in[13] + (size_t)l * D * INW;
    const float* w_br = F.P->in[22] + (size_t)l * 4 * 256 * D;
    const float* w_out = F.P->in[23] + (size_t)l * D * D;
    bf16* WIN = (bf16*)(F.ws + WS_WIN); bf16* WBR = (bf16*)(F.ws + WS_WBR); bf16* WOUT = (bf16*)(F.ws + WS_WOUT);
    int r = it;
    if (r < CW_IN) { const int kb = r / (NPERM / 64), nb = r % (NPERM / 64), r0 = nb * 64;
        if (r0 < 512 || (r0 >= 3840 && r0 < 4096)) {
            transpose_item(w_in, INW, win_src_col(r0 + (F.lane & 31)), WIN, D, r0, kb * 64, scr, F.lane);
            transpose_item(w_in, INW, win_src_col(r0 + 32 + (F.lane & 31)), WIN, D, r0 + 32, kb * 64, scr, F.lane);
        } else transpose_item64(w_in, INW, win_src_col(r0), WIN, D, r0, kb * 64, kb * 64, scr, F.lane);
        return; }
    r -= CW_IN;
    if (r < CW_BR) { const int n = r / (4 * (D / 64)), q = r % (4 * (D / 64)), kb = q / (D / 64), nb = q % (D / 64);
        transpose_item64(w_br + (size_t)n * 256 * D, D, nb * 64, WBR, D, nb * 64, kb * 64, n * 256 + kb * 64, scr, F.lane); return; }
    r -= CW_BR;
    { const int kb = r / (D / 64), nb = r % (D / 64); transpose_item64(w_out, D, nb * 64, WOUT, D, nb * 64, kb * 64, kb * 64, scr, F.lane); }
}
DEV void convert_weights(Frame& F, int l) {
    float* scr = (float*)(F.lds + F.wave * 16640);
    const int gw = F.bx * 8 + F.wave, NGW = F.G * 8;
    for (int it = gw; it < CW_ITEMS; it += NGW) convert_item(F, l, it, scr);
}
constexpr int CT_AV = DEPTH * DB * 2 * (PAST / 64), CT_NV = DEPTH * DB * 4 * (PAST / 64), CT_S0 = 2 * DEPTH * DB * 8, CT_ITEMS = CT_AV + CT_NV + CT_S0;
DEV void cache_item(Frame& F, int it, float* scr) {
    int r = it;
    if (r < CT_AV) { const int sb = r % (PAST / 64); int q = r / (PAST / 64); const int h = q % 2; q /= 2; const int b = q % DB; const int l = q / DB;
        transpose_item64(F.P->in[3] + (((size_t)b * DEPTH + l) * PAST) * 128 + h * 64, 128, 0, (bf16*)(F.ws + WS_VACT) + (((size_t)l * DB + b) * 2 + h) * 64 * PAST, PAST, 0, sb * 64, sb * 64, scr, F.lane); return; }
    r -= CT_AV;
    if (r < CT_NV) { const int sb = r % (PAST / 64); int q = r / (PAST / 64); const int h = q % 4; q /= 4; const int b = q % DB; const int l = q / DB;
        transpose_item64(F.P->in[5] + (((size_t)b * DEPTH + l) * PAST) * 256 + h * 64, 256, 0, (bf16*)(F.ws + WS_NVCT) + (((size_t)l * DB + b) * 4 + h) * 64 * PAST, PAST, 0, sb * 64, sb * 64, scr, F.lane); return; }
    r -= CT_NV;
    { const int hd = r % 8; int q = r / 8; const int b = q % DB; q /= DB; const int l = q % DEPTH; const int type = q / DEPTH;
      const float* src = (type == 0 ? F.P->in[6] : F.P->in[7]) + (((size_t)b * DEPTH + l) * 8 + hd) * 4096;
      transpose_item64(src, 64, 0, (bf16*)(F.ws + WS_S0T) + (size_t)r * 4096, 64, 0, 0, 0, scr, F.lane); }
}
DEV void mod_item(Frame& F, int it, float* red, const float* scond) {
    float* MODT = (float*)(F.ws + WS_MODT);
    const int l = it / 48, c0 = (it % 48) * 64;
    const float* wa = F.P->in[10] + (size_t)l * D * 3072 + c0 + F.lane;
    float acc[NCOND];
#pragma unroll
    for (int j = 0; j < NCOND; ++j) acc[j] = 0.f;
    for (int k0 = F.wave * 128; k0 < F.wave * 128 + 128; k0 += 32) {
        float wv[32];
#pragma unroll
        for (int i = 0; i < 32; ++i) wv[i] = NT_LD(wa + (size_t)(k0 + i) * 3072);
#pragma unroll
        for (int i = 0; i < 32; ++i)
#pragma unroll
            for (int j = 0; j < NCOND; ++j) acc[j] += scond[j * D + k0 + i] * wv[i];
    }
#pragma unroll
    for (int j = 0; j < NCOND; ++j) red[(F.wave * NCOND + j) * 64 + F.lane] = acc[j];
    __syncthreads();
    for (int e = F.tid; e < NCOND * 64; e += 512) { const int j = e >> 6, ln = e & 63; float sm = F.P->in[11][(size_t)l * 3072 + c0 + ln];
        for (int w = 0; w < 8; ++w) sm += red[(w * NCOND + j) * 64 + ln];
        MODT[((size_t)l * NCOND + j) * 3072 + c0 + ln] = sm; }
    __syncthreads();
}
DEV void p0_prologue(Frame& F) {
    float* red = (float*)F.lds;
    float* scond = (float*)F.lds + 8 * NCOND * 64;
    float* scr = (float*)(F.lds + F.wave * 16640);
    volatile LAS unsigned* misc = (volatile LAS unsigned*)(F.ldsl + LDS_MISC);
    constexpr int U_MOD = DEPTH * 48, U_CW = (CW_ITEMS + 7) / 8, U_CT = (CT_ITEMS + 7) / 8;
    bool have_scond = false;
    for (;;) {
        __syncthreads();
        if (F.tid == 0) misc[16] = atomicAdd((unsigned*)(F.ws + WS_CTL) + 4096 + 64 * 2, 1u);
        __syncthreads();
        int u = __builtin_amdgcn_readfirstlane((int)misc[16]);
        if (u < U_MOD) {
            if (!have_scond) { for (int e = F.tid; e < NCOND * D; e += 512) { const int j = e / D, k = e % D; scond[e] = silu_f(j == 0 ? F.P->in[9][k] : F.P->in[8][(size_t)(j - 1) * D + k]); }
                __syncthreads(); have_scond = true; }
            mod_item(F, u, red, scond); continue; }
        u -= U_MOD; have_scond = false;
        if (u < U_CW) { const int it = u * 8 + F.wave; if (it < CW_ITEMS) convert_item(F, 0, it, scr); continue; }
        u -= U_CW;
        if (u < U_CT) { const int it = u * 8 + F.wave; if (it < CT_ITEMS) cache_item(F, it, scr); continue; }
        break;
    }
    if (F.bx == F.G - 1) {
        float* RC = (float*)(F.ws + WS_ROPE); float* RS = RC + 1024;
        for (int e = F.tid; e < 1024; e += 512) { const int pos = e >> 4, i = e & 15; const float inv = powf(10000.0f, -(float)i / 16.0f); const float ang = (float)pos * inv; RC[e] = cosf(ang); RS[e] = sinf(ang); }
    }
    const size_t gt = (size_t)F.bx * 512 + F.tid, NT = (size_t)F.G * 512;
    { bf16* KAC = (bf16*)(F.ws + WS_KAC); constexpr size_t n4 = (size_t)DEPTH * DB * 2 * PAST * 16;
#pragma unroll 4
      for (size_t e = gt; e < n4; e += NT) { const int d = (int)(e & 15) * 4; size_t q = e >> 4; const int sq = q % PAST; q /= PAST; const int h = q % 2; q /= 2; const int b = q % DB; const int l = q / DB;
          const f32x4 v = NT_LD((const f32x4*)(F.P->in[2] + ((((size_t)b * DEPTH + l) * PAST + sq) * 2 + h) * 64 + d)); u32x2 w; w.x = pk2(v.x, v.y); w.y = pk2(v.z, v.w); *(u32x2*)(KAC + e * 4) = w; } }
    { bf16* NKC = (bf16*)(F.ws + WS_NKC); constexpr size_t n4 = (size_t)DEPTH * DB * 4 * PAST * 16;
#pragma unroll 4
      for (size_t e = gt; e < n4; e += NT) { const int d = (int)(e & 15) * 4; size_t q = e >> 4; const int sq = q % PAST; q /= PAST; const int h = q % 4; q /= 4; const int b = q % DB; const int l = q / DB;
          const f32x4 v = NT_LD((const f32x4*)(F.P->in[4] + ((((size_t)b * DEPTH + l) * PAST + sq) * 4 + h) * 64 + d)); u32x2 w; w.x = pk2(v.x, v.y); w.y = pk2(v.z, v.w); *(u32x2*)(NKC + e * 4) = w; } }
}

DEV int norm_row0(const Frame& F, int i) { return (F.G * 64 == T && (F.G & 7) == 0) ? (F.bx & 7) * (T / 8) + ((F.bx >> 3) * 8 + F.wave) * 8 + 4 * i : -1; }
DEV void p1_norm(Frame& F, int l) {
    const float* MODT = (const float*)(F.ws + WS_MODT) + (size_t)l * NCOND * 3072;
    const float* ng = F.P->in[12] + (size_t)l * D;
    bf16* HN = (bf16*)(F.ws + WS_HN);
    const int gw = F.bx * 8 + F.wave, NGW = F.G * 8;
    if (F.G * 64 == T && (F.G & 7) == 0) {
        {
            const int t0 = norm_row0(F, 0);
            f32x4 v[8][4]; float s[8];
#pragma unroll
            for (int r = 0; r < 8; ++r) { const int t = t0 + r;
                const float* xrow = (l == 0) ? (t < TC ? F.P->in[0] + (size_t)t * D : F.P->in[1] + (size_t)(t - TC) * D) : F.out + (size_t)t * D;
#pragma unroll
                for (int j = 0; j < 4; ++j) v[r][j] = *(const f32x4*)(xrow + 4 * F.lane + 256 * j); }
#pragma unroll
            for (int r = 0; r < 8; ++r) { float a = 0.f;
#pragma unroll
                for (int j = 0; j < 4; ++j) a += (v[r][j].x * v[r][j].x + v[r][j].y * v[r][j].y) + (v[r][j].z * v[r][j].z + v[r][j].w * v[r][j].w);
                s[r] = 1.0f / sqrtf(wave_sum(a, F.lane) * (1.0f / D) + EPS); }
            const float* md = MODT + (size_t)tok_cond(t0) * 3072;
#pragma unroll
            for (int j = 0; j < 4; ++j) { const int c = 4 * F.lane + 256 * j;
                const f32x4 g = *(const f32x4*)(ng + c), sh = *(const f32x4*)(md + c), sc = *(const f32x4*)(md + 1024 + c); const f32x4 gs = g * (sc + 1.0f);
#pragma unroll
                for (int r = 0; r < 8; ++r) { const f32x4 o = v[r][j] * s[r] * gs + sh;
                    u32x2 w; w.x = pk2(o.x, o.y); w.y = pk2(o.z, o.w); *(u32x2*)(HN + (size_t)(t0 + r) * D + c) = w; } }
        }
        return;
    }
    for (int t = gw; t < T; t += NGW) {
        const float* xrow = (l == 0) ? (t < TC ? F.P->in[0] + (size_t)t * D : F.P->in[1] + (size_t)(t - TC) * D) : F.out + (size_t)t * D;
        const float* md = MODT + (size_t)tok_cond(t) * 3072;
        f32x4 v[4]; float s = 0.f;
#pragma unroll
        for (int j = 0; j < 4; ++j) { v[j] = *(const f32x4*)(xrow + 4 * F.lane + 256 * j); s += (v[j].x * v[j].x + v[j].y * v[j].y) + (v[j].z * v[j].z + v[j].w * v[j].w); }
        const float rstd = 1.0f / sqrtf(wave_sum(s, F.lane) * (1.0f / D) + EPS);
#pragma unroll
        for (int j = 0; j < 4; ++j) { const int c = 4 * F.lane + 256 * j;
            const f32x4 g = *(const f32x4*)(ng + c), sh = *(const f32x4*)(md + c), sc = *(const f32x4*)(md + 1024 + c);
            const f32x4 o = v[j] * rstd * g * (sc + 1.0f) + sh;
            u32x2 w; w.x = pk2(o.x, o.y); w.y = pk2(o.z, o.w); *(u32x2*)(HN + (size_t)t * D + c) = w; }
    }
}

struct EpiIn {
    static constexpr bool PERM = true;
    unsigned char* ws; float* out; const float* qn; const float* kn; const float* alog_; const float* dtb_; int l;
    DEV void operator()(const f32x4 (&acc)[2][2][4][2], const pg8::Unit& u, int wr, int wc, int fr, int fq) const {
        OPAQUE(fr); OPAQUE(fq);
        const int t0 = u.pm * 256; const bool ctx = t0 < TC;
        const int b = ctx ? t0 / SEQ : (t0 - TC) / DSEQ, sb = ctx ? t0 % SEQ : (t0 - TC) % DSEQ, L = ctx ? SEQ : DSEQ;
        const int rl0 = wr * 64 + fr;
        const int pn = u.pn;
        auto plain = [&](bf16* base, int ld, int coloff, int act, float scale) {
#pragma unroll
            for (int ai = 0; ai < 2; ++ai)
#pragma unroll
                for (int m = 0; m < 4; ++m) { const int t = t0 + rl0 + ai * 128 + m * 16; bf16* rowp = base + (size_t)t * ld + coloff + wc * 32 + 8 * fq;
#pragma unroll
                    for (int bj = 0; bj < 2; ++bj) { f32x4 v0 = acc[ai][bj][m][0], v1 = acc[ai][bj][m][1];
                        if (act == 1) { v0.x = silu_f(v0.x); v0.y = silu_f(v0.y); v0.z = silu_f(v0.z); v0.w = silu_f(v0.w); v1.x = silu_f(v1.x); v1.y = silu_f(v1.y); v1.z = silu_f(v1.z); v1.w = silu_f(v1.w); }
                        v0 = v0 * scale; v1 = v1 * scale;
                        u32x4 w; w.x = pk2(v0.x, v0.y); w.y = pk2(v0.z, v0.w); w.z = pk2(v1.x, v1.y); w.w = pk2(v1.z, v1.w);
                        *(u32x4*)(rowp + bj * 128) = w; } CFENCE(); }
        };
        if (pn == 0 || pn == 1) {
            const bool isq = (pn == 0), isv = (pn == 1 && wc >= 2);
            const float* gn = isq ? qn : kn;
            f32x4 gnv[2][2];
#pragma unroll
            for (int bj = 0; bj < 2; ++bj)
#pragma unroll
                for (int n = 0; n < 2; ++n) gnv[bj][n] = *(const f32x4*)(gn + 32 * bj + 16 * n + 4 * fq);
            const float* RC = (const float*)(ws + WS_ROPE); const float* RS = RC + 1024;
#pragma unroll
            for (int ai = 0; ai < 2; ++ai)
#pragma unroll
                for (int m = 0; m < 4; ++m) {
                    const int rl = rl0 + ai * 128 + m * 16, t = t0 + rl, s = sb + rl;
                    f32x4 x[2][2];
#pragma unroll
                    for (int bj = 0; bj < 2; ++bj)
#pragma unroll
                        for (int n = 0; n < 2; ++n) x[bj][n] = acc[ai][bj][m][n];
                    if (!isv) {
                        float ss = 0.f;
#pragma unroll
                        for (int bj = 0; bj < 2; ++bj)
#pragma unroll
                            for (int n = 0; n < 2; ++n) ss += (x[bj][n].x * x[bj][n].x + x[bj][n].y * x[bj][n].y) + (x[bj][n].z * x[bj][n].z + x[bj][n].w * x[bj][n].w);
                        ss += shx(ss, 16, fr + 16 * fq); ss += shx(ss, 32, fr + 16 * fq);
                        const float rstd = 1.0f / sqrtf(ss * (1.0f / 64.0f) + EPS);
#pragma unroll
                        for (int bj = 0; bj < 2; ++bj)
#pragma unroll
                            for (int n = 0; n < 2; ++n) x[bj][n] = x[bj][n] * rstd * gnv[bj][n];
                    }
                    if (pn == 1 && ctx) {
                        float* dst = out + (wc < 2 ? O_AK : O_AV) + (((size_t)b * DEPTH + l) * SEQ + s) * 128 + (wc & 1) * 64;
#pragma unroll
                        for (int bj = 0; bj < 2; ++bj)
#pragma unroll
                            for (int n = 0; n < 2; ++n) NT_ST((f32x4*)(dst + 32 * bj + 16 * n + 4 * fq), x[bj][n]);
                    }
                    if (!isv && !ctx) {
#pragma unroll
                        for (int bj = 0; bj < 2; ++bj) { const int pos = bj == 0 ? (s >> 6) : (s & 63);
                            const f32x4 cs = *(const f32x4*)(RC + pos * 16 + 4 * fq), sn = *(const f32x4*)(RS + pos * 16 + 4 * fq);
                            const f32x4 x1 = x[bj][0], x2 = x[bj][1];
                            x[bj][0] = x1 * cs - x2 * sn; x[bj][1] = x2 * cs + x1 * sn; }
                    }
                    if (isq) {
                        bf16* dst = (bf16*)(ws + WS_QA) + (size_t)t * 256 + wc * 64;
#pragma unroll
                        for (int bj = 0; bj < 2; ++bj)
#pragma unroll
                            for (int n = 0; n < 2; ++n) { const f32x4 v = x[bj][n] * (0.125f * 1.4426950408889634f); u32x2 w; w.x = pk2(v.x, v.y); w.y = pk2(v.z, v.w); *(u32x2*)(dst + 32 * bj + 16 * n + 4 * fq) = w; }
                    } else if (!isv) {
                        bf16* dst = (bf16*)(ws + WS_KA) + (ctx ? (size_t)0 : (size_t)TC * 128) + (((size_t)b * 2 + wc) * L + s) * 64;
#pragma unroll
                        for (int bj = 0; bj < 2; ++bj)
#pragma unroll
                            for (int n = 0; n < 2; ++n) { const f32x4 v = x[bj][n]; u32x2 w; w.x = pk2(v.x, v.y); w.y = pk2(v.z, v.w); *(u32x2*)(dst + 32 * bj + 16 * n + 4 * fq) = w; }
                    } else {
                        bf16* dst = (bf16*)(ws + WS_VAT) + (ctx ? (size_t)0 : (size_t)TC * 128) + ((size_t)b * 2 + (wc - 2)) * 64 * L + s;
#pragma unroll
                        for (int bj = 0; bj < 2; ++bj)
#pragma unroll
                            for (int n = 0; n < 2; ++n) { const int d0 = 32 * bj + 16 * n + 4 * fq;
                                dst[(size_t)(d0 + 0) * L] = (bf16)f2bf(x[bj][n].x); dst[(size_t)(d0 + 1) * L] = (bf16)f2bf(x[bj][n].y);
                                dst[(size_t)(d0 + 2) * L] = (bf16)f2bf(x[bj][n].z); dst[(size_t)(d0 + 3) * L] = (bf16)f2bf(x[bj][n].w); }
                    }
                    CFENCE();
                }
        } else if (pn == 2) plain((bf16*)(ws + WS_BR), 1024, 0, 1, 1.f);
        else if (pn >= 3 && pn <= 5) plain((bf16*)(ws + WS_GQKV), 768, (pn - 3) * 256, 0, 1.f);
        else if (pn == 6) plain((bf16*)(ws + WS_BR), 1024, 256, 1, 1.f);
        else if (pn == 7 || pn == 8) plain((bf16*)(ws + WS_RQKV), 512, (pn - 7) * 256, 0, pn == 7 ? 0.125f : 1.f);
        else if (pn == 10) plain((bf16*)(ws + WS_BR), 1024, 512, 1, 1.f);
        else if (pn == 11) plain((bf16*)(ws + WS_NQ), 256, 0, 0, 0.125f * 1.4426950408889634f);
        else if (pn == 12 || pn == 13 || pn == 9) {
            const bool isk = pn == 12; const bool isr = pn == 9;
#pragma unroll
            for (int ai = 0; ai < 2; ++ai)
#pragma unroll
                for (int m = 0; m < 4; ++m) { const int rl = rl0 + ai * 128 + m * 16, s = sb + rl;
#pragma unroll
                    for (int bj = 0; bj < 2; ++bj) { const int head = 2 * bj + (wc >> 1), d0 = 32 * (wc & 1) + 8 * fq;
                        const f32x4 v0 = acc[ai][bj][m][0], v1 = acc[ai][bj][m][1];
                        if (ctx && !isr) { float* dst = out + (isk ? O_NK : O_NV) + (((size_t)b * DEPTH + l) * SEQ + s) * 256 + head * 64 + d0; NT_ST((f32x4*)dst, v0); NT_ST((f32x4*)(dst + 4), v1); }
                        if (isk) { bf16* dst = (bf16*)(ws + WS_NK) + (ctx ? (size_t)0 : (size_t)TC * 256) + (((size_t)b * 4 + head) * L + s) * 64 + d0;
                            u32x4 w; w.x = pk2(v0.x, v0.y); w.y = pk2(v0.z, v0.w); w.z = pk2(v1.x, v1.y); w.w = pk2(v1.z, v1.w); *(u32x4*)dst = w; }
                        else { bf16* dst = (bf16*)(ws + (isr ? WS_RVT : WS_NVT)) + (ctx ? (size_t)0 : (size_t)TC * 256) + (((size_t)b * 4 + head) * 64 + d0) * L + s;
                            dst[0] = (bf16)f2bf(v0.x); dst[(size_t)L] = (bf16)f2bf(v0.y); dst[(size_t)2 * L] = (bf16)f2bf(v0.z); dst[(size_t)3 * L] = (bf16)f2bf(v0.w);
                            dst[(size_t)4 * L] = (bf16)f2bf(v1.x); dst[(size_t)5 * L] = (bf16)f2bf(v1.y); dst[(size_t)6 * L] = (bf16)f2bf(v1.z); dst[(size_t)7 * L] = (bf16)f2bf(v1.w); } } CFENCE(); }
        } else if (pn == 14) plain((bf16*)(ws + WS_BR), 1024, 768, 1, 1.f);
        else {
            if (wc == 0 && fq < 2) {
                const float* alog = alog_; const float* dtb = dtb_;
                float* GAB = (float*)(ws + WS_GAB);
#pragma unroll
                for (int ai = 0; ai < 2; ++ai)
#pragma unroll
                    for (int m = 0; m < 4; ++m) { const int t = t0 + rl0 + ai * 128 + m * 16;
#pragma unroll
                        for (int n = 0; n < 2; ++n) { const int c = 8 * fq + 4 * n; const f32x4 v = acc[ai][0][m][n]; f32x4 o;
                            if (c < 8) { o.x = sigmoid_f(v.x); o.y = sigmoid_f(v.y); o.z = sigmoid_f(v.z); o.w = sigmoid_f(v.w); }
                            else { const int dir = (c >> 2) - 2;
                                o.x = -__expf(alog[dir * 4 + 0]) * softplus_f(v.x + dtb[dir * 4 + 0]); o.y = -__expf(alog[dir * 4 + 1]) * softplus_f(v.y + dtb[dir * 4 + 1]);
                                o.z = -__expf(alog[dir * 4 + 2]) * softplus_f(v.z + dtb[dir * 4 + 2]); o.w = -__expf(alog[dir * 4 + 3]) * softplus_f(v.w + dtb[dir * 4 + 3]); }
                            *(f32x4*)(GAB + (size_t)t * 16 + c) = o; } CFENCE(); }
            }
        }
    }
};

DEV f32x4 mfma4(float a, float b, f32x4 c) { return __builtin_amdgcn_mfma_f32_16x16x4f32(a, b, c, 0, 0, 0); }
constexpr int GP = 72;
constexpr int TS_ = 68;
constexpr int G_TM = 0, G_KR = 17408, G_QR = G_KR + 9216, G_KT = G_QR + 9216, G_VT = G_KT + 9216, G_ST = G_VT + 9216, G_VEC = G_ST + 9216, G_HALF = G_VEC + 1536;
static_assert(2 * G_HALF <= 143360, "GDN LDS map");
DEV unsigned char* g_tm(unsigned char* lds, int half) { return lds + half * 17408; }
DEV unsigned char* g_half(unsigned char* lds, int half) { return lds + 2 * 17408 + half * (G_HALF - 17408); }
#define GOFF(x) ((x) - 17408)

DEV f32x4 bmma(bf16x8 a, bf16x8 b, f32x4 c) { return __builtin_amdgcn_mfma_f32_16x16x32_bf16(a, b, c, 0, 0, 0); }
DEV bf16x8 pack8(f32x4 lo, f32x4 hi) { u32x4 u; u.x = pk2(lo.x, lo.y); u.y = pk2(lo.z, lo.w); u.z = pk2(hi.x, hi.y); u.w = pk2(hi.z, hi.w); return __builtin_bit_cast(bf16x8, u); }
DEV bf16x8 ld8(const bf16* p) { return *(const bf16x8*)p; }
DEV bf16x8 ld44(const bf16* p0, const bf16* p1) { const u32x2 a = *(const u32x2*)p0, b = *(const u32x2*)p1; u32x4 u; u.x = a.x; u.y = a.y; u.z = b.x; u.w = b.y; return __builtin_bit_cast(bf16x8, u); }

constexpr int G_PB = 130048;
constexpr size_t WS_ZERO = WS_CTL + 32768;
constexpr int G_TB = G_PB + 26112;
DEV void gdn_dma(Frame& F, int l, int task) {
    const int chunk = task >> 2, head = task & 3, tid = F.tid;
    const int t0 = chunk * 64; const bool ctx = t0 < TC;
    const int L = ctx ? SEQ : DSEQ, s0 = ctx ? t0 % SEQ : (t0 - TC) % DSEQ, tseq = t0 - s0;
    const bf16* SRC = (const bf16*)(F.ws + WS_GQKV); const bf16* ZR = (const bf16*)(F.ws + WS_ZERO);
#pragma unroll
    for (int k = 0; k < 4; ++k) { const int e = tid + 512 * k; const int rr = e / 24, c8 = e % 24; const int sp = s0 - 2 + rr;
        const bf16* src = (sp >= 0 && sp < L) ? SRC + (size_t)(tseq + sp) * 768 + (c8 >> 3) * 256 + head * 64 + (c8 & 7) * 8 : ZR;
        if (e < 68 * 24) __builtin_amdgcn_global_load_lds((const unsigned*)src, (LAS unsigned*)(F.ldsl + G_PB + (F.wave * 64 + 512 * k) * 16), 16, 0, 0); }
#pragma unroll
    for (int rr = 0; rr < 2; ++rr) { const int r = F.wave * 2 + rr;
        if (r < 15) { const float* src = F.P->in[14] + (size_t)l * 5 * 768 + (r % 5) * 768 + (r / 5) * 256 + head * 64 + F.lane;
            __builtin_amdgcn_global_load_lds((const unsigned*)src, (LAS unsigned*)(F.ldsl + G_TB + r * 256), 4, 0, 0); } }
}
DEV void gdn_dma_wait() { PG8_WAIT_V(0); __syncthreads(); }
struct GdnPre { float ga[2]; };
template <bool NEEDQ>
DEV void gdn_prefetch(Frame& F, int l, int task, GdnPre& P) {
    const int chunk = task >> 2, head = task & 3, lane = F.lane, half = F.wave >> 2, wq = F.wave & 3;
    const int t0 = chunk * 64; const bool ctx = t0 < TC;
    const int s0 = ctx ? t0 % SEQ : (t0 - TC) % DSEQ, tseq = t0 - s0;
    P.ga[0] = 0.f; P.ga[1] = 0.f;
    if (wq == 3) { const int s = s0 + (half ? 63 - lane : lane); const float* ga = (const float*)(F.ws + WS_GAB) + (size_t)(tseq + s) * 16; P.ga[0] = ga[8 + half * 4 + head]; P.ga[1] = ga[half * 4 + head]; }
}
DEV bf16x8* gdn_tf(const Frame& F, int task, int half) { const size_t slot = (size_t)task * 2 + half; return (bf16x8*)(F.ws + (slot < TF_NA ? WS_WIN + slot * TF_SLOT : WS_TFB + (slot - TF_NA) * TF_SLOT)); }
template <bool NEEDQ, bool SKIPT = false>
DEV void gdn_front(Frame& F, int l, int chunk, int head, const GdnPre& P, int ntask, GdnPre& N) {
    const int tid = F.tid, lane = F.lane, li = lane & 15, lq = lane >> 4, half = F.wave >> 2, wq = F.wave & 3, dir = half;
    unsigned char* lds = F.lds;
    const int t0 = chunk * 64; const bool ctx = t0 < TC;
    const int L = ctx ? SEQ : DSEQ, s0 = ctx ? t0 % SEQ : (t0 - TC) % DSEQ, tseq = t0 - s0;
    const bf16* raw = (const bf16*)(lds + G_PB);
    float* Tm = (float*)g_tm(lds, half);
    unsigned char* hb = g_half(lds, half);
    bf16* kr = (bf16*)(hb + GOFF(G_KR)); bf16* qr = (bf16*)(hb + GOFF(G_QR)); bf16* kT = (bf16*)(hb + GOFF(G_KT)); bf16* vT = (bf16*)(hb + GOFF(G_VT));
    float* vec = (float*)(hb + GOFF(G_VEC)); float* gs = vec; float* bs = vec + 64; float* rnk = vec + 128; float* rnq = vec + 192; float* sc1 = vec + 256; float* scd = vec + 320;
    {
        LAS bf16* H0 = (LAS bf16*)(F.ldsl + 2 * 17408); LAS bf16* H1 = (LAS bf16*)(F.ldsl + 2 * 17408 + (G_HALF - 17408));
        const int pb = 32 * half + 8 * wq;
#pragma unroll
        for (int t = NEEDQ ? 0 : 1; t < 3; ++t) {
            const bf16* rc = raw + t * 64 + lane;
            float w5[5];
#pragma unroll
            for (int j = 0; j < 5; ++j) w5[j] = ((const float*)(lds + G_TB))[(t * 5 + j) * 64 + lane];
            const int orow = (t == 0 ? GOFF(G_QR) : GOFF(G_KR)) / 2, otr = (t == 1 ? GOFF(G_KT) : GOFF(G_VT)) / 2;
            float x0 = bf2f(rc[(pb + 0) * 192]), x1 = bf2f(rc[(pb + 1) * 192]), x2 = bf2f(rc[(pb + 2) * 192]), x3 = bf2f(rc[(pb + 3) * 192]);
            float yv[8];
#pragma unroll
            for (int e = 0; e < 8; ++e) { const int p = pb + e; const float x4 = bf2f(rc[(p + 4) * 192]);
                const float y = x0 * w5[0] + x1 * w5[1] + x2 * w5[2] + x3 * w5[3] + x4 * w5[4];
                x0 = x1; x1 = x2; x2 = x3; x3 = x4;
                yv[e] = silu_f(y);
                if (t < 2) { const bf16 yb = (bf16)f2bf(yv[e]); H0[orow + p * GP + lane] = yb; H1[orow + (63 - p) * GP + lane] = yb; } }
            if (t > 0) {
                u32x4 f, r; f.x = pk2(yv[0], yv[1]); f.y = pk2(yv[2], yv[3]); f.z = pk2(yv[4], yv[5]); f.w = pk2(yv[6], yv[7]);
                r.x = pk2(yv[7], yv[6]); r.y = pk2(yv[5], yv[4]); r.z = pk2(yv[3], yv[2]); r.w = pk2(yv[1], yv[0]);
                *(LAS u32x4*)(H0 + otr + lane * GP + pb) = f;
                *(LAS u32x4*)(H1 + otr + lane * GP + (56 - pb)) = r; }
        }
    }
    if (wq == 3) {
        float g = P.ga[0];
#pragma unroll
        for (int o = 1; o < 64; o <<= 1) { const float v = shf(g, lane >= o ? lane - o : lane); if (lane >= o) g += v; }
        gs[lane] = g; bs[lane] = P.ga[1];
    }
    __syncthreads();
    gdn_dma(F, l, ntask); gdn_prefetch<NEEDQ>(F, l, ntask, N);
    if (wq == 0 || (NEEDQ && wq == 1)) {
        const bf16* row = (wq == 0 ? kr : qr) + lane * GP; float ss = 0.f;
#pragma unroll
        for (int c = 0; c < 8; ++c) { const u32x4 v = *(const u32x4*)(row + 8 * c);
            const float a0 = bf2f(v.x & 0xffffu), a1 = bf2f(v.x >> 16), a2 = bf2f(v.y & 0xffffu), a3 = bf2f(v.y >> 16), a4 = bf2f(v.z & 0xffffu), a5 = bf2f(v.z >> 16), a6 = bf2f(v.w & 0xffffu), a7 = bf2f(v.w >> 16);
            ss += (a0 * a0 + a1 * a1) + (a2 * a2 + a3 * a3) + (a4 * a4 + a5 * a5) + (a6 * a6 + a7 * a7); }
        const float rn = 1.0f / sqrtf(ss + EPS);
        if (wq == 0) { rnk[lane] = rn; sc1[lane] = bs[lane] * __expf(gs[lane]) * rn; scd[lane] = rn * __expf(gs[63] - gs[lane]); }
        else rnq[lane] = rn * 0.125f;
    }
    __syncthreads();
    if constexpr (SKIPT) return;
    {
        auto a_tile = [&](int ti, int tj) {
            f32x4 c = {0.f, 0.f, 0.f, 0.f};
#pragma unroll
            for (int ks = 0; ks < 2; ++ks) c = bmma(ld8(kr + (16 * ti + li) * GP + 32 * ks + 8 * lq), ld8(kr + (16 * tj + li) * GP + 32 * ks + 8 * lq), c);
            const int j = 16 * tj + li; const float gj = gs[j], rj = rnk[j];
            const f32x4 gi4 = *(const f32x4*)(gs + 16 * ti + 4 * lq), bi4 = *(const f32x4*)(bs + 16 * ti + 4 * lq), ri4 = *(const f32x4*)(rnk + 16 * ti + 4 * lq);
#pragma unroll
            for (int r = 0; r < 4; ++r) { const int i = 16 * ti + 4 * lq + r; Tm[i * TS_ + j] = (i > j) ? c[r] * bi4[r] * ri4[r] * rj * __expf(gi4[r] - gj) : 0.f; }
        };
        auto z_tile = [&](int ti, int tj) {
#pragma unroll
            for (int r = 0; r < 4; ++r) Tm[(16 * ti + 4 * lq + r) * TS_ + 16 * tj + li] = 0.f; };
        if (wq == 0) { a_tile(0, 0); a_tile(3, 3); a_tile(3, 0); z_tile(0, 1); }
        else if (wq == 1) { a_tile(1, 1); a_tile(1, 0); a_tile(3, 1); z_tile(0, 2); }
        else if (wq == 2) { a_tile(2, 2); a_tile(2, 0); a_tile(3, 2); z_tile(0, 3); }
        else { a_tile(2, 1); z_tile(1, 2); z_tile(1, 3); z_tile(2, 3); }
    }
    __syncthreads();
    if (wq == half) {
        {   int cc = li; OPAQUE(cc);
            float* Ab = Tm + (16 * lq) * TS_ + 16 * lq;
            float x[16];
#pragma unroll
            for (int r = 0; r < 16; ++r) {
                float a0 = (r == cc) ? 1.f : 0.f, a1 = 0.f;
#pragma unroll
                for (int j4 = 0; j4 < (r + 3) / 4; ++j4) { const f32x4 a = *(const f32x4*)(Ab + r * TS_ + 4 * j4);
                    if (4 * j4 + 0 < r) a0 -= a.x * x[4 * j4 + 0];
                    if (4 * j4 + 1 < r) a1 -= a.y * x[4 * j4 + 1];
                    if (4 * j4 + 2 < r) a0 -= a.z * x[4 * j4 + 2];
                    if (4 * j4 + 3 < r) a1 -= a.w * x[4 * j4 + 3]; }
                x[r] = a0 + a1;
            }
            WAVE_SYNC();
#pragma unroll
            for (int r = 0; r < 16; ++r) Ab[r * TS_ + li] = x[r];
        }
        WAVE_SYNC();
#pragma unroll
        for (int i = 1; i < 4; ++i) {
            f32x4 Xr[3];
#pragma unroll
            for (int j = 0; j < 3; ++j) { if (j < i) {
                f32x4 M = {0.f, 0.f, 0.f, 0.f};
#pragma unroll
                for (int k = 0; k < 3; ++k) { if (k >= j && k < i) {
#pragma unroll
                    for (int ks = 0; ks < 4; ++ks) M = mfma4(Tm[(16 * i + li) * TS_ + 16 * k + 4 * ks + lq], Tm[(16 * k + 4 * ks + lq) * TS_ + 16 * j + li], M); } }
                f32x4 X = {0.f, 0.f, 0.f, 0.f};
#pragma unroll
                for (int r = 0; r < 4; ++r) X = mfma4(Tm[(16 * i + li) * TS_ + 16 * i + 4 * lq + r], M[r], X);
                Xr[j] = X; } }
            WAVE_SYNC();
#pragma unroll
            for (int j = 0; j < 3; ++j) { if (j < i) {
#pragma unroll
                for (int r = 0; r < 4; ++r) Tm[(16 * i + 4 * lq + r) * TS_ + 16 * j + li] = -Xr[j][r]; } }
            WAVE_SYNC();
        }
    }
    __syncthreads();
}

DEV void gdn_a_task(Frame& F, int l, int task, const GdnPre& pre, int ntask, GdnPre& nxt) {
    const int chunk = task >> 2, head = task & 3;
    gdn_dma_wait();
    gdn_front<false>(F, l, chunk, head, pre, ntask, nxt);
    if ((F.wave & 3) == 3) {
        const int li_ = F.lane & 15, lq_ = F.lane >> 4; const float* Tm_ = (const float*)g_tm(F.lds, F.wave >> 2); bf16x8* TF = gdn_tf(F, task, F.wave >> 2);
#pragma unroll
        for (int tc = 0; tc < 4; ++tc) { const float* tp = Tm_ + (16 * tc + li_) * TS_ + 4 * lq_; const int j0 = tc < 2 ? tc : 2 * tc - 2;
            TF[j0 * 64 + F.lane] = pack8(*(const f32x4*)tp, *(const f32x4*)(tp + 16));
            if (tc >= 2) TF[(j0 + 1) * 64 + F.lane] = pack8(*(const f32x4*)(tp + 32), *(const f32x4*)(tp + 48)); }
    }
    const int lane = F.lane, li = lane & 15, lq = lane >> 4, half = F.wave >> 2, tj = F.wave & 3, dir = half;
    const float* Tm = (const float*)g_tm(F.lds, half);
    unsigned char* hb = g_half(F.lds, half);
    const bf16* kT = (const bf16*)(hb + GOFF(G_KT)); const bf16* vT = (const bf16*)(hb + GOFF(G_VT));
    const float* vec = (const float*)(hb + GOFF(G_VEC)); const float* gs = vec; const float* bs = vec + 64; const float* sc1 = vec + 256; const float* scd = vec + 320;
    f32x4 w[4], u[4];
#pragma unroll
    for (int tc = 0; tc < 4; ++tc) { w[tc] = (f32x4){0.f, 0.f, 0.f, 0.f}; u[tc] = w[tc];
#pragma unroll
        for (int ks = 0; ks < 2; ++ks) { if (32 * ks <= 16 * tc + 15) {
            const float* tp = Tm + (16 * tc + li) * TS_ + 32 * ks + 8 * lq;
            const f32x4 t0 = *(const f32x4*)tp, t1 = *(const f32x4*)(tp + 4);
            const f32x4 s0 = *(const f32x4*)(sc1 + 32 * ks + 8 * lq), s1 = *(const f32x4*)(sc1 + 32 * ks + 8 * lq + 4);
            const f32x4 b0 = *(const f32x4*)(bs + 32 * ks + 8 * lq), b1 = *(const f32x4*)(bs + 32 * ks + 8 * lq + 4);
            w[tc] = bmma(pack8(t0 * s0, t1 * s1), ld8(kT + (16 * tj + li) * GP + 32 * ks + 8 * lq), w[tc]);
            u[tc] = bmma(pack8(t0 * b0, t1 * b1), ld8(vT + (16 * tj + li) * GP + 32 * ks + 8 * lq), u[tc]); } }
         }
#pragma unroll
    for (int tc = 0; tc < 4; ++tc) { const f32x4 sd = *(const f32x4*)(scd + 16 * tc + 4 * lq); w[tc] = w[tc] * sd; u[tc] = u[tc] * sd; }
    const bf16x8 wb0 = pack8(w[0], w[1]), wb1 = pack8(w[2], w[3]), ub0 = pack8(u[0], u[1]), ub1 = pack8(u[2], u[3]);
    const float egl = __expf(gs[63]);
    const size_t cell = ((size_t)chunk * 4 + head) * 2 + dir;
    float* Mb = (float*)(F.ws + WS_MB) + cell * 4096; float* Bb = (float*)(F.ws + WS_BS) + cell * 4096;
#pragma unroll
    for (int tk = 0; tk < 4; ++tk) {
        const bf16* kp = kT + (16 * tk + li) * GP + 4 * lq;
        const bf16x8 a0 = ld44(kp, kp + 16), a1 = ld44(kp + 32, kp + 48);
        f32x4 m = {0.f, 0.f, 0.f, 0.f}, bm = m;
        m = bmma(a0, wb0, m); m = bmma(a1, wb1, m); bm = bmma(a0, ub0, bm); bm = bmma(a1, ub1, bm);
#pragma unroll
        for (int r = 0; r < 4; ++r) { const int dk = 16 * tk + 4 * lq + r, dk2 = 16 * tj + li; Mb[dk * 64 + dk2] = (dk == dk2 ? egl : 0.f) - m[r]; }
        *(f32x4*)(Bb + ((tj * 4 + tk) * 64 + lane) * 4) = bm;

    }
    __syncthreads();
}
constexpr int N_GDN_TASKS = (T / 64) * 4;

DEV void gdn_b_wave(Frame& F, int l, int task) {
    const int lane = F.lane, li = lane & 15, lq = lane >> 4;
    const int tj = task & 3; int q = task >> 2; const int dir = q & 1; q >>= 1; const int head = q & 3; q >>= 2;
    const int seq = q < DB ? NB + q : q - DB;
    const bool ctx = seq < NB; const int L = ctx ? SEQ : DSEQ, nch = L / 64, tseq = ctx ? seq * SEQ : TC + (seq - NB) * DSEQ;
    f32x4 S[4];
    if (ctx) {
#pragma unroll
        for (int ti = 0; ti < 4; ++ti) S[ti] = (f32x4){0.f, 0.f, 0.f, 0.f};
    } else {
        const float* s0 = F.P->in[6] + ((((size_t)(seq - NB) * DEPTH + l) * 2 + dir) * 4 + head) * 4096;
#pragma unroll
        for (int ti = 0; ti < 4; ++ti)
#pragma unroll
            for (int r = 0; r < 4; ++r) S[ti][r] = NT_LD(s0 + (16 * ti + 4 * lq + r) * 64 + 16 * tj + li);
    }
    f32x4 mf[4][4], bm[4];
    auto cell_of = [&](int n) { const int c = dir ? nch - 1 - n : n; return ((size_t)(tseq / 64 + c) * 4 + head) * 2 + dir; };
    auto load_step = [&](int n, f32x4 (&m)[4][4], f32x4 (&b)[4]) { const size_t cell = cell_of(n);
        const float* Mb = (const float*)(F.ws + WS_MB) + cell * 4096; const float* Bb = (const float*)(F.ws + WS_BS) + cell * 4096;
#pragma unroll
        for (int ti = 0; ti < 4; ++ti) { b[ti] = *(const f32x4*)(Bb + ((tj * 4 + ti) * 64 + lane) * 4);
#pragma unroll
            for (int kb = 0; kb < 4; ++kb) m[ti][kb] = *(const f32x4*)(Mb + (16 * ti + li) * 64 + 16 * kb + 4 * lq); } };
    load_step(0, mf, bm);
    for (int n = 0; n < nch; ++n) {
        f32x4 mfn[4][4], bmn[4];
        if (n + 1 < nch) load_step(n + 1, mfn, bmn);
        float* Bb = (float*)(F.ws + WS_BS) + cell_of(n) * 4096;
        f32x4 nS[4];
#pragma unroll
        for (int ti = 0; ti < 4; ++ti) { nS[ti] = bm[ti]; *(f32x4*)(Bb + ((tj * 4 + ti) * 64 + lane) * 4) = S[ti]; }
#pragma unroll
        for (int kb = 0; kb < 4; ++kb)
#pragma unroll
            for (int r = 0; r < 4; ++r)
#pragma unroll
                for (int ti = 0; ti < 4; ++ti) nS[ti] = mfma4(mf[ti][kb][r], S[kb][r], nS[ti]);
#pragma unroll
        for (int ti = 0; ti < 4; ++ti) { S[ti] = nS[ti]; bm[ti] = bmn[ti];
#pragma unroll
            for (int kb = 0; kb < 4; ++kb) mf[ti][kb] = mfn[ti][kb]; }
    }
    if (ctx) { float* dst = F.out + O_SG + ((((size_t)seq * DEPTH + l) * 2 + dir) * 4 + head) * 4096;
#pragma unroll
        for (int ti = 0; ti < 4; ++ti)
#pragma unroll
            for (int r = 0; r < 4; ++r) NT_ST(dst + (16 * ti + 4 * lq + r) * 64 + 16 * tj + li, S[ti][r]); }
}
constexpr int N_GDNB_TASKS = NSEQ * 32;

template <bool DRY = false>
DEV void gdn_c_task(Frame& F, int l, int task, const GdnPre& pre, int ntask, GdnPre& nxt) {
    const int chunk = task >> 2, head = task & 3;
    const int tid = F.tid, lane = F.lane, li = lane & 15, lq = lane >> 4, half = F.wave >> 2, tj = F.wave & 3, dir = half;
    unsigned char* hb = g_half(F.lds, half);
    gdn_dma_wait();
    f32x4 sn[4]; u32x2 zc0, zc1;
    { const size_t cell = ((size_t)chunk * 4 + head) * 2 + half; const float* Sb = (const float*)(F.ws + WS_BS) + cell * 4096; const int ht = tid & 255;
#pragma unroll
      for (int e = 0; e < 4; ++e) sn[e] = *(const f32x4*)(Sb + (size_t)(ht + 256 * e) * 4);
      const bf16* zb = (const bf16*)(F.ws + WS_BR) + (size_t)(chunk * 64 + 8 * F.wave + (lane >> 4)) * 1024 + 256 + head * 64 + 4 * (lane & 15);
      zc0 = *(const u32x2*)zb; zc1 = *(const u32x2*)(zb + 4 * 1024); }
    const f32x4 gg = *(const f32x4*)(F.P->in[17] + l * 64 + 4 * li);
    bf16x8 tf[6];
    { const bf16x8* TF = gdn_tf(F, task, half);
#pragma unroll
      for (int j = 0; j < 6; ++j) tf[j] = TF[j * 64 + lane]; }
    gdn_front<true, true>(F, l, chunk, head, pre, ntask, nxt);
    {
        bf16* sT = (bf16*)(hb + GOFF(G_ST));
        const int ht = tid & 255;
#pragma unroll
        for (int e = 0; e < 4; ++e) { const int idx = ht + 256 * e;
            const f32x4 v = sn[e]; const int ln = idx & 63, ti2 = (idx >> 6) & 3, tj2 = idx >> 8;
            const int dv = 16 * tj2 + (ln & 15), dk = 16 * ti2 + 4 * (ln >> 4);
            u32x2 w; w.x = pk2(v.x, v.y); w.y = pk2(v.z, v.w); *(u32x2*)(sT + dv * GP + dk) = w; }
    }
    __syncthreads();
    float* Tm = (float*)g_tm(F.lds, half);
    const bf16* kr = (const bf16*)(hb + GOFF(G_KR)); const bf16* qr = (const bf16*)(hb + GOFF(G_QR)); const bf16* vT = (const bf16*)(hb + GOFF(G_VT)); const bf16* sT = (const bf16*)(hb + GOFF(G_ST));
    const float* vec = (const float*)(hb + GOFF(G_VEC)); const float* gs = vec; const float* bs = vec + 64; const float* rnk = vec + 128; const float* rnq = vec + 192;
    f32x4 X[4];
#pragma unroll
    for (int tc = 0; tc < 4; ++tc) { f32x4 a = {0.f, 0.f, 0.f, 0.f};
#pragma unroll
        for (int ks = 0; ks < 2; ++ks) a = bmma(ld8(kr + (16 * tc + li) * GP + 32 * ks + 8 * lq), ld8(sT + (16 * tj + li) * GP + 32 * ks + 8 * lq), a);
        const u32x2 vv = *(const u32x2*)(vT + (16 * tj + li) * GP + 16 * tc + 4 * lq);
        const f32x4 vf = {bf2f(vv.x & 0xffffu), bf2f(vv.x >> 16), bf2f(vv.y & 0xffffu), bf2f(vv.y >> 16)};
        const f32x4 g4 = *(const f32x4*)(gs + 16 * tc + 4 * lq), b4 = *(const f32x4*)(bs + 16 * tc + 4 * lq), r4 = *(const f32x4*)(rnk + 16 * tc + 4 * lq);
#pragma unroll
        for (int r = 0; r < 4; ++r) X[tc][r] = b4[r] * (vf[r] - __expf(g4[r]) * r4[r] * a[r]); }

    f32x4 vn[4];
    { const bf16x8 xb0 = pack8(X[0], X[1]), xb1 = pack8(X[2], X[3]);
#pragma unroll
      for (int tc = 0; tc < 4; ++tc) { const int j0 = tc < 2 ? tc : 2 * tc - 2; f32x4 a = {0.f, 0.f, 0.f, 0.f};
          a = bmma(tf[j0], xb0, a);
          if (tc >= 2) a = bmma(tf[j0 + 1], xb1, a);
          vn[tc] = a; } }
    const bf16x8 vb0 = pack8(vn[0], vn[1]), vb1 = pack8(vn[2], vn[3]);

    f32x4 o[4];
#pragma unroll
    for (int ti = 0; ti < 4; ++ti) { f32x4 a = {0.f, 0.f, 0.f, 0.f};
#pragma unroll
        for (int ks = 0; ks < 2; ++ks) a = bmma(ld8(qr + (16 * ti + li) * GP + 32 * ks + 8 * lq), ld8(sT + (16 * tj + li) * GP + 32 * ks + 8 * lq), a);
        const f32x4 g4 = *(const f32x4*)(gs + 16 * ti + 4 * lq), q4 = *(const f32x4*)(rnq + 16 * ti + 4 * lq);
#pragma unroll
        for (int r = 0; r < 4; ++r) a[r] *= q4[r] * __expf(g4[r]);
        o[ti] = a; }
    {
        bf16* QKL = (bf16*)g_tm(F.lds, half);
        auto qk_tile = [&](int ti, int tc) {
            f32x4 a = {0.f, 0.f, 0.f, 0.f};
#pragma unroll
            for (int ks = 0; ks < 2; ++ks) a = bmma(ld8(kr + (16 * tc + li) * GP + 32 * ks + 8 * lq), ld8(qr + (16 * ti + li) * GP + 32 * ks + 8 * lq), a);
            const int i = 16 * ti + li; const float gi = gs[i], rqi = rnq[i];
            const f32x4 gc = *(const f32x4*)(gs + 16 * tc + 4 * lq), rc = *(const f32x4*)(rnk + 16 * tc + 4 * lq);
#pragma unroll
            for (int r = 0; r < 4; ++r) { const int c = 16 * tc + 4 * lq + r; a[r] = (i >= c) ? a[r] * rc[r] * rqi * __expf(gi - gc[r]) : 0.f; }
            u32x2 w; w.x = pk2(a.x, a.y); w.y = pk2(a.z, a.w); *(u32x2*)(QKL + i * GP + 16 * tc + 4 * lq) = w; };
        if (tj == 0) { qk_tile(3, 0); qk_tile(3, 3); qk_tile(0, 0); }
        else if (tj == 1) { qk_tile(3, 1); qk_tile(1, 1); qk_tile(1, 0); }
        else if (tj == 2) { qk_tile(3, 2); qk_tile(2, 2); }
        else { qk_tile(2, 0); qk_tile(2, 1); }
        __syncthreads();
#pragma unroll
        for (int ti = 0; ti < 4; ++ti) { const bf16* rp = QKL + (16 * ti + li) * GP + 4 * lq;
            const u32x2 q0 = *(const u32x2*)rp, q1 = ti >= 1 ? *(const u32x2*)(rp + 16) : (u32x2){0u, 0u};
            u32x4 f0; f0.x = q0.x; f0.y = q0.y; f0.z = q1.x; f0.w = q1.y;
            o[ti] = bmma(__builtin_bit_cast(bf16x8, f0), vb0, o[ti]);
            if (ti >= 2) { const u32x2 q2 = *(const u32x2*)(rp + 32), q3 = ti >= 3 ? *(const u32x2*)(rp + 48) : (u32x2){0u, 0u};
                u32x4 f1; f1.x = q2.x; f1.y = q2.y; f1.z = q3.x; f1.w = q3.y;
                o[ti] = bmma(__builtin_bit_cast(bf16x8, f1), vb1, o[ti]); } }
    }
    __syncthreads();
#pragma unroll
    for (int ti = 0; ti < 4; ++ti)
#pragma unroll
        for (int r = 0; r < 4; ++r) { const int i = 16 * ti + 4 * lq + r; Tm[(dir ? 63 - i : i) * TS_ + 16 * tj + li] = o[ti][r]; }
    __syncthreads();
    {
        const float* O0 = (const float*)g_tm(F.lds, 0); const float* O1 = (const float*)g_tm(F.lds, 1);
#pragma unroll
        for (int it = 0; it < 2; ++it) { const int pos = 8 * F.wave + 4 * it + lq;
            const f32x4 a = *(const f32x4*)(O0 + pos * TS_ + 4 * li) + *(const f32x4*)(O1 + pos * TS_ + 4 * li);
            float ss = (a.x * a.x + a.y * a.y) + (a.z * a.z + a.w * a.w);
            ss += shx(ss, 1, lane); ss += shx(ss, 2, lane); ss += shx(ss, 4, lane); ss += shx(ss, 8, lane);
            const float rstd = 1.0f / sqrtf(ss * (1.0f / 64.0f) + EPS);
            bf16* z = (bf16*)(F.ws + WS_BR) + (size_t)(chunk * 64 + pos) * 1024 + 256 + head * 64 + 4 * li; const u32x2 zz = it == 0 ? zc0 : zc1;
            u32x2 wv; wv.x = pk2(a.x * rstd * gg.x * bf2f(zz.x & 0xffffu), a.y * rstd * gg.y * bf2f(zz.x >> 16)); wv.y = pk2(a.z * rstd * gg.z * bf2f(zz.y & 0xffffu), a.w * rstd * gg.w * bf2f(zz.y >> 16));
            if (DRY) *(volatile u32x2*)(F.lds + 143360 + lane * 8) = wv; else *(u32x2*)z = wv; }
    }
    __syncthreads();
}

constexpr int AT_BUF = 36864;
constexpr int AT_VP = 136;
struct AtSrc { const bf16* k; const bf16* vt; int kstr, vld, nst; };
struct AtState { f32x4 o[4]; float m, l; };

DEV float ret_lg2(int dir, int head) { const float uu = exp2f(-((dir ? 5.5f : 5.0f) + (float)head)); const float ln = -uu * (1.f + uu * (0.5f + uu * (1.f / 3.f + uu * (0.25f + uu * (0.2f + uu * (1.f / 6.f)))))); return ln * 1.4426950408889634f; }

DEV void sm_update(AtState& S, f32x4 (&st)[2], const bf16x8 (&vf)[4], int lane) {
    float mb = fmaxf(fmaxf(fmaxf(st[0].x, st[0].y), fmaxf(st[0].z, st[0].w)), fmaxf(fmaxf(st[1].x, st[1].y), fmaxf(st[1].z, st[1].w)));
    if (__any(mb > 8.0f)) {
        mb = fmaxf(mb, shx(mb, 16, lane)); mb = fmaxf(mb, shx(mb, 32, lane));
        const float dm = fmaxf(mb, 0.f), alpha = __builtin_amdgcn_exp2f(-dm);
        S.m += dm; S.l *= alpha;
#pragma unroll
        for (int dt = 0; dt < 4; ++dt) S.o[dt] = S.o[dt] * alpha;
#pragma unroll
        for (int kt = 0; kt < 2; ++kt) st[kt] = st[kt] - dm;
    }
    float ps = 0.f; float pv[8];
#pragma unroll
    for (int kt = 0; kt < 2; ++kt)
#pragma unroll
        for (int r = 0; r < 4; ++r) { const float p = __builtin_amdgcn_exp2f(st[kt][r]); pv[kt * 4 + r] = p; ps += p; }
    S.l += ps;
    u32x4 pu; pu.x = pk2(pv[0], pv[1]); pu.y = pk2(pv[2], pv[3]); pu.z = pk2(pv[4], pv[5]); pu.w = pk2(pv[6], pv[7]);
    const bf16x8 pf = __builtin_bit_cast(bf16x8, pu);
    __builtin_amdgcn_s_setprio(1);
#pragma unroll
    for (int dt = 0; dt < 4; ++dt) S.o[dt] = __builtin_amdgcn_mfma_f32_16x16x32_bf16(vf[dt], pf, S.o[dt], 0, 0, 0);
    __builtin_amdgcn_s_setprio(0);
}

template <int MODE>
DEV void at_stream(Frame& F, const bf16x8 (&qf)[2][2], const AtSrc& A, const AtSrc& B, AtState (&S)[2], int tq0, float lf2, float lb2) {
    const int tid = F.tid, lane = F.lane, li = lane & 15, lq = lane >> 4;
    const int ns = A.nst + B.nst;
    const int srow = tid >> 3, sch = (tid & 7) * 8;
    const int vrow = tid >> 4, vch = (tid & 15) * 8;
    struct StageRegs { u32x4 k0, k1, v0, v1; };
    StageRegs kra, krb; u32x4 vra, vrb;
    auto gload = [&](int st, StageRegs& R, u32x4&) { const bool a = st < A.nst; const bf16* kp = a ? A.k : B.k; const bf16* vp = a ? A.vt : B.vt; const int ks = a ? A.kstr : B.kstr, vl = a ? A.vld : B.vld, s2 = a ? st : st - A.nst;
        R.k0 = *(const u32x4*)(kp + (size_t)(s2 * 128 + srow) * ks + sch); R.k1 = *(const u32x4*)(kp + (size_t)(s2 * 128 + 64 + srow) * ks + sch);
        R.v0 = *(const u32x4*)(vp + (size_t)vrow * vl + s2 * 128 + vch); R.v1 = *(const u32x4*)(vp + (size_t)(vrow + 32) * vl + s2 * 128 + vch); };
    auto lstore = [&](int buf, const StageRegs& R, const u32x4&) { unsigned char* b = F.lds + buf * AT_BUF;
        *(u32x4*)(b + (srow * 72 + sch) * 2) = R.k0; *(u32x4*)(b + ((srow + 64) * 72 + sch) * 2) = R.k1;
        *(u32x4*)(b + 18432 + (vrow * AT_VP + vch) * 2) = R.v0; *(u32x4*)(b + 18432 + ((vrow + 32) * AT_VP + vch) * 2) = R.v1; };
    float cf[8], cb[8]; int q0w = 0;
    if (MODE == 1) {
#pragma unroll
        for (int e = 0; e < 8; ++e) { const float j = (float)(8 * lq + e); cf[e] = __builtin_amdgcn_exp2f(-lf2 * j); cb[e] = __builtin_amdgcn_exp2f(lb2 * j); }
        q0w = __builtin_amdgcn_readfirstlane(tq0 - li);
    }
    gload(0, kra, vra); if (ns > 1) gload(1, krb, vrb);
    lstore(0, kra, vra);
    __syncthreads();
    for (int st = 0; st < ns; ++st) {
        if (st + 2 < ns) gload(st + 2, kra, vra);
        const bf16* kl = (const bf16*)(F.lds + (st & 1) * AT_BUF); const bf16* vl = kl + 9216;
#pragma unroll 1
        for (int sub = 0; sub < 4; ++sub) {
            bf16x8 kf[2][2];
#pragma unroll
            for (int kt = 0; kt < 2; ++kt)
#pragma unroll
                for (int ks = 0; ks < 2; ++ks) kf[kt][ks] = *(const bf16x8*)(kl + (32 * sub + 8 * (li >> 2) + 4 * kt + (li & 3)) * 72 + 32 * ks + 8 * lq);
            bf16x8 vf[4];
#pragma unroll
            for (int dt = 0; dt < 4; ++dt) vf[dt] = *(const bf16x8*)(vl + (16 * dt + li) * AT_VP + 32 * sub + 8 * lq);
#pragma unroll
            for (int ti = 0; ti < 2; ++ti) {
                f32x4 sc[2];
                __builtin_amdgcn_s_setprio(1);
#pragma unroll
                for (int kt = 0; kt < 2; ++kt) { sc[kt] = (f32x4){0.f, 0.f, 0.f, 0.f};
#pragma unroll
                    for (int ks = 0; ks < 2; ++ks) sc[kt] = __builtin_amdgcn_mfma_f32_16x16x32_bf16(kf[kt][ks], qf[ti][ks], sc[kt], 0, 0, 0); }
                __builtin_amdgcn_s_setprio(0);
                if (MODE == 0) { sc[0] = sc[0] - S[ti].m; sc[1] = sc[1] - S[ti].m; sm_update(S[ti], sc, vf, lane); }
                else {
                    const int tq = tq0 + 16 * ti, kb0 = st * 128 + sub * 32, qt0 = q0w + 16 * ti;
                    float pv[8];
                    if (kb0 + 31 < qt0) {
                        const float a = __builtin_amdgcn_exp2f(lf2 * (float)(tq - kb0));
#pragma unroll
                        for (int e = 0; e < 8; ++e) pv[e] = sc[e >> 2][e & 3] * cf[e] * a;
                    } else if (kb0 > qt0 + 15) {
                        const float a = __builtin_amdgcn_exp2f(lb2 * (float)(kb0 - tq));
#pragma unroll
                        for (int e = 0; e < 8; ++e) pv[e] = sc[e >> 2][e & 3] * cb[e] * a;
                    } else {
#pragma unroll
                    for (int kt = 0; kt < 2; ++kt)
#pragma unroll
                        for (int r = 0; r < 4; ++r) { const int d = tq - (kb0 + 8 * lq + 4 * kt + r); const float fd = (float)d;
                            const float wf = d >= 0 ? exp2f(lf2 * fd) : 0.f, wb = d <= 0 ? exp2f(-lb2 * fd) : 0.f;
                            pv[kt * 4 + r] = sc[kt][r] * (wf + wb); }
                    }
                    u32x4 pu; pu.x = pk2(pv[0], pv[1]); pu.y = pk2(pv[2], pv[3]); pu.z = pk2(pv[4], pv[5]); pu.w = pk2(pv[6], pv[7]);
                    const bf16x8 pf = __builtin_bit_cast(bf16x8, pu);
                    __builtin_amdgcn_s_setprio(1);
#pragma unroll
                    for (int dt = 0; dt < 4; ++dt) S[ti].o[dt] = __builtin_amdgcn_mfma_f32_16x16x32_bf16(vf[dt], pf, S[ti].o[dt], 0, 0, 0);
                    __builtin_amdgcn_s_setprio(0);
                }
            }
        }
        if (st + 1 < ns) lstore((st + 1) & 1, krb, vrb);
        __syncthreads();
        krb = kra; vrb = vra;
    }
}

template <bool DRY = false>
DEV void at_finish_softmax_(AtState& S, bf16* gate_io, int lane, unsigned char* g_dry = nullptr) {
    const int lq = lane >> 4;
    float lsum = S.l; lsum += shx(lsum, 16, lane); lsum += shx(lsum, 32, lane);
    const float inv = 1.0f / lsum;
#pragma unroll
    for (int dt = 0; dt < 4; ++dt) { bf16* gp = gate_io + 16 * dt + 4 * lq; const u32x2 g = *(const u32x2*)gp;
        const float r0 = S.o[dt].x * inv * bf2f(g.x & 0xffffu), r1 = S.o[dt].y * inv * bf2f(g.x >> 16), r2 = S.o[dt].z * inv * bf2f(g.y & 0xffffu), r3 = S.o[dt].w * inv * bf2f(g.y >> 16);
        u32x2 w; w.x = pk2(r0, r1); w.y = pk2(r2, r3); if (DRY) *(volatile u32x2*)(g_dry + (lane & 63) * 8) = w; else *(u32x2*)gp = w; }
}
#define at_finish_softmax(S_, g_, l_) at_finish_softmax_<DRY>(S_, g_, l_, F.lds + 143360)

constexpr int N_AT_UNITS = 3 * DB * 16 + 3 * NB * 4;
template <bool DRY = false>
DEV void at_unit(Frame& F, int l, int u, unsigned* qctr = nullptr, unsigned* nx = nullptr) {
    const int lane = F.lane, li = lane & 15, lq = lane >> 4, w = F.wave;
    int kind;
    if (u < DB * 16) kind = 0; else if (u < 2 * DB * 16) { kind = 1; u -= DB * 16; } else if (u < 3 * DB * 16) { kind = 2; u -= 2 * DB * 16; }
    else { u -= 3 * DB * 16; kind = 3 + u / (NB * 4); u %= NB * 4; }
    const bool ctx = kind >= 3;
    const int b = ctx ? u / 4 : u / 16, h = ctx ? u % 4 : (u % 16) / 4, qb = ctx ? 0 : u % 4;
    const int L = ctx ? SEQ : DSEQ, tseq = ctx ? b * SEQ : TC + b * DSEQ;
    const int q0 = qb * 256 + w * 32;
    AtSrc A, B; B.k = nullptr; B.vt = nullptr; B.kstr = 64; B.vld = 64; B.nst = 0;
    AtState S[2];
#pragma unroll
    for (int ti = 0; ti < 2; ++ti) {
#pragma unroll
        for (int dt = 0; dt < 4; ++dt) S[ti].o[dt] = (f32x4){0.f, 0.f, 0.f, 0.f};
        S[ti].m = -1024.0f; S[ti].l = 0.f; }
    bf16x8 qf[2][2];
    auto load_q = [&](const bf16* qbase, int rowstride, int coloff) {
#pragma unroll
        for (int ti = 0; ti < 2; ++ti) { const bf16* q = qbase + (size_t)(tseq + q0 + 16 * ti + li) * rowstride + coloff + h * 64;
            qf[ti][0] = *(const bf16x8*)(q + 8 * lq); qf[ti][1] = *(const bf16x8*)(q + 32 + 8 * lq); } };
    if (kind == 0 || kind == 3) {
        const int kvh = h >> 1;
        load_q((const bf16*)(F.ws + WS_QA), 256, 0);
        A.k = (const bf16*)(F.ws + WS_KA) + (ctx ? (size_t)0 : (size_t)TC * 128) + ((size_t)b * 2 + kvh) * L * 64; A.vt = (const bf16*)(F.ws + WS_VAT) + (ctx ? (size_t)0 : (size_t)TC * 128) + ((size_t)b * 2 + kvh) * 64 * L;
        A.kstr = 64; A.vld = L; A.nst = L / 128;
        if (!ctx) { B.k = (const bf16*)(F.ws + WS_KAC) + (((size_t)l * DB + b) * 2 + kvh) * PAST * 64; B.vt = (const bf16*)(F.ws + WS_VACT) + (((size_t)l * DB + b) * 2 + kvh) * 64 * PAST; B.kstr = 64; B.vld = PAST; B.nst = PAST / 128; }
        at_stream<0>(F, qf, A, B, S, 0, 0.f, 0.f);
        if (nx && F.tid == 0) *nx = atomicAdd(qctr, 1u);
#pragma unroll
        for (int ti = 0; ti < 2; ++ti) at_finish_softmax(S[ti], (bf16*)(F.ws + WS_BR) + (size_t)(tseq + q0 + 16 * ti + li) * 1024 + h * 64, lane);
    } else if (kind == 4) {
        load_q((const bf16*)(F.ws + WS_NQ), 256, 0);
        A.k = (const bf16*)(F.ws + WS_NK) + ((size_t)b * 4 + h) * SEQ * 64; A.vt = (const bf16*)(F.ws + WS_NVT) + ((size_t)b * 4 + h) * 64 * SEQ; A.kstr = 64; A.vld = SEQ; A.nst = SEQ / 128;
        at_stream<0>(F, qf, A, B, S, 0, 0.f, 0.f);
        if (nx && F.tid == 0) *nx = atomicAdd(qctr, 1u);
#pragma unroll
        for (int ti = 0; ti < 2; ++ti) at_finish_softmax(S[ti], (bf16*)(F.ws + WS_BR) + (size_t)(tseq + q0 + 16 * ti + li) * 1024 + 768 + h * 64, lane);
    } else if (kind == 2) {
        load_q((const bf16*)(F.ws + WS_NQ), 256, 0);
        const int r = q0 >> 6;
        const int rs = r - 4 < 0 ? 0 : (r - 4 > 8 ? 8 : r - 4);
        float* bias = (float*)(F.lds + 2 * AT_BUF);
        { const float* bsrc = F.P->in[21] + ((size_t)l * 4 + h) * 15 * 31; if (F.tid < 465) bias[F.tid] = bsrc[F.tid] * 1.4426950408889634f; }
        __syncthreads();
#pragma unroll
        for (int ti = 0; ti < 2; ++ti) {
            const int jb = ((q0 & 63) >> 4) + ti; const int bs = jb * 16 - 8 < 0 ? 0 : (jb * 16 - 8 > 32 ? 32 : jb * 16 - 8);
            const int tok0 = rs * 64 + bs;
            const bf16* kA = (const bf16*)(F.ws + WS_NK) + (size_t)TC * 256 + (((size_t)b * 4 + h) * DSEQ + tok0) * 64;
            const bf16* vA = (const bf16*)(F.ws + WS_NVT) + (size_t)TC * 256 + ((size_t)b * 4 + h) * 64 * DSEQ + tok0;
            const int qc = jb * 16 + li, cs = qc - 8 < 0 ? 0 : (qc - 8 > 48 ? 48 : qc - 8);
            auto load_blk = [&](int blk, bf16x8 (&kf)[2][2], bf16x8 (&vf)[4]) {
                const bf16* kb = kA + (size_t)blk * 4096; const bf16* vb = vA + (size_t)blk * 64;
#pragma unroll
                for (int kt = 0; kt < 2; ++kt)
#pragma unroll
                    for (int ks = 0; ks < 2; ++ks) kf[kt][ks] = *(const bf16x8*)(kb + (size_t)(8 * (li >> 2) + 4 * kt + (li & 3)) * 64 + 32 * ks + 8 * lq);
#pragma unroll
                for (int dt = 0; dt < 4; ++dt) vf[dt] = *(const bf16x8*)(vb + (size_t)(16 * dt + li) * DSEQ + 8 * lq); };
            bf16x8 kc[2][2], vc[4];
            load_blk(0, kc, vc);
            for (int blk = 0; blk < 8; ++blk) {
                bf16x8 kn[2][2], vn[4];
                load_blk(blk < 7 ? blk + 1 : 7, kn, vn);
                f32x4 sc[2];
#pragma unroll
                for (int kt = 0; kt < 2; ++kt) { sc[kt] = (f32x4){0.f, 0.f, 0.f, 0.f};
#pragma unroll
                    for (int ks = 0; ks < 2; ++ks) sc[kt] = __builtin_amdgcn_mfma_f32_16x16x32_bf16(kc[kt][ks], qf[ti][ks], sc[kt], 0, 0, 0); }
                const int dr = rs + blk - r + 7;
#pragma unroll
                for (int kt = 0; kt < 2; ++kt)
#pragma unroll
                    for (int rr = 0; rr < 4; ++rr) { const int kc_ = bs + 8 * lq + 4 * kt + rr; int dc = kc_ - qc + 15; dc = dc < 0 ? 0 : (dc > 30 ? 30 : dc);
                        float bv = bias[dr * 31 + dc]; OPAQUE(bv);
                        const bool ok = kc_ >= cs && kc_ < cs + 16;
                        sc[kt][rr] = ok ? sc[kt][rr] + bv : -1e30f; }
                sc[0] = sc[0] - S[ti].m; sc[1] = sc[1] - S[ti].m; sm_update(S[ti], sc, vc, lane);
#pragma unroll
                for (int kt = 0; kt < 2; ++kt)
#pragma unroll
                    for (int ks = 0; ks < 2; ++ks) kc[kt][ks] = kn[kt][ks];
#pragma unroll
                for (int dt = 0; dt < 4; ++dt) vc[dt] = vn[dt];
            }
        }
        __syncthreads();
        A.k = (const bf16*)(F.ws + WS_NKC) + (((size_t)l * DB + b) * 4 + h) * PAST * 64; A.vt = (const bf16*)(F.ws + WS_NVCT) + (((size_t)l * DB + b) * 4 + h) * 64 * PAST; A.kstr = 64; A.vld = PAST; A.nst = PAST / 128;
        at_stream<0>(F, qf, A, B, S, 0, 0.f, 0.f);
        if (nx && F.tid == 0) *nx = atomicAdd(qctr, 1u);
#pragma unroll
        for (int ti = 0; ti < 2; ++ti) at_finish_softmax(S[ti], (bf16*)(F.ws + WS_BR) + (size_t)(tseq + q0 + 16 * ti + li) * 1024 + 768 + h * 64, lane);
    } else {
        const bf16* RQ = (const bf16*)(F.ws + WS_RQKV);
        load_q(RQ, 512, 0);
        const float lf2 = ret_lg2(0, h), lb2 = ret_lg2(1, h);
        if (!ctx) {
#pragma unroll
            for (int dir = 0; dir < 2; ++dir) {
                const bf16* s0t = (const bf16*)(F.ws + WS_S0T) + ((((size_t)(1 * DEPTH + l) * DB + b) * 2 + dir) * 4 + h) * 4096;
#pragma unroll
                for (int dt = 0; dt < 4; ++dt) { const bf16x8 s0f = *(const bf16x8*)(s0t + (size_t)(16 * dt + li) * 64 + 8 * lq), s1f = *(const bf16x8*)(s0t + (size_t)(16 * dt + li) * 64 + 32 + 8 * lq);
#pragma unroll
                    for (int ti = 0; ti < 2; ++ti) { const int tq = q0 + 16 * ti + li; const float sc = dir == 0 ? exp2f(lf2 * (float)(tq + 1)) : exp2f(lb2 * (float)(L - tq));
                        f32x4 a = {0.f, 0.f, 0.f, 0.f};
                        a = __builtin_amdgcn_mfma_f32_16x16x32_bf16(s0f, qf[ti][0], a, 0, 0, 0); a = __builtin_amdgcn_mfma_f32_16x16x32_bf16(s1f, qf[ti][1], a, 0, 0, 0);
                        S[ti].o[dt] = S[ti].o[dt] + a * sc; } }
            }
        }
        A.k = RQ + (size_t)tseq * 512 + 256 + h * 64; A.kstr = 512; A.vt = (const bf16*)(F.ws + WS_RVT) + (ctx ? (size_t)0 : (size_t)TC * 256) + ((size_t)b * 4 + h) * 64 * L; A.vld = L; A.nst = L / 128;
        at_stream<1>(F, qf, A, B, S, q0 + li, lf2, lb2);
        if (nx && F.tid == 0) *nx = atomicAdd(qctr, 1u);
        const float* gn = F.P->in[20] + l * 64;
#pragma unroll
        for (int ti = 0; ti < 2; ++ti) {
            float ss = 0.f;
#pragma unroll
            for (int dt = 0; dt < 4; ++dt) ss += (S[ti].o[dt].x * S[ti].o[dt].x + S[ti].o[dt].y * S[ti].o[dt].y) + (S[ti].o[dt].z * S[ti].o[dt].z + S[ti].o[dt].w * S[ti].o[dt].w);
            ss += shx(ss, 16, lane); ss += shx(ss, 32, lane);
            const float rstd = 1.0f / sqrtf(ss * (1.0f / 64.0f) + EPS);
            bf16* zrow = (bf16*)(F.ws + WS_BR) + (size_t)(tseq + q0 + 16 * ti + li) * 1024 + 512 + h * 64;
#pragma unroll
            for (int dt = 0; dt < 4; ++dt) { bf16* gp = zrow + 16 * dt + 4 * lq; const u32x2 g = *(const u32x2*)gp; const f32x4 gg = *(const f32x4*)(gn + 16 * dt + 4 * lq);
                u32x2 wv; wv.x = pk2(S[ti].o[dt].x * rstd * gg.x * bf2f(g.x & 0xffffu), S[ti].o[dt].y * rstd * gg.y * bf2f(g.x >> 16)); wv.y = pk2(S[ti].o[dt].z * rstd * gg.z * bf2f(g.y & 0xffffu), S[ti].o[dt].w * rstd * gg.w * bf2f(g.y >> 16));
                if (DRY) *(volatile u32x2*)(F.lds + 143360 + lane * 8) = wv; else *(u32x2*)gp = wv; }
        }
    }
}

DEV void ret_state_group(Frame& F, int l, int grp) {
    int wv_ = F.wave;
#ifndef EMU
    asm volatile("" : "+s"(wv_));
#endif
    const int task = grp * 8 + wv_, lane = F.lane, li = lane & 15, lq = lane >> 4;
    const int b = task / 8, h = (task % 8) / 2, dir = task & 1;
    bf16* Kl = (bf16*)F.lds + (size_t)wv_ * (32 * 72);
    const bf16* kbase = (const bf16*)(F.ws + WS_RQKV) + (size_t)(b * SEQ) * 512 + 256 + h * 64;
    const bf16* vbase = (const bf16*)(F.ws + WS_RVT) + ((size_t)b * 4 + h) * 64 * SEQ;
    const float lg2 = ret_lg2(dir, h);
    f32x4 acc[4][4];
#pragma unroll
    for (int a = 0; a < 4; ++a)
#pragma unroll
        for (int c = 0; c < 4; ++c) acc[a][c] = (f32x4){0.f, 0.f, 0.f, 0.f};
    for (int ks = 0; ks < SEQ / 32; ++ks) {
        { const int rr = lane >> 1, hh = (lane & 1) * 32; const bf16* src = kbase + (size_t)(32 * ks + rr) * 512 + hh;
#pragma unroll
          for (int c = 0; c < 4; ++c) *(u32x4*)(Kl + rr * 72 + hh + 8 * c) = *(const u32x4*)(src + 8 * c); }
        WAVE_SYNC();
        float wt[8];
#pragma unroll
        for (int e = 0; e < 8; ++e) { const int t = 32 * ks + 8 * lq + e; wt[e] = exp2f(lg2 * (float)(dir == 0 ? SEQ - 1 - t : t)); }
        bf16x8 bfr[4];
#pragma unroll
        for (int kt = 0; kt < 4; ++kt) { float x[8];
#pragma unroll
            for (int e = 0; e < 8; ++e) x[e] = bf2f(Kl[(8 * lq + e) * 72 + 16 * kt + li]) * wt[e];
            u32x4 pu; pu.x = pk2(x[0], x[1]); pu.y = pk2(x[2], x[3]); pu.z = pk2(x[4], x[5]); pu.w = pk2(x[6], x[7]); bfr[kt] = __builtin_bit_cast(bf16x8, pu); }
#pragma unroll
        for (int vt = 0; vt < 4; ++vt) { const bf16x8 af = *(const bf16x8*)(vbase + (size_t)(16 * vt + li) * SEQ + 32 * ks + 8 * lq);
#pragma unroll
            for (int kt = 0; kt < 4; ++kt) acc[vt][kt] = __builtin_amdgcn_mfma_f32_16x16x32_bf16(af, bfr[kt], acc[vt][kt], 0, 0, 0); }
        WAVE_SYNC();
    }
    float* dst = F.out + O_SR + ((((size_t)b * DEPTH + l) * 2 + dir) * 4 + h) * 4096;
#pragma unroll
    for (int vt = 0; vt < 4; ++vt)
#pragma unroll
        for (int kt = 0; kt < 4; ++kt) NT_ST((f32x4*)(dst + (16 * kt + li) * 64 + 16 * vt + 4 * lq), acc[vt][kt]);
}

#ifdef EMU
DEV unsigned pk_u8_(float x, int byte, unsigned old) { float c = x < 0.f ? 0.f : (x > 255.f ? 255.f : x); const unsigned v = (unsigned)__builtin_lrintf(c); return (old & ~(0xffu << (8 * byte))) | (v << (8 * byte)); }
#else
#define pk_u8_(x, byte, old) __builtin_amdgcn_cvt_pk_u8_f32((x), (byte), (old))
#endif
struct EpiP6 {
    static constexpr bool PERM = true;
    unsigned char* G8; bf16* Pt; bf16* Mg; LAS unsigned char* xl;
    static constexpr int LSLOT = 9;
    DEV void operator()(const f32x4 (&acc)[2][2][4][2], const pg8::Unit& u, int wr, int wc, int fr, int fq) const {
        OPAQUE(fr); OPAQUE(fq);
        const bool gate = (u.kind & 1) == 0, first = u.kind == 1, lastb = u.kind == 7;
        const int tid = (wr * 4 + wc) * 64 + fq * 16 + fr;
        LAS u32x2* gl = (LAS u32x2*)(xl + tid * 8);
        unsigned char* gg8 = G8 + (size_t)(u.pm * 4 + u.pn) * 65536 + tid * 8;
        const size_t pbase = ((size_t)(u.pm * 4 + u.pn) * 16 * 512 + (size_t)tid) * 8;
        if (gate) {
#define SG255(x) (255.f * sigmoid_f(x))
#pragma unroll
            for (int it = 0; it < 8; ++it) {
#pragma unroll
                for (int bj = 0; bj < 2; ++bj) { const f32x4 v0 = acc[it >> 2][bj][it & 3][0], v1 = acc[it >> 2][bj][it & 3][1]; u32x2 w; w.x = 0u; w.y = 0u;
                    w.x = pk_u8_(SG255(v0.x), 0, w.x); w.x = pk_u8_(SG255(v0.y), 1, w.x); w.x = pk_u8_(SG255(v0.z), 2, w.x); w.x = pk_u8_(SG255(v0.w), 3, w.x);
                    w.y = pk_u8_(SG255(v1.x), 0, w.y); w.y = pk_u8_(SG255(v1.y), 1, w.y); w.y = pk_u8_(SG255(v1.z), 2, w.y); w.y = pk_u8_(SG255(v1.w), 3, w.y);
                    if (it * 2 + bj >= LSLOT) gl[(it * 2 + bj - LSLOT) * 512] = w; else *(u32x2*)(gg8 + (it * 2 + bj) * 4096) = w; }
                if (it & 1) CFENCE(); }
#undef SG255
            return; }
        if (first) merge<true, false>(acc, u, pbase, gg8, gl, wr, wc, fr, fq); else if (lastb) merge<false, true>(acc, u, pbase, gg8, gl, wr, wc, fr, fq); else merge<false, false>(acc, u, pbase, gg8, gl, wr, wc, fr, fq);
    }
    template <bool FIRST, bool LAST>
    DEV void merge(const f32x4 (&acc)[2][2][4][2], const pg8::Unit& u, size_t pbase, const unsigned char* gg8, LAS u32x2* gl, int wr, int wc, int fr, int fq) const {
        u32x2 g[3][2]; u32x4 o[3][2];
#define P6_LOAD(it_) do { _Pragma("unroll") for (int bj = 0; bj < 2; ++bj) { const int s_ = (7 - (it_)) * 2 + bj;     \
        if (s_ >= LSLOT) g[(it_) % 3][bj] = gl[(s_ - LSLOT) * 512]; else g[(it_) % 3][bj] = *(const u32x2*)(gg8 + s_ * 4096); \
        if (FIRST) o[(it_) % 3][bj] = (u32x4){0u, 0u, 0u, 0u}; else o[(it_) % 3][bj] = *(const u32x4*)(Pt + pbase + (size_t)s_ * 4096); } } while (0)
        P6_LOAD(0); P6_LOAD(1);
#pragma unroll
        for (int it = 0; it < 8; ++it) {
            if (it + 2 < 8) P6_LOAD(it + 2);
            CFENCE();
            if (FIRST) { if (it == 0) PG8_WAIT_V(0); else if (it == 1) PG8_WAIT_V(1); else if (it == 2) PG8_WAIT_V(3); else if (it < 6) PG8_WAIT_V(4); else if (it == 6) PG8_WAIT_V(2); else PG8_WAIT_V(0); }
            else { if (it == 0) PG8_WAIT_V(4); else if (it == 1) PG8_WAIT_V(5); else if (it == 2) PG8_WAIT_V(7); else if (it < 6) PG8_WAIT_V(8); else if (it == 6) PG8_WAIT_V(4); else PG8_WAIT_V(0); }
            const int jt = 7 - it;
            const size_t off = (size_t)(u.pm * 256 + wr * 64 + fr + (jt >> 2) * 128 + (jt & 3) * 16) * D + u.pn * 256 + wc * 32 + 8 * fq;
            constexpr float fs = LAST ? (1.0f / 255.0f) : 1.0f;
#pragma unroll
            for (int bj = 0; bj < 2; ++bj) { const f32x4 v0 = acc[jt >> 2][bj][jt & 3][0], v1 = acc[jt >> 2][bj][jt & 3][1]; const u32x2 gg = g[it % 3][bj]; const u32x4 oo = o[it % 3][bj]; u32x4 w;
                const float g0 = (float)(gg.x & 0xffu), g1 = (float)((gg.x >> 8) & 0xffu), g2 = (float)((gg.x >> 16) & 0xffu), g3 = (float)(gg.x >> 24);
                const float g4 = (float)(gg.y & 0xffu), g5 = (float)((gg.y >> 8) & 0xffu), g6 = (float)((gg.y >> 16) & 0xffu), g7 = (float)(gg.y >> 24);
                w.x = pk2((bf2f(oo.x & 0xffffu) + g0 * v0.x) * fs, (bf2f(oo.x >> 16) + g1 * v0.y) * fs);
                w.y = pk2((bf2f(oo.y & 0xffffu) + g2 * v0.z) * fs, (bf2f(oo.y >> 16) + g3 * v0.w) * fs);
                w.z = pk2((bf2f(oo.z & 0xffffu) + g4 * v1.x) * fs, (bf2f(oo.z >> 16) + g5 * v1.y) * fs);
                w.w = pk2((bf2f(oo.w & 0xffffu) + g6 * v1.z) * fs, (bf2f(oo.w >> 16) + g7 * v1.w) * fs);
                if (LAST) *(u32x4*)(Mg + off + bj * 128) = w; else *(u32x4*)(Pt + pbase + (size_t)(jt * 2 + bj) * 4096) = w; }
            CFENCE(); }
#undef P6_LOAD
    }
};
struct EpiOut {
    static constexpr bool PERM = false;
    const float* x0; const float* x1; float* H; const float* modt; int l;
    DEV void operator()(const f32x4 (&acc)[2][2][4][2], const pg8::Unit& u, int wr, int wc, int fr, int fq) const {
        OPAQUE(fr); OPAQUE(fq);
        const int t0 = u.pm * 256; const float* gm = modt + (size_t)tok_cond(t0) * 3072 + 2048;
        const int col0 = u.pn * 256 + wc * 32 + 4 * fq;
        f32x4 gv[2][2];
#pragma unroll
        for (int bj = 0; bj < 2; ++bj)
#pragma unroll
            for (int n = 0; n < 2; ++n) gv[bj][n] = *(const f32x4*)(gm + col0 + bj * 128 + n * 16);
        const int tb = t0 + wr * 64 + fr;
        const float* sbase = (l == 0) ? (tb < TC ? x0 + (size_t)tb * D : x1 + (size_t)(tb - TC) * D) : H + (size_t)tb * D;
        f32x4 rs[3][2][2];
#define EO_LOAD(it_) do { const float* sp_ = sbase + (size_t)(((it_) >> 2) * 128 + ((it_) & 3) * 16) * D + col0; _Pragma("unroll") for (int bj = 0; bj < 2; ++bj) _Pragma("unroll") for (int n = 0; n < 2; ++n) \
        rs[(it_) % 3][bj][n] = *(const f32x4*)(sp_ + bj * 128 + n * 16); } while (0)
        EO_LOAD(0); EO_LOAD(1);
#pragma unroll
        for (int it = 0; it < 8; ++it) {
            if (it + 2 < 8) EO_LOAD(it + 2);
            CFENCE();
            if (it < 6) PG8_WAIT_V(8); else if (it == 6) PG8_WAIT_V(4); else PG8_WAIT_V(0);
            float* dst = H + (size_t)(tb + (it >> 2) * 128 + (it & 3) * 16) * D + col0;
#pragma unroll
            for (int bj = 0; bj < 2; ++bj)
#pragma unroll
                for (int n = 0; n < 2; ++n) *(f32x4*)(dst + bj * 128 + n * 16) = rs[it % 3][bj][n] + gv[bj][n] * acc[it >> 2][bj][it & 3][n];
            CFENCE(); }
#undef EO_LOAD
    }
};

DEV void pf_final(Frame& F) {
    const float* fg = F.P->in[24];
    const int gw = F.bx * 8 + F.wave, NGW = F.G * 8;
    if (F.G * 64 == T && (F.G & 7) == 0) {
        for (int i = 0; i < 2; ++i) {
            const int t0 = norm_row0(F, i);
            f32x4 v[4][4]; float s[4];
#pragma unroll
            for (int r = 0; r < 4; ++r)
#pragma unroll
                for (int j = 0; j < 4; ++j) v[r][j] = *(const f32x4*)(F.out + (size_t)(t0 + r) * D + 4 * F.lane + 256 * j);
#pragma unroll
            for (int r = 0; r < 4; ++r) { float a = 0.f;
#pragma unroll
                for (int j = 0; j < 4; ++j) a += (v[r][j].x * v[r][j].x + v[r][j].y * v[r][j].y) + (v[r][j].z * v[r][j].z + v[r][j].w * v[r][j].w);
                s[r] = 1.0f / sqrtf(wave_sum(a, F.lane) * (1.0f / D) + EPS); }
#pragma unroll
            for (int j = 0; j < 4; ++j) { const int c = 4 * F.lane + 256 * j; const f32x4 g = *(const f32x4*)(fg + c);
#pragma unroll
                for (int r = 0; r < 4; ++r) NT_ST((f32x4*)(F.out + (size_t)(t0 + r) * D + c), v[r][j] * s[r] * g); }
        }
        return;
    }
    for (int t = gw; t < T; t += NGW) {
        float* row = F.out + (size_t)t * D;
        f32x4 v[4]; float s = 0.f;
#pragma unroll
        for (int j = 0; j < 4; ++j) { v[j] = *(const f32x4*)(row + 4 * F.lane + 256 * j); s += (v[j].x * v[j].x + v[j].y * v[j].y) + (v[j].z * v[j].z + v[j].w * v[j].w); }
        const float rstd = 1.0f / sqrtf(wave_sum(s, F.lane) * (1.0f / D) + EPS);
#pragma unroll
        for (int j = 0; j < 4; ++j) { const int c = 4 * F.lane + 256 * j; *(f32x4*)(row + c) = v[j] * rstd * *(const f32x4*)(fg + c); }
    }
}

#ifdef EMU
#define DECL_LDS unsigned char* lds = emu::smem(); unsigned char* lds_las = lds;
#else
#define DECL_LDS extern __shared__ __attribute__((aligned(16))) unsigned char lds_raw[]; unsigned char* lds = lds_raw; LAS unsigned char* lds_las = (LAS unsigned char*)lds_raw;
#endif

#ifndef PH_LIMIT
#define PH_LIMIT 1000
#endif
#ifndef PH_MASK
#define PH_MASK 0xFFFF
#endif
#define PH_ON(k) ((PH_MASK >> (k)) & 1)

__global__ void __launch_bounds__(512, 2) fwd_kernel(Params prm) {
    DECL_LDS
    Frame F; F.lds = lds; F.ldsl = lds_las; F.ws = (GAS unsigned char*)prm.ws; F.out = (GAS float*)prm.out;
#ifdef EMU
    F.P = &prm;
#else
    F.P = (PP)__builtin_amdgcn_kernarg_segment_ptr();
#endif
    F.tid = threadIdx.x; F.lane = F.tid & 63; F.wave = __builtin_amdgcn_readfirstlane(F.tid >> 6); F.G = gridDim.x; F.bx = blockIdx.x;
    volatile LAS unsigned* misc = (volatile LAS unsigned*)(lds_las + LDS_MISC);
    if (F.tid < 64) misc[F.tid] = 0u;
    __syncthreads();
    XcdBarrier bar = xcd_barrier_post((unsigned*)(F.ws + WS_CTL), misc + 8); bar.wave = F.wave;
    int phase = 0;
#define GRID_BAR() do { xcd_barrier(bar); if (REP_BAR) xcd_barrier(bar); if (++phase >= PH_LIMIT) return; } while (0)
    LAS unsigned char* glds = lds_las;
#ifdef EMU
#define REFRESH() do { F.tid = threadIdx.x; F.lane = F.tid & 63; } while (0)
#else
#define REFRESH() do { F.lane = FRESH_LANE(); F.tid = F.wave * 64 + F.lane; PP kp_ = (PP)__builtin_amdgcn_kernarg_segment_ptr(); asm volatile("" : "+s"(kp_)); F.P = kp_; \
    GAS unsigned char* w_ = F.ws; asm volatile("" : "+s"(w_)); F.ws = w_; GAS float* o_ = F.out; asm volatile("" : "+s"(o_)); F.out = o_; } while (0)
#endif

    REFRESH(); if (PH_ON(0)) p0_prologue(F);
#if REP_P0
    REFRESH(); p0_prologue(F);
#endif
    GRID_BAR();
    for (int l = 0; l < DEPTH; ++l) {
        REFRESH(); if (PH_ON(1)) { if (l > 0) convert_weights(F, l);
        p1_norm(F, l); if (REP_P1) p1_norm(F, l); }
        GRID_BAR();
        for (int rep = 0; rep <= REP_P2; ++rep) { REFRESH(); if (PH_ON(2)) { pg8::Gemm g{(const bf16*)(F.ws + WS_HN), (const bf16*)(F.ws + WS_WIN), T, NIN, D}; pg8::StaticOrder S; S.init(T, NIN, F.G, F.bx);
          EpiIn E{F.ws, F.out, F.P->in[18] + l * 64, F.P->in[19] + l * 64, F.P->in[15] + l * 8, F.P->in[16] + l * 8, l};
          pg8::gemm_phase<EpiIn, pg8::StaticOrder, true, true>(glds, g, S, E, F.wave); } }
        GRID_BAR();
        REFRESH(); if (PH_ON(3)) { GdnPre pre, nxt; int k = F.bx; if (k < N_GDN_TASKS) { gdn_dma(F, l, k); gdn_prefetch<false>(F, l, k, pre); }
            for (; k < N_GDN_TASKS; k += F.G) { { int t_ = F.lane; OPAQUE(t_); F.lane = t_; F.tid = F.wave * 64 + t_; }
                gdn_a_task(F, l, k, pre, k + F.G < N_GDN_TASKS ? k + F.G : k, nxt); pre = nxt; }
            PG8_WAIT_V(0); }
        GRID_BAR();
        REFRESH();
        if (PH_ON(4)) { unsigned* qctr = (unsigned*)(F.ws + WS_CTL) + 4096 + 64 * l; unsigned nx_ = 0u; bool have = false;
          for (;;) {
            __syncthreads();
            if (F.tid == 0) misc[16] = have ? nx_ : atomicAdd(qctr, 1u);
            __syncthreads();
            int u = __builtin_amdgcn_readfirstlane((int)misc[16]);
            have = false;
            { int t_ = F.lane; OPAQUE(t_); F.lane = t_; F.tid = F.wave * 64 + t_; }
            constexpr int NB_S = DB * 4, NA_S = 3 * DB * 16, NB_C = NB * 4, NA_C = 3 * NB * 4;
            if (u < NB_S) { gdn_b_wave(F, l, u * 8 + F.wave); continue; }
            u -= NB_S;
            if (u < NA_S) { at_unit(F, l, u, qctr, &nx_); have = true; continue; }
            u -= NA_S;
            if (u < NB) { ret_state_group(F, l, u); continue; }
            u -= NB;
            if (u < NB_C) { gdn_b_wave(F, l, (NB_S + u) * 8 + F.wave); continue; }
            u -= NB_C;
            if (u < NA_C) { at_unit(F, l, NA_S + u, qctr, &nx_); have = true; continue; }
            break;
          } }
        GRID_BAR();
        REFRESH(); if (PH_ON(6)) { GdnPre pre, nxt; int k = F.bx; if (k < N_GDN_TASKS) { gdn_dma(F, l, k); gdn_prefetch<true>(F, l, k, pre); }
            for (; k < N_GDN_TASKS; k += F.G) { { int t_ = F.lane; OPAQUE(t_); F.lane = t_; F.tid = F.wave * 64 + t_; }
                gdn_c_task(F, l, k, pre, k + F.G < N_GDN_TASKS ? k + F.G : k, nxt); pre = nxt; }
            PG8_WAIT_V(0); }
        GRID_BAR();
        REFRESH(); if (PH_ON(7)) {
            pg8::Gemm g{nullptr, nullptr, T, D, D};
            pg8::P6Order S{(const char*)(F.ws + WS_HN), (const char*)(F.ws + WS_WIN) + (size_t)NIN * D * 2, (const char*)(F.ws + WS_BR), (const char*)(F.ws + WS_WBR), (T / 256) * 4, F.G, F.bx};
            EpiP6 E{F.ws + WS_GATE, (bf16*)(F.ws + WS_MB), (bf16*)(F.ws + WS_MERGED), lds_las + 131072};
            pg8::gemm_phase<EpiP6, pg8::P6Order, true, true>(glds, g, S, E, F.wave); }
        GRID_BAR();
        REFRESH(); if (PH_ON(8)) { pg8::Gemm g{(const bf16*)(F.ws + WS_MERGED), (const bf16*)(F.ws + WS_WOUT), T, D, D}; pg8::StaticOrder S; S.init(T, D, F.G, F.bx);
          EpiOut E{F.P->in[0], F.P->in[1], F.out, (const float*)(F.ws + WS_MODT) + (size_t)l * NCOND * 3072, l};
          pg8::gemm_phase<EpiOut, pg8::StaticOrder, true, true>(glds, g, S, E, F.wave);
          if (REP_P7 && l == 0) pg8::gemm_phase<EpiOut, pg8::StaticOrder, true, true>(glds, g, S, E, F.wave); }
        GRID_BAR();
    }
    REFRESH(); if (PH_ON(9)) pf_final(F);
}

extern "C" void kernel_launch(void* const* d_in, const int* in_sizes, int n_in, void* d_out, int out_size, void* d_ws, size_t ws_size, hipStream_t stream) {
    static int grid = 0;
    if (grid == 0) {
        if (n_in != 25 || (size_t)out_size != O_END || ws_size < WS_END2) { fprintf(stderr, "kernel_launch: unexpected shapes (n_in %d out %d ws %zu)\n", n_in, out_size, ws_size); grid = -1; return; }
        int dev = 0, cus = 0;
        if (hipGetDevice(&dev) != hipSuccess || hipDeviceGetAttribute(&cus, hipDeviceAttributeMultiprocessorCount, dev) != hipSuccess) { grid = -1; return; }
        if (hipFuncSetAttribute((const void*)fwd_kernel, hipFuncAttributeMaxDynamicSharedMemorySize, LDS_BYTES) != hipSuccess) { fprintf(stderr, "kernel_launch: hipFuncSetAttribute failed\n"); grid = -1; return; }
        (void)hipGetLastError();
        grid = cus;
    }
    if (grid < 0) return;
    (void)hipMemsetAsync((char*)d_ws + WS_CTL, 0, CTL_BYTES, stream);
    Params p{};
    for (int i = 0; i < 25; ++i) p.in[i] = (const float*)d_in[i];
    p.out = (float*)d_out; p.ws = (unsigned char*)d_ws;
    hipLaunchKernelGGL(fwd_kernel, dim3(grid), dim3(512), LDS_BYTES, stream, p);
}

#ifdef EMU
size_t emu_out_size() { return O_END; }
size_t emu_ws_size() { return (size_t)256 * 1024 * 1024; }
size_t emu_ws_used() { return WS_END2; }
#endif
```
